# Optimizing an MI355X kernel written in HIP

```python
import math
import jax, jax.numpy as jnp
from jax import lax
import numpy as np

D_MODEL = 1024
BATCH = 2
SEQ = 8192
DEPTH = 4

BR_WIDTH = 512
N_BRANCH = 3
CONV_WIDTH = 3
HG_HEADS = 4
HG_DK = BR_WIDTH // HG_HEADS
HG_DV = BR_WIDTH // HG_HEADS
HG_CHUNK = 64
F_FLOOR = 1e-30
NSA_QHEADS = 8
NSA_KVHEADS = 2
NSA_GROUP = NSA_QHEADS // NSA_KVHEADS
NSA_HD = BR_WIDTH // NSA_QHEADS
CMP_BLOCK = 32
CMP_STRIDE = 16
CMP_HIDDEN = 256
SLC_BLOCK = 64
SLC_TOPK = 16
WINDOW = 512
Q_BLOCK = 128
ROPE_THETA = 10000.0
D_FF = 2816
N_FFN = 2
N_NORMS = 6
EPS = 1e-6
SEL_FORCE = 1e6
MASK_VALUE = -1e30
KV_COLS = NSA_KVHEADS * NSA_HD
IN_SIZES = (BR_WIDTH,) * 3 + (BR_WIDTH,) * 4 + (BR_WIDTH,) + (KV_COLS,) * 6 + (3 * NSA_QHEADS, N_BRANCH * D_MODEL)
IN_COLS = 3 * BR_WIDTH + 4 * BR_WIDTH + BR_WIDTH + 6 * KV_COLS + 3 * NSA_QHEADS + N_BRANCH * D_MODEL

kernel_name = 'hybrid_conv_hgrn2_nsa_macaron'


def rmsnorm(x, g):
    x32 = x.astype(jnp.float32)
    y = x32 * lax.rsqrt(jnp.mean(x32 * x32, axis=-1, keepdims=True) + EPS)
    return (y * g.astype(jnp.float32)).astype(x.dtype)


def rope(x, positions):
    hd = x.shape[-1]
    half = hd // 2
    inv = ROPE_THETA ** (-jnp.arange(half, dtype=jnp.float32) * 2.0 / hd)
    ang = positions.astype(jnp.float32)[..., None] * inv
    cos = jnp.cos(ang)[:, :, None, :]
    sin = jnp.sin(ang)[:, :, None, :]
    x32 = x.astype(jnp.float32)
    x1, x2 = x32[..., :half], x32[..., half:]
    return jnp.concatenate([x1 * cos - x2 * sin, x2 * cos + x1 * sin], axis=-1).astype(x.dtype)


def masked_softmax(s, mask):
    s = jnp.where(mask, s.astype(jnp.float32), MASK_VALUE)
    m = jnp.max(s, axis=-1, keepdims=True)
    e = jnp.where(mask, jnp.exp(s - m), 0.0)
    d = jnp.sum(e, axis=-1, keepdims=True)
    return e / jnp.where(d > 0, d, 1.0)


def swiglu(h, wg, wu, wd):
    return (jax.nn.silu(h @ wg) * (h @ wu)) @ wd


def short_conv_mixer(b, c, xt, w):
    v = c * xt
    y = lax.conv_general_dilated(v, w[:, None, :].astype(v.dtype), window_strides=(1,),
                                 padding=[(CONV_WIDTH - 1, 0)],
                                 dimension_numbers=('NWC', 'WIO', 'NWC'),
                                 feature_group_count=BR_WIDTH)
    return b * y


def hgrn2_mixer(q, f_logit, i, g, lb, gnorm):
    B, S, _ = q.shape
    dt = q.dtype
    f32 = jnp.float32
    q = jax.nn.silu(q.astype(f32))
    z = f_logit.astype(f32)
    f = lb + (1.0 - lb) * jax.nn.sigmoid(z)
    log_f = jnp.log(jnp.maximum(f, F_FLOOR))
    k = (1.0 - lb) * jax.nn.sigmoid(-z)
    v = i.astype(f32)
    n = S // HG_CHUNK

    def chunks(a, d):
        return a.reshape(B, n, HG_CHUNK, HG_HEADS, d).transpose(1, 0, 3, 2, 4)

    tri = jnp.tril(jnp.ones((HG_CHUNK, HG_CHUNK), dtype=bool))[:, :, None]
    tri_f = tri.astype(f32)

    def step(state, xs):
        qc, kc, vc, lc = xs
        bcum = jnp.cumsum(lc, axis=2)
        diff = bcum[:, :, :, None, :] - bcum[:, :, None, :, :]
        decay = jnp.exp(jnp.where(tri, diff, 0.0)) * tri_f
        attn = jnp.einsum('bhtd,bhsd,bhtsd->bhts', qc, kc, decay)
        o = (jnp.einsum('bhts,bhsv->bhtv', attn, vc)
             + jnp.einsum('bhtd,bhdv->bhtv', qc * jnp.exp(bcum), state))
        b_last = bcum[:, :, -1]
        new_state = (jnp.exp(b_last)[..., None] * state
                     + jnp.einsum('bhsd,bhsv->bhdv', kc * jnp.exp(b_last[:, :, None] - bcum), vc))
        return new_state, o

    state0 = jnp.zeros((B, HG_HEADS, HG_DK, HG_DV), f32)
    _, o = lax.scan(step, state0, (chunks(q, HG_DK), chunks(k, HG_DK), chunks(v, HG_DV), chunks(log_f, HG_DK)))
    o = o.transpose(1, 0, 3, 2, 4).reshape(B, S, HG_HEADS, HG_DV)
    o = rmsnorm(o, gnorm) * jax.nn.silu(g.astype(f32).reshape(B, S, HG_HEADS, HG_DV))
    return o.reshape(B, S, BR_WIDTH).astype(dt)


def compress_blocks(k, pe, w1, w2):
    B, S, H, hd = k.shape
    ch = k.reshape(B, S // CMP_STRIDE, CMP_STRIDE, H, hd)
    blk = jnp.concatenate([ch[:, :-1], ch[:, 1:]], axis=2)
    blk = blk + pe[None, None, :, None, :].astype(blk.dtype)
    flat = blk.transpose(0, 1, 3, 2, 4).reshape(B, blk.shape[1], H, CMP_BLOCK * hd)
    return jax.nn.gelu(flat @ w1) @ w2


def nsa_mixer(q, kc, vc, ks, vs, kw, vw, gate_logits, positions, pe, w1, w2):
    B, S, _ = q.shape
    scale = NSA_HD ** -0.5
    q = rope(q.reshape(B, S, NSA_QHEADS, NSA_HD), positions).reshape(B, S, NSA_KVHEADS, NSA_GROUP, NSA_HD)
    kvr = lambda a: a.reshape(B, S, NSA_KVHEADS, NSA_HD)
    kc, ks, kw = rope(kvr(kc), positions), rope(kvr(ks), positions), rope(kvr(kw), positions)
    vc, vs, vw = kvr(vc), kvr(vs), kvr(vw)
    gates = jax.nn.sigmoid(gate_logits.reshape(B, S, NSA_KVHEADS, NSA_GROUP, 3))

    k_cmp = compress_blocks(kc, pe[0], w1[0], w2[0])
    v_cmp = compress_blocks(vc, pe[1], w1[1], w2[1])
    n_cmp = k_cmp.shape[1]
    cmp_start = jnp.arange(n_cmp) * CMP_STRIDE
    cmp_end = cmp_start + CMP_BLOCK - 1
    n_sel = S // SLC_BLOCK
    top_k = min(SLC_TOPK, n_sel)
    sel_start = jnp.arange(n_sel) * SLC_BLOCK
    overlap = ((cmp_start[:, None] < sel_start[None, :] + SLC_BLOCK)
               & (cmp_start[:, None] + CMP_BLOCK > sel_start[None, :])).astype(jnp.float32)
    ks_blk = ks.transpose(0, 2, 1, 3).reshape(B, NSA_KVHEADS, n_sel, SLC_BLOCK, NSA_HD)
    vs_blk = vs.transpose(0, 2, 1, 3).reshape(B, NSA_KVHEADS, n_sel, SLC_BLOCK, NSA_HD)
    gather = jax.vmap(jax.vmap(lambda blk, ix: blk[ix]))
    pad = ((0, 0), (WINDOW, 0), (0, 0), (0, 0))
    kw_pad, vw_pad = jnp.pad(kw, pad), jnp.pad(vw, pad)
    jsel = jnp.arange(n_sel)

    def block(qb_i):
        t0 = qb_i * Q_BLOCK
        qb = lax.dynamic_slice_in_dim(q, t0, Q_BLOCK, axis=1)
        gb = lax.dynamic_slice_in_dim(gates, t0, Q_BLOCK, axis=1)
        t = t0 + jnp.arange(Q_BLOCK)
        s = jnp.einsum('btkgd,bnkd->bkgtn', qb, k_cmp) * scale
        p_cmp = masked_softmax(s, cmp_end[None, :] <= t[:, None])
        o_cmp = jnp.einsum('bkgtn,bnkd->btkgd', p_cmp.astype(v_cmp.dtype), v_cmp)
        imp = jnp.einsum('bkgtn,nj->bktj', p_cmp, overlap)
        cur = t // SLC_BLOCK
        forced = (jsel[None] == 0) | (jsel[None] == cur[:, None]) | (jsel[None] == cur[:, None] - 1)
        score = jnp.where(forced, SEL_FORCE, jnp.where(sel_start[None] <= t[:, None], imp, -SEL_FORCE))
        _, idx = lax.top_k(score, top_k)
        k_sel = gather(ks_blk, idx)
        v_sel = gather(vs_blk, idx).reshape(B, NSA_KVHEADS, Q_BLOCK, top_k * SLC_BLOCK, NSA_HD)
        s = jnp.einsum('btkgd,bktnld->bkgtnl', qb, k_sel) * scale
        pos = idx[..., None] * SLC_BLOCK + jnp.arange(SLC_BLOCK)
        smask = (pos <= t[:, None, None])[:, :, None]
        p = masked_softmax(s.reshape(B, NSA_KVHEADS, NSA_GROUP, Q_BLOCK, top_k * SLC_BLOCK),
                           smask.reshape(B, NSA_KVHEADS, 1, Q_BLOCK, top_k * SLC_BLOCK))
        o_slc = jnp.einsum('bkgtm,bktmd->btkgd', p.astype(v_sel.dtype), v_sel)
        kwb = lax.dynamic_slice_in_dim(kw_pad, t0, Q_BLOCK + WINDOW, axis=1)
        vwb = lax.dynamic_slice_in_dim(vw_pad, t0, Q_BLOCK + WINDOW, axis=1)
        s_pos = t0 - WINDOW + jnp.arange(Q_BLOCK + WINDOW)
        wmask = (s_pos[None] <= t[:, None]) & (s_pos[None] > t[:, None] - WINDOW) & (s_pos[None] >= 0)
        s = jnp.einsum('btkgd,bskd->bkgts', qb, kwb) * scale
        p = masked_softmax(s, wmask)
        o_win = jnp.einsum('bkgts,bskd->btkgd', p.astype(vwb.dtype), vwb)
        o = gb[..., 0:1] * o_cmp + gb[..., 1:2] * o_slc + gb[..., 2:3] * o_win
        return o.reshape(B, Q_BLOCK, NSA_QHEADS * NSA_HD)

    out = lax.map(block, jnp.arange(S // Q_BLOCK))
    return out.transpose(1, 0, 2, 3).reshape(B, S, BR_WIDTH)


def hybrid_mixer(h, positions, w_in, conv_w, lb, gnorm, cmp_pe, cmp_w1, cmp_w2, w_branch, w_out):
    B, S, _ = h.shape
    u = h @ w_in
    split_pts = [int(v) for v in np.cumsum(IN_SIZES)[:-1]]
    (a_b, a_c, a_x, hq, hf, hi, hg, nq, nkc, nvc, nks, nvs, nkw, nvw, ngate, mgate) = jnp.split(u, split_pts, axis=-1)
    y_a = short_conv_mixer(a_b, a_c, a_x, conv_w)
    y_b = hgrn2_mixer(hq, hf, hi, hg, lb, gnorm)
    y_c = nsa_mixer(nq, nkc, nvc, nks, nvs, nkw, nvw, ngate, positions, cmp_pe, cmp_w1, cmp_w2)
    br = jnp.stack([y_a, y_b.astype(y_a.dtype), y_c.astype(y_a.dtype)], axis=2)
    proj = jnp.einsum('bsnw,nwd->bsnd', br, w_branch)
    g = jax.nn.sigmoid(mgate.reshape(B, S, N_BRANCH, D_MODEL))
    return jnp.sum(g * proj, axis=2) @ w_out


def setup_inputs(seed: int = 0) -> dict:
    key = jax.random.key(seed)
    ks = jax.random.split(key, 16)
    nrm = lambda k, shape, sc: jax.random.normal(k, shape, jnp.float32) * sc
    x = nrm(ks[0], (BATCH, SEQ, D_MODEL), 1.0)
    offset = jax.random.randint(ks[1], (BATCH, 1), 0, 1024, dtype=jnp.int32)
    positions = offset + jnp.arange(SEQ, dtype=jnp.int32)[None, :]
    hgrn_lb_logits = nrm(ks[2], (DEPTH, BR_WIDTH), 0.1)
    norm_gains = 1.0 + nrm(ks[3], (DEPTH, N_NORMS, D_MODEL), 0.05)
    w_ffn_gate = nrm(ks[4], (DEPTH, N_FFN, D_MODEL, D_FF), D_MODEL ** -0.5)
    w_ffn_up = nrm(ks[5], (DEPTH, N_FFN, D_MODEL, D_FF), D_MODEL ** -0.5)
    w_ffn_down = nrm(ks[6], (DEPTH, N_FFN, D_FF, D_MODEL), D_FF ** -0.5)
    w_in = nrm(ks[7], (DEPTH, D_MODEL, IN_COLS), D_MODEL ** -0.5)
    conv_w = nrm(ks[8], (DEPTH, CONV_WIDTH, BR_WIDTH), CONV_WIDTH ** -0.5)
    hgrn_gnorm = 1.0 + nrm(ks[9], (DEPTH, HG_DV), 0.05)
    cmp_pe = nrm(ks[10], (DEPTH, 2, CMP_BLOCK, NSA_HD), 0.1)
    cmp_w1 = nrm(ks[11], (DEPTH, 2, CMP_BLOCK * NSA_HD, CMP_HIDDEN), (CMP_BLOCK * NSA_HD) ** -0.5)
    cmp_w2 = nrm(ks[12], (DEPTH, 2, CMP_HIDDEN, NSA_HD), CMP_HIDDEN ** -0.5)
    w_branch = nrm(ks[13], (DEPTH, N_BRANCH, BR_WIDTH, D_MODEL), BR_WIDTH ** -0.5)
    w_out = nrm(ks[14], (DEPTH, D_MODEL, D_MODEL), D_MODEL ** -0.5)
    return {'x': x, 'positions': positions, 'hgrn_lb_logits': hgrn_lb_logits, 'norm_gains': norm_gains,
            'w_ffn_gate': w_ffn_gate, 'w_ffn_up': w_ffn_up, 'w_ffn_down': w_ffn_down, 'w_in': w_in,
            'conv_w': conv_w, 'hgrn_gnorm': hgrn_gnorm, 'cmp_pe': cmp_pe, 'cmp_w1': cmp_w1,
            'cmp_w2': cmp_w2, 'w_branch': w_branch, 'w_out': w_out}


def reference(x, positions, hgrn_lb_logits, norm_gains, w_ffn_gate, w_ffn_up, w_ffn_down, w_in,
              conv_w, hgrn_gnorm, cmp_pe, cmp_w1, cmp_w2, w_branch, w_out):
    lbp = jax.nn.softmax(hgrn_lb_logits.astype(jnp.float32), axis=0)
    lower_bounds = jnp.cumsum(lbp, axis=0) - lbp[0]
    for l in range(DEPTH):
        g = norm_gains[l]
        h = rmsnorm(x, g[0])
        x = x + 0.5 * rmsnorm(swiglu(h, w_ffn_gate[l, 0], w_ffn_up[l, 0], w_ffn_down[l, 0]), g[1])
        h = rmsnorm(x, g[2])
        x = x + rmsnorm(hybrid_mixer(h, positions, w_in[l], conv_w[l], lower_bounds[l], hgrn_gnorm[l],
                                     cmp_pe[l], cmp_w1[l], cmp_w2[l], w_branch[l], w_out[l]), g[3])
        h = rmsnorm(x, g[4])
        x = x + 0.5 * rmsnorm(swiglu(h, w_ffn_gate[l, 1], w_ffn_up[l, 1], w_ffn_down[l, 1]), g[5])
    return x
```

```cpp
#include <hip/hip_runtime.h>
#include <hip/hip_cooperative_groups.h>
#include <cstdio>
namespace cg = cooperative_groups;

typedef unsigned short u16;
typedef unsigned int u32;
typedef __attribute__((ext_vector_type(8))) short bf16x8;
typedef __attribute__((ext_vector_type(4))) short bf16x4;
typedef __attribute__((ext_vector_type(4))) float f32x4;

#define T_TOK 16384
#define SEQL 8192
#define DM 1024
#define DFF 2816
#define EPSN 1e-6f

#define W_GU0 0ul
#define W_D0 11534336ul
#define W_GU1 17301504ul
#define W_D1 28835840ul
#define W_IN 34603008ul
#define W_BR 51118080ul
#define W_OUT 54263808ul
#define W_C1 56360960ul
#define OFF_H 58458112ul
#define OFF_ACT 92012544ul
#define OFF_STATES OFF_ACT
#define OFF_KR (OFF_ACT + 67108864ul)
#define OFF_VT (OFF_KR + 12582912ul)
#define OFF_D 184287232ul
#define OFF_Y OFF_D
#define OFF_IMP (OFF_D + 50331648ul)
#define OFF_U1 251396096ul
#define OFF_UCONV OFF_U1
#define OFF_UNSA (OFF_U1 + 50331648ul)
#define OFF_UHG OFF_U1
#define OFF_D2 OFF_U1
#define OFF_UMG 347865088ul
#define OFF_QR 448528384ul
#define OFF_CMPA (OFF_QR + 16777216ul)
#define OFF_OCMP (OFF_CMPA + 16777216ul)
#define OFF_ROPE 498860032ul
#define OFF_HC (OFF_ROPE + 4194304ul)
#define OFF_GATES (OFF_HC + 2097152ul)
#define OFF_GDEC (OFF_GATES + 1572864ul)
#define OFF_KCMP (OFF_GDEC + 524288ul)
#define OFF_VCMP (OFF_KCMP + 262144ul)
#define WS_NEEDED (OFF_VCMP + 262144ul)

struct Params {
  const float* x_in; const int* pos; const float* lb_logits; const float* gains;
  const float* wg; const float* wu; const float* wd; const float* win; const float* convw;
  const float* gnorm; const float* pe; const float* cw1; const float* cw2; const float* wbr; const float* wout;
  float* x; char* ws;
};

__device__ __forceinline__ int opaque_tid() { int t = threadIdx.x; asm volatile("" : "+v"(t)); return t; }
__device__ __forceinline__ int opaque_bid() { int t = blockIdx.x; asm volatile("" : "+s"(t)); return t; }
#define TIDX opaque_tid()
#define BIDX opaque_bid()

__device__ __forceinline__ u16 f2bf(float f) {
  u32 u = __float_as_uint(f);
  u += 0x7fffu + ((u >> 16) & 1u);
  return (u16)(u >> 16);
}
__device__ __forceinline__ float bf2f(u16 h) { return __uint_as_float(((u32)h) << 16); }
__device__ __forceinline__ float sigmoidf_(float x) { return 1.0f / (1.0f + __expf(-x)); }
__device__ __forceinline__ float siluf_(float x) { return x / (1.0f + __expf(-x)); }
__device__ __forceinline__ float wave_sum(float v) {
#pragma unroll
  for (int o = 32; o; o >>= 1) v += __shfl_xor(v, o);
  return v;
}
__device__ __forceinline__ f32x4 mfma16(bf16x8 a, bf16x8 b, f32x4 c) {
  return __builtin_amdgcn_mfma_f32_16x16x32_bf16(a, b, c, 0, 0, 0);
}

#define LSTR 72
template <int NJ>
__device__ __forceinline__ void gemm_acc(f32x4 (&acc)[4][NJ], const u16* __restrict__ A, int lda,
                                         const u16* __restrict__ Bt, int ldb, int kbeg, int kend,
                                         int row0, int col0, u16* smem) {
  const int tid = TIDX;
  const int lane = tid & 63, wave = tid >> 6;
  const int wm = wave >> 1, wn = wave & 1;
  u16* sA = smem;
  u16* sB = smem + 2 * 128 * LSTR;
  uint4 ra[4], rb[NJ];
  const int lrow = tid >> 3, lkc = tid & 7;
  const u16* Ag = A + (size_t)(row0 + lrow) * lda + kbeg + lkc * 8;
  const u16* Bg = Bt + (size_t)(col0 + lrow) * ldb + kbeg + lkc * 8;
  const int nk = (kend - kbeg) >> 6;
#pragma unroll
  for (int j = 0; j < 4; ++j) ra[j] = *(const uint4*)(Ag + (size_t)(32 * j) * lda);
#pragma unroll
  for (int j = 0; j < NJ; ++j) rb[j] = *(const uint4*)(Bg + (size_t)(32 * j) * ldb);
#pragma unroll
  for (int j = 0; j < 4; ++j) *(uint4*)(sA + (lrow + 32 * j) * LSTR + lkc * 8) = ra[j];
#pragma unroll
  for (int j = 0; j < NJ; ++j) *(uint4*)(sB + (lrow + 32 * j) * LSTR + lkc * 8) = rb[j];
  __syncthreads();
  for (int kt = 0; kt < nk; ++kt) {
    const int buf = kt & 1;
    if (kt + 1 < nk) {
      const int ko = (kt + 1) * 64;
#pragma unroll
      for (int j = 0; j < 4; ++j) ra[j] = *(const uint4*)(Ag + (size_t)(32 * j) * lda + ko);
#pragma unroll
      for (int j = 0; j < NJ; ++j) rb[j] = *(const uint4*)(Bg + (size_t)(32 * j) * ldb + ko);
    }
    const u16* a = sA + buf * 128 * LSTR + (wm * 64 + (lane & 15)) * LSTR + (lane >> 4) * 8;
    const u16* b = sB + buf * 128 * LSTR + (wn * (NJ * 16) + (lane & 15)) * LSTR + (lane >> 4) * 8;
#pragma unroll
    for (int ks = 0; ks < 2; ++ks) {
      bf16x8 af[4], bfr[NJ];
#pragma unroll
      for (int i = 0; i < 4; ++i) af[i] = *(const bf16x8*)(a + i * 16 * LSTR + ks * 32);
#pragma unroll
      for (int j = 0; j < NJ; ++j) bfr[j] = *(const bf16x8*)(b + j * 16 * LSTR + ks * 32);
#pragma unroll
      for (int i = 0; i < 4; ++i)
#pragma unroll
        for (int j = 0; j < NJ; ++j) acc[i][j] = mfma16(af[i], bfr[j], acc[i][j]);
    }
    if (kt + 1 < nk) {
      const int nb = buf ^ 1;
#pragma unroll
      for (int j = 0; j < 4; ++j) *(uint4*)(sA + nb * 128 * LSTR + (lrow + 32 * j) * LSTR + lkc * 8) = ra[j];
#pragma unroll
      for (int j = 0; j < NJ; ++j) *(uint4*)(sB + nb * 128 * LSTR + (lrow + 32 * j) * LSTR + lkc * 8) = rb[j];
    }
    __syncthreads();
  }
}

#define ZERO_ACC(acc)                                  \
  _Pragma("unroll") for (int i_ = 0; i_ < 4; ++i_)     \
  _Pragma("unroll") for (int j_ = 0; j_ < 4; ++j_) { acc[i_][j_] = (f32x4){0.f, 0.f, 0.f, 0.f}; }

#define CONV_ITEMS 7136
__device__ __forceinline__ void convert_tile(const Params& p, int l, int item, float* tile) {
  const int tid = TIDX;
  int id, loc;
  if (item < 1408) { id = 0; loc = item; }
  else if (item < 2112) { id = 1; loc = item - 1408; }
  else if (item < 3520) { id = 2; loc = item - 2112; }
  else if (item < 4224) { id = 3; loc = item - 3520; }
  else if (item < 6240) { id = 4; loc = item - 4224; }
  else if (item < 6624) { id = 5; loc = item - 6240; }
  else if (item < 6880) { id = 6; loc = item - 6624; }
  else { id = 7; loc = item - 6880; }
  int KT = 16;
  if (id == 1 || id == 3) KT = 44; else if (id == 5) KT = 24; else if (id == 7) KT = 32;
  const int nt = loc / KT, kt = loc % KT;
  const int n0 = nt * 64, k0 = kt * 64;
  const int tn = tid & 63, tk = tid >> 6;
  const int n = n0 + tn;
  const float* src = nullptr; size_t ldsrc = 0; bool zero = false;
  u16* dst = nullptr; int lddst = 0;
  char* ws = p.ws;
  if (id == 0 || id == 2) {
    const int f = id >> 1;
    const int pp = n >> 5, s = (n >> 4) & 1, i = n & 15;
    src = (s ? p.wu : p.wg) + (size_t)(l * 2 + f) * 1024 * DFF + (pp * 16 + i);
    ldsrc = DFF; dst = (u16*)(ws + (f ? W_GU1 : W_GU0)); lddst = 1024;
  } else if (id == 1 || id == 3) {
    const int f = id >> 1;
    src = p.wd + (size_t)(l * 2 + f) * DFF * 1024 + n;
    ldsrc = 1024; dst = (u16*)(ws + (f ? W_D1 : W_D0)); lddst = DFF;
  } else if (id == 4) {
    int col = n;
    if (n >= 4888 && n < 4992) { zero = true; col = 0; }
    else if (n >= 4992) col = n - 104;
    src = p.win + (size_t)l * 1024 * 7960 + col;
    ldsrc = 7960; dst = (u16*)(ws + W_IN); lddst = 1024;
  } else if (id == 5) {
    src = p.wbr + (size_t)l * 1536 * 1024 + n;
    ldsrc = 1024; dst = (u16*)(ws + W_BR); lddst = 1536;
  } else if (id == 6) {
    src = p.wout + (size_t)l * 1024 * 1024 + n;
    ldsrc = 1024; dst = (u16*)(ws + W_OUT); lddst = 1024;
  } else {
    const int m = n >> 8, nn = n & 255;
    src = p.cw1 + (size_t)(l * 2 + m) * 2048 * 256 + nn;
    ldsrc = 256; dst = (u16*)(ws + W_C1); lddst = 2048;
  }
#pragma unroll 4
  for (int it = 0; it < 16; ++it) {
    const int k = it * 4 + tk;
    tile[k * 65 + tn] = zero ? 0.f : src[(size_t)(k0 + k) * ldsrc];
  }
  __syncthreads();
#pragma unroll 4
  for (int it = 0; it < 16; ++it) {
    const int nn = it * 4 + tk, kk = tid & 63;
    dst[(size_t)(n0 + nn) * lddst + k0 + kk] = f2bf(tile[kk * 65 + nn]);
  }
  __syncthreads();
}

__device__ __forceinline__ void phase_convert(const Params& p, int l, float* tile) {
  for (int it = BIDX; it < CONV_ITEMS; it += gridDim.x) convert_tile(p, l, it, tile);
}

__device__ __forceinline__ void phase_norm(const Params& p, int mode, const float* D, const float* gD, float scale,
                           const float* gH, bool writeH) {
  const int lane = TIDX & 63, wave = TIDX >> 6;
  u16* H = (u16*)(p.ws + OFF_H);
  for (int it = BIDX; it < T_TOK / 4; it += gridDim.x) {
    const int row = it * 4 + wave;
    const float* xs = (mode == 0 ? p.x_in : p.x) + (size_t)row * DM;
    float4 xv[4];
#pragma unroll
    for (int i = 0; i < 4; ++i) xv[i] = *(const float4*)(xs + i * 256 + lane * 4);
    if (mode == 1) {
      float4 dv[4];
      float ss = 0.f;
#pragma unroll
      for (int i = 0; i < 4; ++i) {
        dv[i] = *(const float4*)(D + (size_t)row * DM + i * 256 + lane * 4);
        ss += dv[i].x * dv[i].x + dv[i].y * dv[i].y + dv[i].z * dv[i].z + dv[i].w * dv[i].w;
      }
      ss = wave_sum(ss);
      const float r = rsqrtf(ss * (1.0f / DM) + EPSN) * scale;
#pragma unroll
      for (int i = 0; i < 4; ++i) {
        const float4 g = *(const float4*)(gD + i * 256 + lane * 4);
        xv[i].x += dv[i].x * r * g.x; xv[i].y += dv[i].y * r * g.y;
        xv[i].z += dv[i].z * r * g.z; xv[i].w += dv[i].w * r * g.w;
      }
    }
#pragma unroll
    for (int i = 0; i < 4; ++i) *(float4*)(p.x + (size_t)row * DM + i * 256 + lane * 4) = xv[i];
    if (writeH) {
      float ss = 0.f;
#pragma unroll
      for (int i = 0; i < 4; ++i) ss += xv[i].x * xv[i].x + xv[i].y * xv[i].y + xv[i].z * xv[i].z + xv[i].w * xv[i].w;
      ss = wave_sum(ss);
      const float r = rsqrtf(ss * (1.0f / DM) + EPSN);
#pragma unroll
      for (int i = 0; i < 4; ++i) {
        const float4 g = *(const float4*)(gH + i * 256 + lane * 4);
        uint2 o;
        o.x = (u32)f2bf(xv[i].x * r * g.x) | ((u32)f2bf(xv[i].y * r * g.y) << 16);
        o.y = (u32)f2bf(xv[i].z * r * g.z) | ((u32)f2bf(xv[i].w * r * g.w) << 16);
        *(uint2*)(H + (size_t)row * DM + i * 256 + lane * 4) = o;
      }
    }
  }
}

__device__ __forceinline__ void phase_rope_table(const Params& p) {
  float2* cs = (float2*)(p.ws + OFF_ROPE);
  const size_t nth = (size_t)gridDim.x * blockDim.x;
  for (size_t e = (size_t)BIDX * blockDim.x + TIDX; e < (size_t)T_TOK * 32; e += nth) {
    const int t = (int)(e >> 5), i = (int)(e & 31);
    const float inv = powf(10000.0f, -(float)i * (2.0f / 64.0f));
    const float ang = (float)p.pos[t] * inv;
    double rev = (double)ang * 0.15915494309189535;
    rev -= floor(rev);
    const float fr = (float)rev;
    cs[e] = make_float2(__builtin_amdgcn_cosf(fr), __builtin_amdgcn_sinf(fr));
  }
}

__device__ __forceinline__ void phase_ffn_up(const Params& p, const u16* Wgu, u16* smem) {
  const u16* H = (const u16*)(p.ws + OFF_H);
  u16* act = (u16*)(p.ws + OFF_ACT);
  const int lane = TIDX & 63, wave = TIDX >> 6;
  const int wm = wave >> 1, wn = wave & 1;
  for (int it = BIDX; it < 128 * 44; it += gridDim.x) {
    const int nt = it % 44, mt = it / 44;
    f32x4 acc[4][4];
    ZERO_ACC(acc);
    gemm_acc<4>(acc, H, 1024, Wgu, 1024, 0, 1024, mt * 128, nt * 128, smem);
#pragma unroll
    for (int i = 0; i < 4; ++i)
#pragma unroll
      for (int jp = 0; jp < 2; ++jp) {
        const int col = (nt * 4 + wn * 2 + jp) * 16 + (lane & 15);
#pragma unroll
        for (int r = 0; r < 4; ++r) {
          const int row = mt * 128 + wm * 64 + i * 16 + (lane >> 4) * 4 + r;
          const float g = acc[i][2 * jp][r], u = acc[i][2 * jp + 1][r];
          act[(size_t)row * DFF + col] = f2bf(siluf_(g) * u);
        }
      }
  }
}

__device__ __forceinline__ void phase_gemm_f32(const u16* A, int lda, const u16* Bt, int ldb, int K, int MT, int NT,
                               float* out, int ldo, u16* smem) {
  const int lane = TIDX & 63, wave = TIDX >> 6;
  const int wm = wave >> 1, wn = wave & 1;
  for (int it = BIDX; it < MT * NT; it += gridDim.x) {
    const int nt = it % NT, mt = it / NT;
    f32x4 acc[4][4];
    ZERO_ACC(acc);
    gemm_acc<4>(acc, A, lda, Bt, ldb, 0, K, mt * 128, nt * 128, smem);
#pragma unroll
    for (int i = 0; i < 4; ++i)
#pragma unroll
      for (int j = 0; j < 4; ++j) {
        const int col = nt * 128 + wn * 64 + j * 16 + (lane & 15);
#pragma unroll
        for (int r = 0; r < 4; ++r) {
          const int row = mt * 128 + wm * 64 + i * 16 + (lane >> 4) * 4 + r;
          out[(size_t)row * ldo + col] = acc[i][j][r];
        }
      }
  }
}

__device__ __forceinline__ void phase_win(const Params& p, int part, u16* smem) {
  const u16* H = (const u16*)(p.ws + OFF_H);
  const u16* W = (const u16*)(p.ws + W_IN);
  const int lane = TIDX & 63, wave = TIDX >> 6;
  const int wm = wave >> 1, wn = wave & 1;
  const int NT = part ? 40 : 23;
  for (int it = BIDX; it < 128 * NT; it += gridDim.x) {
    const int nl = it % NT, mt = it / NT;
    int ct;
    if (part == 0) ct = (nl < 12) ? nl : (28 + nl - 12);
    else ct = (nl < 16) ? (12 + nl) : (39 + nl - 16);
    u16* dst; int ld, cb;
    if (ct < 12) { dst = (u16*)(p.ws + OFF_UCONV); ld = 1536; cb = ct * 128; }
    else if (ct < 28) { dst = (u16*)(p.ws + OFF_UHG); ld = 2048; cb = (ct - 12) * 128; }
    else if (ct < 39) { dst = (u16*)(p.ws + OFF_UNSA); ld = 1408; cb = (ct - 28) * 128; }
    else { dst = (u16*)(p.ws + OFF_UMG); ld = 3072; cb = (ct - 39) * 128; }
    f32x4 acc[4][4];
    ZERO_ACC(acc);
    gemm_acc<4>(acc, H, 1024, W, 1024, 0, 1024, mt * 128, ct * 128, smem);
#pragma unroll
    for (int i = 0; i < 4; ++i)
#pragma unroll
      for (int j = 0; j < 4; ++j) {
        const int col = cb + wn * 64 + j * 16 + (lane & 15);
#pragma unroll
        for (int r = 0; r < 4; ++r) {
          const int row = mt * 128 + wm * 64 + i * 16 + (lane >> 4) * 4 + r;
          dst[(size_t)row * ld + col] = f2bf(acc[i][j][r]);
        }
      }
  }
}

__device__ __forceinline__ void phase_cmp1(const Params& p, u16* smem) {
  const int lane = TIDX & 63, wave = TIDX >> 6;
  const int wm = wave >> 1, wn = wave & 1;
  for (int it = BIDX; it < 64; it += gridDim.x) {
    const int m = it >> 5, mt = (it >> 1) & 15, nt = it & 1;
    const u16* A = (const u16*)(p.ws + OFF_CMPA) + (size_t)m * 2048 * 2048;
    const u16* Bt = (const u16*)(p.ws + W_C1) + (size_t)m * 256 * 2048;
    u16* Hc = (u16*)(p.ws + OFF_HC) + (size_t)m * 2048 * 256;
    f32x4 acc[4][4];
    ZERO_ACC(acc);
    gemm_acc<4>(acc, A, 2048, Bt, 2048, 0, 2048, mt * 128, nt * 128, smem);
#pragma unroll
    for (int i = 0; i < 4; ++i)
#pragma unroll
      for (int j = 0; j < 4; ++j) {
        const int col = nt * 128 + wn * 64 + j * 16 + (lane & 15);
#pragma unroll
        for (int r = 0; r < 4; ++r) {
          const int row = mt * 128 + wm * 64 + i * 16 + (lane >> 4) * 4 + r;
          const float x = acc[i][j][r];
          const float u = 0.7978845608028654f * (x + 0.044715f * x * x * x);
          Hc[(size_t)row * 256 + col] = f2bf(x * sigmoidf_(2.0f * u));
        }
      }
  }
}

__device__ __forceinline__ void phase_cmp2(const Params& p, int l) {
  const u16* Hc = (const u16*)(p.ws + OFF_HC);
  u16* kcmp = (u16*)(p.ws + OFF_KCMP);
  u16* vcmpT = (u16*)(p.ws + OFF_VCMP);
  const size_t nth = (size_t)gridDim.x * blockDim.x;
  for (size_t e = (size_t)BIDX * blockDim.x + TIDX; e < (size_t)2 * 2048 * 64; e += nth) {
    const int m = (int)(e >> 17);
    const int rem = (int)(e & 131071);
    const int row = rem >> 6, d = rem & 63;
    if (row < 2044) {
      const u16* hr = Hc + ((size_t)m * 2048 + row) * 256;
      const float* w2 = p.cw2 + (size_t)(l * 2 + m) * 256 * 64 + d;
      float acc = 0.f;
#pragma unroll 8
      for (int k = 0; k < 256; ++k) acc += bf2f(hr[k]) * w2[k * 64];
      const int b = row / 1022, r2 = row % 1022;
      const int n = r2 >> 1, kh = r2 & 1;
      if (m == 0) kcmp[((size_t)(b * 2 + kh) * 512 + n) * 64 + d] = f2bf(acc);
      else vcmpT[((size_t)(b * 2 + kh) * 64 + d) * 512 + n] = f2bf(acc);
    } else {
      const int bk = row - 2044;
      if (m == 0) kcmp[((size_t)bk * 512 + 511) * 64 + d] = 0;
      else vcmpT[((size_t)bk * 64 + d) * 512 + 511] = 0;
    }
  }
}

__device__ __forceinline__ void phase_merge(const Params& p, u16* smem) {
  const u16* Y = (const u16*)(p.ws + OFF_Y);
  const u16* W = (const u16*)(p.ws + W_BR);
  const u16* MG = (const u16*)(p.ws + OFF_UMG);
  u16* outp = (u16*)(p.ws + OFF_H);
  const int lane = TIDX & 63, wave = TIDX >> 6;
  const int wm = wave >> 1, wn = wave & 1;
  for (int it = BIDX; it < 128 * 16; it += gridDim.x) {
    const int nt = it & 15, mt = it >> 4;
    f32x4 tot[4][2];
#pragma unroll
    for (int i = 0; i < 4; ++i)
#pragma unroll
      for (int j = 0; j < 2; ++j) tot[i][j] = (f32x4){0.f, 0.f, 0.f, 0.f};
    for (int n = 0; n < 3; ++n) {
      f32x4 acc[4][2];
#pragma unroll
      for (int i = 0; i < 4; ++i)
#pragma unroll
        for (int j = 0; j < 2; ++j) acc[i][j] = (f32x4){0.f, 0.f, 0.f, 0.f};
      gemm_acc<2>(acc, Y, 1536, W, 1536, n * 512, n * 512 + 512, mt * 128, nt * 64, smem);
#pragma unroll
      for (int i = 0; i < 4; ++i)
#pragma unroll
        for (int j = 0; j < 2; ++j) {
          const int col = nt * 64 + wn * 32 + j * 16 + (lane & 15);
#pragma unroll
          for (int r = 0; r < 4; ++r) {
            const int row = mt * 128 + wm * 64 + i * 16 + (lane >> 4) * 4 + r;
            const float g = sigmoidf_(bf2f(MG[(size_t)row * 3072 + n * 1024 + col]));
            tot[i][j][r] += g * acc[i][j][r];
          }
        }
    }
#pragma unroll
    for (int i = 0; i < 4; ++i)
#pragma unroll
      for (int j = 0; j < 2; ++j) {
        const int col = nt * 64 + wn * 32 + j * 16 + (lane & 15);
#pragma unroll
        for (int r = 0; r < 4; ++r) {
          const int row = mt * 128 + wm * 64 + i * 16 + (lane >> 4) * 4 + r;
          outp[(size_t)row * 1024 + col] = f2bf(tot[i][j][r]);
        }
      }
  }
}

__device__ __forceinline__ void phase_prep(const Params& p, int l) {
  const u16* Uc = (const u16*)(p.ws + OFF_UCONV);
  const u16* Un = (const u16*)(p.ws + OFF_UNSA);
  u16* Y = (u16*)(p.ws + OFF_Y);
  u16* qr = (u16*)(p.ws + OFF_QR);
  u16* KR = (u16*)(p.ws + OFF_KR);
  u16* VT = (u16*)(p.ws + OFF_VT);
  u16* CA = (u16*)(p.ws + OFF_CMPA);
  float* gates = (float*)(p.ws + OFF_GATES);
  const float2* cs = (const float2*)(p.ws + OFF_ROPE);
  const int tid = TIDX;
  const size_t nth = (size_t)gridDim.x * blockDim.x;
  const size_t gt = (size_t)BIDX * blockDim.x + tid;
  for (size_t e = gt; e < (size_t)T_TOK * 512; e += nth) {
    const int t = (int)(e >> 9), c = (int)(e & 511);
    const int s = t & (SEQL - 1);
    const float w0 = p.convw[(l * 3 + 0) * 512 + c], w1 = p.convw[(l * 3 + 1) * 512 + c], w2 = p.convw[(l * 3 + 2) * 512 + c];
    const u16* r2 = Uc + (size_t)t * 1536;
    const float v2 = bf2f(r2[512 + c]) * bf2f(r2[1024 + c]);
    float v1 = 0.f, v0 = 0.f;
    if (s >= 1) { const u16* r1 = r2 - 1536; v1 = bf2f(r1[512 + c]) * bf2f(r1[1024 + c]); }
    if (s >= 2) { const u16* r0 = r2 - 3072; v0 = bf2f(r0[512 + c]) * bf2f(r0[1024 + c]); }
    Y[(size_t)t * 1536 + c] = f2bf(bf2f(r2[c]) * (w0 * v0 + w1 * v1 + w2 * v2));
  }
  for (size_t e = gt; e < (size_t)2 * 4 * 2048; e += nth) {
    const int m = (int)(e >> 13), rem = (int)(e & 8191);
    CA[((size_t)m * 2048 + 2044) * 2048 + rem] = 0;
  }
  const float* pek = p.pe + (size_t)(l * 2 + 0) * 2048;
  const float* pev = p.pe + (size_t)(l * 2 + 1) * 2048;
  for (int it = BIDX; it < 1024; it += gridDim.x) {
    const int b = it >> 9, ch = it & 511;
    const int s0 = ch * 16, t0 = b * SEQL + s0;
    for (int idx = tid; idx < 4096; idx += 256) {
      const int i = idx >> 8, pr = idx & 255;
      const int head = pr >> 5, d = pr & 31;
      const int t = t0 + i;
      const float2 c_s = cs[(size_t)t * 32 + d];
      const float x1 = bf2f(Un[(size_t)t * 1408 + head * 64 + d]);
      const float x2 = bf2f(Un[(size_t)t * 1408 + head * 64 + 32 + d]);
      qr[(size_t)t * 512 + head * 64 + d] = f2bf(x1 * c_s.x - x2 * c_s.y);
      qr[(size_t)t * 512 + head * 64 + 32 + d] = f2bf(x2 * c_s.x + x1 * c_s.y);
    }
    for (int idx = tid; idx < 3072; idx += 256) {
      const int i = idx / 192, rem = idx % 192;
      const int m = rem >> 6, hp = rem & 63;
      const int kh = hp >> 5, d = hp & 31;
      const int t = t0 + i;
      const float2 c_s = cs[(size_t)t * 32 + d];
      const int col = 512 + m * 256 + kh * 64;
      const float x1 = bf2f(Un[(size_t)t * 1408 + col + d]);
      const float x2 = bf2f(Un[(size_t)t * 1408 + col + 32 + d]);
      const float o1 = x1 * c_s.x - x2 * c_s.y, o2 = x2 * c_s.x + x1 * c_s.y;
      u16* kd = KR + (size_t)m * 2097152 + ((size_t)(b * 2 + kh) * SEQL + s0 + i) * 64;
      kd[d] = f2bf(o1); kd[32 + d] = f2bf(o2);
      if (m == 0) {
        if (ch <= 510) {
          u16* a = CA + ((size_t)((b * 511 + ch) * 2 + kh)) * 2048 + i * 64;
          a[d] = f2bf(o1 + pek[i * 64 + d]); a[32 + d] = f2bf(o2 + pek[i * 64 + 32 + d]);
        }
        if (ch >= 1) {
          u16* a = CA + ((size_t)((b * 511 + ch - 1) * 2 + kh)) * 2048 + (16 + i) * 64;
          a[d] = f2bf(o1 + pek[(16 + i) * 64 + d]); a[32 + d] = f2bf(o2 + pek[(16 + i) * 64 + 32 + d]);
        }
      }
    }
    for (int idx = tid; idx < 2048; idx += 256) {
      const int i = idx >> 7, cc = idx & 127;
      const int kh = cc >> 6, d = cc & 63;
      const int t = t0 + i;
      const float v = bf2f(Un[(size_t)t * 1408 + 640 + cc]);
      u16* CAv = CA + (size_t)2048 * 2048;
      if (ch <= 510) CAv[((size_t)((b * 511 + ch) * 2 + kh)) * 2048 + i * 64 + d] = f2bf(v + pev[i * 64 + d]);
      if (ch >= 1) CAv[((size_t)((b * 511 + ch - 1) * 2 + kh)) * 2048 + (16 + i) * 64 + d] = f2bf(v + pev[(16 + i) * 64 + d]);
    }
    for (int idx = tid; idx < 4096; idx += 256) {
      const int i = idx & 15, cc = idx >> 4;
      const int m = cc >> 7, c2 = cc & 127;
      const int kh = c2 >> 6, d = c2 & 63;
      VT[(size_t)m * 2097152 + ((size_t)(b * 2 + kh) * 64 + d) * SEQL + s0 + i] =
          Un[(size_t)(t0 + i) * 1408 + 896 + m * 256 + c2];
    }
    for (int idx = tid; idx < 384; idx += 256) {
      const int i = idx / 24, gI = idx % 24;
      gates[(size_t)(t0 + i) * 24 + gI] = sigmoidf_(bf2f(Un[(size_t)(t0 + i) * 1408 + 1280 + gI]));
    }
  }
}

template <class MaskF>
__device__ __forceinline__ void qk_tile32(const u16* __restrict__ Kp, const bf16x8 (&qf)[2], float scale,
                                          MaskF maskf, int lane, f32x4 (&st)[2]) {
  const int c16 = lane & 15, q = lane >> 4;
#pragma unroll
  for (int kt = 0; kt < 2; ++kt) {
    const u16* kr = Kp + (kt * 16 + c16) * 64 + q * 8;
    const bf16x8 k0 = *(const bf16x8*)(kr);
    const bf16x8 k1 = *(const bf16x8*)(kr + 32);
    f32x4 z = {0.f, 0.f, 0.f, 0.f};
    z = mfma16(k0, qf[0], z);
    z = mfma16(k1, qf[1], z);
#pragma unroll
    for (int r = 0; r < 4; ++r) st[kt][r] = maskf(kt * 16 + q * 4 + r) ? z[r] * scale : -1e30f;
  }
}

__device__ __forceinline__ void pv_tile32(const u16* __restrict__ Vp, int ldv, const f32x4 (&pr)[2], int lane,
                                          f32x4 (&o)[4]) {
  const int c16 = lane & 15, q = lane >> 4;
  bf16x8 pb;
#pragma unroll
  for (int j = 0; j < 4; ++j) { pb[j] = (short)f2bf(pr[0][j]); pb[4 + j] = (short)f2bf(pr[1][j]); }
#pragma unroll
  for (int dt = 0; dt < 4; ++dt) {
    const u16* vr = Vp + (size_t)(dt * 16 + c16) * ldv + q * 4;
    const bf16x4 va = *(const bf16x4*)(vr);
    const bf16x4 vb = *(const bf16x4*)(vr + 16);
    bf16x8 vf;
    vf[0] = va[0]; vf[1] = va[1]; vf[2] = va[2]; vf[3] = va[3];
    vf[4] = vb[0]; vf[5] = vb[1]; vf[6] = vb[2]; vf[7] = vb[3];
    o[dt] = mfma16(vf, pb, o[dt]);
  }
}

template <class MaskF>
__device__ __forceinline__ void attn_tile32(const u16* __restrict__ Kp, const u16* __restrict__ Vp, int ldv,
                                            const bf16x8 (&qf)[2], float scale, MaskF maskf, int lane,
                                            float& m, float& lsum, f32x4 (&o)[4]) {
  f32x4 st[2];
  qk_tile32(Kp, qf, scale, maskf, lane, st);
  float mx = -1e30f;
#pragma unroll
  for (int kt = 0; kt < 2; ++kt)
#pragma unroll
    for (int r = 0; r < 4; ++r) mx = fmaxf(mx, st[kt][r]);
  mx = fmaxf(mx, __shfl_xor(mx, 16));
  mx = fmaxf(mx, __shfl_xor(mx, 32));
  const float mnew = fmaxf(m, mx);
  const float alpha = __expf(m - mnew);
  float ps = 0.f;
#pragma unroll
  for (int kt = 0; kt < 2; ++kt)
#pragma unroll
    for (int r = 0; r < 4; ++r) {
      const float pv = (st[kt][r] > -1e29f) ? __expf(st[kt][r] - mnew) : 0.f;
      st[kt][r] = pv;
      ps += pv;
    }
  lsum = lsum * alpha + ps;
  m = mnew;
#pragma unroll
  for (int dt = 0; dt < 4; ++dt) o[dt] *= alpha;
  pv_tile32(Vp, ldv, st, lane, o);
}

__device__ __forceinline__ void phase_cmp_attn(const Params& p) {
  const u16* qr = (const u16*)(p.ws + OFF_QR);
  const u16* kcmp = (const u16*)(p.ws + OFF_KCMP);
  const u16* vcmpT = (const u16*)(p.ws + OFF_VCMP);
  u16* ocmp = (u16*)(p.ws + OFF_OCMP);
  float* imp = (float*)(p.ws + OFF_IMP);
  const int lane = TIDX & 63, wave = TIDX >> 6;
  const int c16 = lane & 15, q = lane >> 4;
  const int tq = c16 >> 2, g = c16 & 3;
  const float scale = 0.125f;
  for (int it = BIDX; it < 2048; it += gridDim.x) {
    const int b = it >> 10, kh = (it >> 9) & 1, grp = it & 511;
    const int s0 = (grp * 4 + wave) * 4;
    const int s = s0 + tq;
    const int t = b * SEQL + s;
    const int head = kh * 4 + g;
    bf16x8 qf[2];
    qf[0] = *(const bf16x8*)(qr + (size_t)t * 512 + head * 64 + q * 8);
    qf[1] = *(const bf16x8*)(qr + (size_t)t * 512 + head * 64 + 32 + q * 8);
    const int nvalid = (s >= 31) ? (((s - 31) >> 4) + 1) : 0;
    const int slast = s0 + 3;
    const int nvmax = (slast >= 31) ? (((slast - 31) >> 4) + 1) : 0;
    const int ntile = (nvmax + 31) >> 5;
    const u16* Kb = kcmp + (size_t)(b * 2 + kh) * 512 * 64;
    const u16* Vb = vcmpT + (size_t)(b * 2 + kh) * 64 * 512;
    float m = -1e30f, lsum = 0.f;
    for (int tl = 0; tl < ntile; ++tl) {
      const int n0 = tl * 32;
      f32x4 st[2];
      qk_tile32(Kb + (size_t)n0 * 64, qf, scale, [&](int ko) { return (n0 + ko) < nvalid; }, lane, st);
      float mx = -1e30f;
#pragma unroll
      for (int kt = 0; kt < 2; ++kt)
#pragma unroll
        for (int r = 0; r < 4; ++r) mx = fmaxf(mx, st[kt][r]);
      mx = fmaxf(mx, __shfl_xor(mx, 16));
      mx = fmaxf(mx, __shfl_xor(mx, 32));
      const float mnew = fmaxf(m, mx);
      float ps = 0.f;
#pragma unroll
      for (int kt = 0; kt < 2; ++kt)
#pragma unroll
        for (int r = 0; r < 4; ++r) ps += (st[kt][r] > -1e29f) ? __expf(st[kt][r] - mnew) : 0.f;
      lsum = lsum * __expf(m - mnew) + ps;
      m = mnew;
    }
    lsum += __shfl_xor(lsum, 16);
    lsum += __shfl_xor(lsum, 32);
    const float invl = (lsum > 0.f) ? 1.0f / lsum : 0.f;
    f32x4 o[4];
#pragma unroll
    for (int dt = 0; dt < 4; ++dt) o[dt] = (f32x4){0.f, 0.f, 0.f, 0.f};
    float carry = 0.f;
    float* impr = imp + ((size_t)(b * 2 + kh) * SEQL + s) * 128;
    for (int tl = 0; tl < ntile; ++tl) {
      const int n0 = tl * 32;
      f32x4 st[2];
      qk_tile32(Kb + (size_t)n0 * 64, qf, scale, [&](int ko) { return (n0 + ko) < nvalid; }, lane, st);
#pragma unroll
      for (int kt = 0; kt < 2; ++kt)
#pragma unroll
        for (int r = 0; r < 4; ++r) st[kt][r] = (st[kt][r] > -1e29f) ? __expf(st[kt][r] - m) * invl : 0.f;
      pv_tile32(Vb + n0, 512, st, lane, o);
      float main0 = 0.f, main1 = 0.f, e0 = 0.f, e1 = 0.f;
#pragma unroll
      for (int r = 0; r < 4; ++r) {
        float a0 = st[0][r], a1 = st[1][r];
        a0 += __shfl_xor(a0, 1); a0 += __shfl_xor(a0, 2);
        a1 += __shfl_xor(a1, 1); a1 += __shfl_xor(a1, 2);
        main0 += a0; main1 += a1;
        if (r == 3) { e0 = a0; e1 = a1; }
      }
      const float e0_up = __shfl(e0, (lane + 48) & 63);
      const float e1_up = __shfl(e1, (lane + 48) & 63);
      const float pe0 = (q > 0) ? e0_up : carry;
      const float pe1 = (q > 0) ? e1_up : e0_up;
      carry = e1_up;
      if (g == 0) {
        impr[(n0 >> 2) + q] = main0 + pe0;
        impr[(n0 >> 2) + 4 + q] = main1 + pe1;
      }
    }
#pragma unroll
    for (int dt = 0; dt < 4; ++dt) {
      uint2 w;
      w.x = (u32)f2bf(o[dt][0]) | ((u32)f2bf(o[dt][1]) << 16);
      w.y = (u32)f2bf(o[dt][2]) | ((u32)f2bf(o[dt][3]) << 16);
      *(uint2*)(ocmp + (size_t)t * 512 + head * 64 + dt * 16 + q * 4) = w;
    }
  }
}

__device__ __forceinline__ void phase_slc_win(const Params& p) {
  const u16* qr = (const u16*)(p.ws + OFF_QR);
  const u16* KS = (const u16*)(p.ws + OFF_KR) + (size_t)1 * 2097152;
  const u16* KW = (const u16*)(p.ws + OFF_KR) + (size_t)2 * 2097152;
  const u16* VS = (const u16*)(p.ws + OFF_VT);
  const u16* VW = (const u16*)(p.ws + OFF_VT) + (size_t)2097152;
  const u16* ocmp = (const u16*)(p.ws + OFF_OCMP);
  const float* imp = (const float*)(p.ws + OFF_IMP);
  const float* gates = (const float*)(p.ws + OFF_GATES);
  u16* Y = (u16*)(p.ws + OFF_Y);
  const int lane = TIDX & 63, wave = TIDX >> 6;
  const int c16 = lane & 15, q = lane >> 4;
  const int tq = c16 >> 2, g = c16 & 3;
  const float scale = 0.125f;
  for (int it = BIDX; it < 2048; it += gridDim.x) {
    const int b = it >> 10, kh = (it >> 9) & 1, grp = it & 511;
    const int s0 = (grp * 4 + wave) * 4;
    const int s = s0 + tq;
    const int t = b * SEQL + s;
    const int head = kh * 4 + g;
    bf16x8 qf[2];
    qf[0] = *(const bf16x8*)(qr + (size_t)t * 512 + head * 64 + q * 8);
    qf[1] = *(const bf16x8*)(qr + (size_t)t * 512 + head * 64 + 32 + q * 8);
    const size_t kvb = (size_t)(b * 2 + kh);
    const u16* Kw = KW + kvb * SEQL * 64;
    const u16* Vw = VW + kvb * 64 * SEQL;
    const u16* Ks = KS + kvb * SEQL * 64;
    const u16* Vs = VS + kvb * 64 * SEQL;
    float mw = -1e30f, lw = 0.f;
    f32x4 ow[4];
#pragma unroll
    for (int dt = 0; dt < 4; ++dt) ow[dt] = (f32x4){0.f, 0.f, 0.f, 0.f};
    {
      int lo = s0 - 511; if (lo < 0) lo = 0;
      lo &= ~31;
      for (int k0 = lo; k0 <= s0 + 3; k0 += 32) {
        attn_tile32(Kw + (size_t)k0 * 64, Vw + k0, SEQL, qf, scale,
                    [&](int ko) { const int ks = k0 + ko; return (ks <= s) && (ks + 512 > s); }, lane, mw, lw, ow);
      }
    }
    float ms = -1e30f, ls = 0.f;
    f32x4 os[4];
#pragma unroll
    for (int dt = 0; dt < 4; ++dt) os[dt] = (f32x4){0.f, 0.f, 0.f, 0.f};
    const int cur = s0 >> 6;
    const int nforced = (cur < 2 ? cur : 2) + 1;
    const int ncand = cur - 2;
    const int nsel = ncand <= 0 ? 0 : (ncand < 13 ? ncand : 13);
    for (int tk = -1; tk < 4; ++tk) {
      const int nblk = (tk < 0) ? nforced : nsel;
      const bool mine = (tk < 0) || (tq == tk);
      float v0 = -1.f, v1 = -1.f;
      if (tk >= 0 && ncand > 13) {
        const float* ir = imp + (kvb * SEQL + s0 + tk) * 128;
        v0 = (lane >= 1 && lane <= ncand) ? ir[lane] : -1.f;
        v1 = (lane + 64 <= ncand) ? ir[lane + 64] : -1.f;
      }
      for (int bi = 0; bi < nblk; ++bi) {
        int j;
        if (tk < 0) j = (bi == 0) ? 0 : (cur - (nforced - 1 - bi));
        else if (ncand <= 13) j = 1 + bi;
        else {
          float bv; int bx;
          if (v0 >= v1) { bv = v0; bx = lane; } else { bv = v1; bx = lane + 64; }
#pragma unroll
          for (int off = 32; off; off >>= 1) {
            const float ov = __shfl_xor(bv, off);
            const int oi = __shfl_xor(bx, off);
            if (ov > bv || (ov == bv && oi < bx)) { bv = ov; bx = oi; }
          }
          j = __builtin_amdgcn_readfirstlane(bx);
          if (j == lane) v0 = -2.f;
          if (j == lane + 64) v1 = -2.f;
        }
        for (int hh = 0; hh < 2; ++hh) {
          const int k0 = j * 64 + hh * 32;
          attn_tile32(Ks + (size_t)k0 * 64, Vs + k0, SEQL, qf, scale,
                      [&](int ko) { return mine && ((k0 + ko) <= s); }, lane, ms, ls, os);
        }
      }
    }
    lw += __shfl_xor(lw, 16); lw += __shfl_xor(lw, 32);
    ls += __shfl_xor(ls, 16); ls += __shfl_xor(ls, 32);
    const float iw = (lw > 0.f) ? 1.0f / lw : 0.f;
    const float is = (ls > 0.f) ? 1.0f / ls : 0.f;
    const float g0 = gates[(size_t)t * 24 + kh * 12 + g * 3 + 0];
    const float g1 = gates[(size_t)t * 24 + kh * 12 + g * 3 + 1] * is;
    const float g2 = gates[(size_t)t * 24 + kh * 12 + g * 3 + 2] * iw;
#pragma unroll
    for (int dt = 0; dt < 4; ++dt) {
      const uint2 oc = *(const uint2*)(ocmp + (size_t)t * 512 + head * 64 + dt * 16 + q * 4);
      const float c0 = bf2f((u16)(oc.x & 0xffff)), c1 = bf2f((u16)(oc.x >> 16));
      const float c2 = bf2f((u16)(oc.y & 0xffff)), c3 = bf2f((u16)(oc.y >> 16));
      const float y0 = g0 * c0 + g1 * os[dt][0] + g2 * ow[dt][0];
      const float y1 = g0 * c1 + g1 * os[dt][1] + g2 * ow[dt][1];
      const float y2 = g0 * c2 + g1 * os[dt][2] + g2 * ow[dt][2];
      const float y3 = g0 * c3 + g1 * os[dt][3] + g2 * ow[dt][3];
      uint2 w;
      w.x = (u32)f2bf(y0) | ((u32)f2bf(y1) << 16);
      w.y = (u32)f2bf(y2) | ((u32)f2bf(y3) << 16);
      *(uint2*)(Y + (size_t)t * 1536 + 1024 + head * 64 + dt * 16 + q * 4) = w;
    }
  }
}

#define BCS 132
__device__ __forceinline__ float hg_lb(const Params& p, int l, int ch) {
  if (l == 0) return 0.f;
  const float a0 = p.lb_logits[ch], a1 = p.lb_logits[512 + ch], a2 = p.lb_logits[1024 + ch], a3 = p.lb_logits[1536 + ch];
  const float mx = fmaxf(fmaxf(a0, a1), fmaxf(a2, a3));
  const float e0 = __expf(a0 - mx), e1 = __expf(a1 - mx), e2 = __expf(a2 - mx), e3 = __expf(a3 - mx);
  const float inv = 1.0f / (e0 + e1 + e2 + e3);
  float sacc = e1;
  if (l >= 2) sacc += e2;
  if (l >= 3) sacc += e3;
  return sacc * inv;
}

__device__ __forceinline__ void hg_bcum(const Params& p, int l, const u16* Uhg, int t0, int h, float* bc, float* lbs) {
  const int tid = TIDX;
  const int d = tid & 127;
  const float lbv = hg_lb(p, l, h * 128 + d);
  if (tid < 128) lbs[d] = lbv;
  for (int idx = tid; idx < 64 * 128; idx += 256) {
    const int s = idx >> 7;
    const float z = bf2f(Uhg[(size_t)(t0 + s) * 2048 + 512 + h * 128 + d]);
    const float f = lbv + (1.0f - lbv) * sigmoidf_(z);
    bc[s * BCS + d] = __logf(fmaxf(f, 1e-30f));
  }
  __syncthreads();
  if (tid < 128) {
    float run = 0.f;
    for (int s = 0; s < 64; ++s) { run += bc[s * BCS + d]; bc[s * BCS + d] = run; }
  }
  __syncthreads();
}

__device__ __forceinline__ void phase_hg_local(const Params& p, int l, char* smem) {
  const u16* Uhg = (const u16*)(p.ws + OFF_UHG);
  float* states = (float*)(p.ws + OFF_STATES);
  float* gdec = (float*)(p.ws + OFF_GDEC);
  float* bc = (float*)smem;
  float* lbs = (float*)(smem + 33792);
  u16* KT = (u16*)(smem + 33792 + 512);
  u16* VTs = (u16*)(smem + 33792 + 512 + 18432);
  const int tid = TIDX, lane = tid & 63, wave = tid >> 6;
  const int c16 = lane & 15, q = lane >> 4;
  for (int it = BIDX; it < 1024; it += gridDim.x) {
    const int b = it >> 9, h = (it >> 7) & 3, c = it & 127;
    const int t0 = b * SEQL + c * 64;
    hg_bcum(p, l, Uhg, t0, h, bc, lbs);
    {
      const int d = tid & 127;
      const float lbv = lbs[d];
      const float bl = bc[63 * BCS + d];
      for (int idx = tid; idx < 64 * 128; idx += 256) {
        const int s = idx >> 7;
        const float z = bf2f(Uhg[(size_t)(t0 + s) * 2048 + 512 + h * 128 + d]);
        const float kk = (1.0f - lbv) * sigmoidf_(-z);
        KT[d * 72 + s] = f2bf(kk * __expf(bl - bc[s * BCS + d]));
        VTs[d * 72 + s] = Uhg[(size_t)(t0 + s) * 2048 + 1024 + h * 128 + d];
      }
      if (tid < 128) gdec[(size_t)it * 128 + d] = __expf(bl);
    }
    __syncthreads();
    f32x4 acc[2][8];
#pragma unroll
    for (int i = 0; i < 2; ++i)
#pragma unroll
      for (int j = 0; j < 8; ++j) acc[i][j] = (f32x4){0.f, 0.f, 0.f, 0.f};
#pragma unroll
    for (int ks = 0; ks < 2; ++ks) {
      bf16x8 af[2];
#pragma unroll
      for (int i = 0; i < 2; ++i) af[i] = *(const bf16x8*)(VTs + (wave * 32 + i * 16 + c16) * 72 + ks * 32 + q * 8);
#pragma unroll
      for (int j = 0; j < 8; ++j) {
        const bf16x8 bfr = *(const bf16x8*)(KT + (j * 16 + c16) * 72 + ks * 32 + q * 8);
#pragma unroll
        for (int i = 0; i < 2; ++i) acc[i][j] = mfma16(af[i], bfr, acc[i][j]);
      }
    }
    float* st = states + (size_t)it * 16384;
#pragma unroll
    for (int i = 0; i < 2; ++i)
#pragma unroll
      for (int j = 0; j < 8; ++j)
#pragma unroll
        for (int r = 0; r < 4; ++r) st[(wave * 32 + i * 16 + q * 4 + r) * 128 + j * 16 + c16] = acc[i][j][r];
    __syncthreads();
  }
}

__device__ __forceinline__ void phase_hg_scan(const Params& p) {
  float* states = (float*)(p.ws + OFF_STATES);
  const float* gdec = (const float*)(p.ws + OFF_GDEC);
  const size_t nth = (size_t)gridDim.x * blockDim.x;
  for (size_t e = (size_t)BIDX * blockDim.x + TIDX; e < (size_t)8 * 16384; e += nth) {
    const int bh = (int)(e >> 14), vd = (int)(e & 16383), d = vd & 127;
    float S = 0.f;
#pragma unroll 8
    for (int c = 0; c < 128; ++c) {
      const size_t item = (size_t)bh * 128 + c;
      S = gdec[item * 128 + d] * S + states[item * 16384 + vd];
      states[item * 16384 + vd] = S;
    }
  }
}

__device__ __forceinline__ void phase_hg_out(const Params& p, int l, char* smem) {
  const u16* Uhg = (const u16*)(p.ws + OFF_UHG);
  const float* states = (const float*)(p.ws + OFF_STATES);
  u16* Y = (u16*)(p.ws + OFF_Y);
  float* bc = (float*)smem;
  float* lbs = (float*)(smem + 33792);
  u16* VTs = (u16*)(smem + 33792 + 512);
  const int tid = TIDX, lane = tid & 63, wave = tid >> 6;
  const int c16 = lane & 15, q = lane >> 4;
  for (int it = BIDX; it < 1024; it += gridDim.x) {
    const int b = it >> 9, h = (it >> 7) & 3, c = it & 127;
    const int t0 = b * SEQL + c * 64;
    hg_bcum(p, l, Uhg, t0, h, bc, lbs);
    {
      const int d = tid & 127;
      for (int idx = tid; idx < 64 * 128; idx += 256) {
        const int s = idx >> 7;
        VTs[d * 72 + s] = Uhg[(size_t)(t0 + s) * 2048 + 1024 + h * 128 + d];
      }
    }
    __syncthreads();
    const int tt = wave * 16 + c16;
    const bool hi = (wave >= 2);
    bf16x8 Qt[4], Qh[4];
#pragma unroll
    for (int ks = 0; ks < 4; ++ks) {
      const int d0 = ks * 32 + q * 8;
      const bf16x8 qraw = *(const bf16x8*)(Uhg + (size_t)(t0 + tt) * 2048 + h * 128 + d0);
#pragma unroll
      for (int j = 0; j < 8; ++j) {
        const float qv = siluf_(bf2f((u16)qraw[j]));
        const float bt = bc[tt * BCS + d0 + j];
        const float rr = hi ? bc[31 * BCS + d0 + j] : 0.f;
        Qt[ks][j] = (short)f2bf(qv * __expf(bt - rr));
        Qh[ks][j] = (short)f2bf(qv * __expf(bt));
      }
    }
    f32x4 at[4];
#pragma unroll
    for (int st = 0; st < 4; ++st) {
      at[st] = (f32x4){0.f, 0.f, 0.f, 0.f};
      if (st <= wave) {
        f32x4 a = {0.f, 0.f, 0.f, 0.f};
        const int srow = st * 16 + c16;
#pragma unroll
        for (int ks = 0; ks < 4; ++ks) {
          const int d0 = ks * 32 + q * 8;
          const bf16x8 zraw = *(const bf16x8*)(Uhg + (size_t)(t0 + srow) * 2048 + 512 + h * 128 + d0);
          bf16x8 kf;
#pragma unroll
          for (int j = 0; j < 8; ++j) {
            const float z = bf2f((u16)zraw[j]);
            const float kk = (1.0f - lbs[d0 + j]) * sigmoidf_(-z);
            const float rr = hi ? bc[31 * BCS + d0 + j] : 0.f;
            const float ex = fminf(rr - bc[srow * BCS + d0 + j], 80.f);
            kf[j] = (short)f2bf(kk * __expf(ex));
          }
          a = mfma16(kf, Qt[ks], a);
        }
#pragma unroll
        for (int r = 0; r < 4; ++r) at[st][r] = ((st * 16 + q * 4 + r) <= tt) ? a[r] : 0.f;
      }
    }
    bf16x8 pb[2];
#pragma unroll
    for (int sp = 0; sp < 2; ++sp)
#pragma unroll
      for (int j = 0; j < 4; ++j) {
        pb[sp][j] = (short)f2bf(at[2 * sp][j]);
        pb[sp][4 + j] = (short)f2bf(at[2 * sp + 1][j]);
      }
    f32x4 o[8];
    float ss = 0.f;
    const float* Sp = states + (size_t)(it - 1) * 16384;
#pragma unroll
    for (int vt = 0; vt < 8; ++vt) {
      f32x4 acc = {0.f, 0.f, 0.f, 0.f};
#pragma unroll
      for (int sp = 0; sp < 2; ++sp) {
        if (2 * sp <= wave) {
          const u16* vr = VTs + (vt * 16 + c16) * 72 + sp * 32 + q * 4;
          const bf16x4 va = *(const bf16x4*)(vr);
          const bf16x4 vb = *(const bf16x4*)(vr + 16);
          bf16x8 vf;
          vf[0] = va[0]; vf[1] = va[1]; vf[2] = va[2]; vf[3] = va[3];
          vf[4] = vb[0]; vf[5] = vb[1]; vf[6] = vb[2]; vf[7] = vb[3];
          acc = mfma16(vf, pb[sp], acc);
        }
      }
      if (c > 0) {
#pragma unroll
        for (int ks = 0; ks < 4; ++ks) {
          const float* sr = Sp + (size_t)(vt * 16 + c16) * 128 + ks * 32 + q * 8;
          const float4 s0v = *(const float4*)(sr);
          const float4 s1v = *(const float4*)(sr + 4);
          bf16x8 sf;
          sf[0] = (short)f2bf(s0v.x); sf[1] = (short)f2bf(s0v.y); sf[2] = (short)f2bf(s0v.z); sf[3] = (short)f2bf(s0v.w);
          sf[4] = (short)f2bf(s1v.x); sf[5] = (short)f2bf(s1v.y); sf[6] = (short)f2bf(s1v.z); sf[7] = (short)f2bf(s1v.w);
          acc = mfma16(sf, Qh[ks], acc);
        }
      }
      o[vt] = acc;
#pragma unroll
      for (int r = 0; r < 4; ++r) ss += acc[r] * acc[r];
    }
    ss += __shfl_xor(ss, 16);
    ss += __shfl_xor(ss, 32);
    const float rinv = rsqrtf(ss * (1.0f / 128.0f) + EPSN);
    const size_t trow = (size_t)(t0 + tt);
#pragma unroll
    for (int vt = 0; vt < 8; ++vt) {
      const int v0 = vt * 16 + q * 4;
      const uint2 graw = *(const uint2*)(Uhg + trow * 2048 + 1536 + h * 128 + v0);
      const float4 gn = *(const float4*)(p.gnorm + l * 128 + v0);
      const float y0 = o[vt][0] * rinv * gn.x * siluf_(bf2f((u16)(graw.x & 0xffff)));
      const float y1 = o[vt][1] * rinv * gn.y * siluf_(bf2f((u16)(graw.x >> 16)));
      const float y2 = o[vt][2] * rinv * gn.z * siluf_(bf2f((u16)(graw.y & 0xffff)));
      const float y3 = o[vt][3] * rinv * gn.w * siluf_(bf2f((u16)(graw.y >> 16)));
      uint2 w;
      w.x = (u32)f2bf(y0) | ((u32)f2bf(y1) << 16);
      w.y = (u32)f2bf(y2) | ((u32)f2bf(y3) << 16);
      *(uint2*)(Y + trow * 1536 + 512 + h * 128 + v0) = w;
    }
    __syncthreads();
  }
}

#define SMEM_BYTES 73728
__global__ void __launch_bounds__(256, 2) mega(Params p) {
  cg::grid_group grid = cg::this_grid();
  __shared__ __attribute__((aligned(16))) char smem[SMEM_BYTES];
  u16* sm16 = (u16*)smem;
  char* ws = p.ws;
  for (int gs = -1; gs < 60; ++gs) {
    const int l = (gs < 0) ? 0 : gs / 15;
    const int st = (gs < 0) ? -1 : gs % 15;
    const float* g = p.gains + (size_t)l * 6 * 1024;
    if (st == 0 || st == 12) {
      phase_ffn_up(p, (const u16*)(ws + (st == 0 ? W_GU0 : W_GU1)), sm16);
    } else if (st == 1 || st == 10 || st == 13) {
      const u16* A = (const u16*)(ws + (st == 10 ? OFF_H : OFF_ACT));
      const u16* Bt = (const u16*)(ws + (st == 10 ? W_OUT : (st == 1 ? W_D0 : W_D1)));
      const int K = (st == 10) ? 1024 : DFF;
      float* outp = (float*)(ws + (st == 10 ? OFF_D2 : OFF_D));
      phase_gemm_f32(A, K, Bt, K, K, 128, 8, outp, 1024, sm16);
    } else if (st == -1 || st == 2 || st == 11 || st == 14) {
      if (st == -1) phase_rope_table(p);
      const int mode = (st == -1) ? 0 : 1;
      const float* D = (const float*)(ws + (st == 11 ? OFF_D2 : OFF_D));
      const float* gD = g + (st == 2 ? 1 : (st == 11 ? 3 : 5)) * 1024;
      const float scale = (st == 11) ? 1.0f : 0.5f;
      const float* gH = (st == -1) ? g : g + (st == 2 ? 2 : (st == 11 ? 4 : 6)) * 1024;
      const bool writeH = !(st == 14 && l == 3);
      phase_norm(p, mode, D, gD, scale, gH, writeH);
      if (st == -1 || (st == 14 && l < 3)) phase_convert(p, (st == -1) ? 0 : l + 1, (float*)smem);
    } else if (st == 3 || st == 5) {
      if (st == 5) phase_cmp1(p, sm16);
      phase_win(p, st == 5 ? 1 : 0, sm16);
    } else if (st == 4) {
      phase_prep(p, l);
    } else if (st == 6) {
      phase_cmp2(p, l);
      phase_hg_local(p, l, smem);
    } else if (st == 7) {
      phase_cmp_attn(p);
      phase_hg_scan(p);
    } else if (st == 8) {
      phase_slc_win(p);
      phase_hg_out(p, l, smem);
    } else if (st == 9) {
      phase_merge(p, sm16);
    }
    if (gs < 59) grid.sync();
  }
}

extern "C" void kernel_launch(void* const* d_in, const int* in_sizes, int n_in,
                              void* d_out, int out_size, void* d_ws, size_t ws_size,
                              hipStream_t stream) {
  static int grid_blocks = 0;
  if (!grid_blocks) {
    int dev = 0, cus = 0, per_cu = 0;
    hipGetDevice(&dev);
    hipDeviceGetAttribute(&cus, hipDeviceAttributeMultiprocessorCount, dev);
    hipOccupancyMaxActiveBlocksPerMultiprocessor(&per_cu, mega, 256, 0);
    if (per_cu > 2) per_cu = 2;
    if (per_cu < 1) per_cu = 1;
    grid_blocks = cus * per_cu;
  }
  if (ws_size < (size_t)WS_NEEDED) {
    fprintf(stderr, "workspace too small: %zu < %zu\n", ws_size, (size_t)WS_NEEDED);
    return;
  }
  Params p{};
  p.x_in = (const float*)d_in[0];
  p.pos = (const int*)d_in[1];
  p.lb_logits = (const float*)d_in[2];
  p.gains = (const float*)d_in[3];
  p.wg = (const float*)d_in[4];
  p.wu = (const float*)d_in[5];
  p.wd = (const float*)d_in[6];
  p.win = (const float*)d_in[7];
  p.convw = (const float*)d_in[8];
  p.gnorm = (const float*)d_in[9];
  p.pe = (const float*)d_in[10];
  p.cw1 = (const float*)d_in[11];
  p.cw2 = (const float*)d_in[12];
  p.wbr = (const float*)d_in[13];
  p.wout = (const float*)d_in[14];
  p.x = (float*)d_out;
  p.ws = (char*)d_ws;
  void* args[] = {&p};
  hipError_t e = hipLaunchCooperativeKernel((void*)mega, dim3(grid_blocks), dim3(256), args, 0, stream);
  if (e != hipSuccess) fprintf(stderr, "coop launch failed: %s (grid %d)\n", hipGetErrorString(e), grid_blocks);
}
```

```cpp
#include <hip/hip_runtime.h>
#include <hip/hip_cooperative_groups.h>
#include <cstdio>
namespace cg = cooperative_groups;

typedef unsigned short u16;
typedef unsigned int u32;
typedef __attribute__((ext_vector_type(8))) short bf16x8;
typedef __attribute__((ext_vector_type(4))) short bf16x4;
typedef __attribute__((ext_vector_type(4))) float f32x4;

#define T_TOK 16384
#define SEQL 8192
#define DM 1024
#define DFF 2816
#define EPSN 1e-6f

#define W_GU0 0ul
#define W_D0 11534336ul
#define W_GU1 17301504ul
#define W_D1 28835840ul
#define W_IN 34603008ul
#define W_BR 51118080ul
#define W_OUT 54263808ul
#define W_C1 56360960ul
#define OFF_H 58458112ul
#define OFF_ACT 92012544ul
#define OFF_STATES OFF_ACT
#define OFF_KR (OFF_ACT + 67108864ul)
#define OFF_VT (OFF_KR + 12582912ul)
#define OFF_D 184287232ul
#define OFF_Y OFF_D
#define OFF_IMP (OFF_D + 50331648ul)
#define OFF_U1 251396096ul
#define OFF_UCONV OFF_U1
#define OFF_UNSA (OFF_U1 + 50331648ul)
#define OFF_UHG OFF_U1
#define OFF_D2 OFF_U1
#define OFF_UMG 347865088ul
#define OFF_QR 448528384ul
#define OFF_CMPA (OFF_QR + 16777216ul)
#define OFF_OCMP (OFF_CMPA + 16777216ul)
#define OFF_ROPE 498860032ul
#define OFF_HC (OFF_ROPE + 4194304ul)
#define OFF_GATES (OFF_HC + 2097152ul)
#define OFF_GDEC (OFF_GATES + 1572864ul)
#define OFF_KCMP (OFF_GDEC + 524288ul)
#define OFF_VCMP (OFF_KCMP + 262144ul)
#define WS_NEEDED (OFF_VCMP + 262144ul)

struct Params {
  const float* x_in; const int* pos; const float* lb_logits; const float* gains;
  const float* wg; const float* wu; const float* wd; const float* win; const float* convw;
  const float* gnorm; const float* pe; const float* cw1; const float* cw2; const float* wbr; const float* wout;
  float* x; char* ws;
};

__device__ __forceinline__ int opaque_tid() { int t = threadIdx.x; asm volatile("" : "+v"(t)); return t; }
__device__ __forceinline__ int opaque_bid() { int t = blockIdx.x; asm volatile("" : "+s"(t)); return t; }
#define TIDX opaque_tid()
#define BIDX opaque_bid()

__device__ __forceinline__ u16 f2bf(float f) {
  u32 u = __float_as_uint(f);
  u += 0x7fffu + ((u >> 16) & 1u);
  return (u16)(u >> 16);
}
__device__ __forceinline__ float bf2f(u16 h) { return __uint_as_float(((u32)h) << 16); }
__device__ __forceinline__ float sigmoidf_(float x) { return 1.0f / (1.0f + __expf(-x)); }
__device__ __forceinline__ float siluf_(float x) { return x / (1.0f + __expf(-x)); }
__device__ __forceinline__ float wave_sum(float v) {
#pragma unroll
  for (int o = 32; o; o >>= 1) v += __shfl_xor(v, o);
  return v;
}
__device__ __forceinline__ f32x4 mfma16(bf16x8 a, bf16x8 b, f32x4 c) {
  return __builtin_amdgcn_mfma_f32_16x16x32_bf16(a, b, c, 0, 0, 0);
}

#define LSTR 72
template <int NJ>
__device__ __forceinline__ void gemm_acc(f32x4 (&acc)[4][NJ], const u16* __restrict__ A, int lda,
                                         const u16* __restrict__ Bt, int ldb, int kbeg, int kend,
                                         int row0, int col0, u16* smem) {
  const int tid = TIDX;
  const int lane = tid & 63, wave = tid >> 6;
  const int wm = wave >> 1, wn = wave & 1;
  u16* sA = smem;
  u16* sB = smem + 2 * 128 * LSTR;
  const int lrow = tid >> 3, lkc = tid & 7;
  const u16* Ag = A + (size_t)(row0 + lrow) * lda + kbeg + lkc * 8;
  const u16* Bg = Bt + (size_t)(col0 + lrow) * ldb + kbeg + lkc * 8;
  const size_t a32 = (size_t)32 * lda, b32 = (size_t)32 * ldb;
  uint4 ra0, ra1, ra2, ra3, rb0, rb1, rb2, rb3;
  const int nk = (kend - kbeg) >> 6;
  ra0 = *(const uint4*)(Ag); ra1 = *(const uint4*)(Ag + a32); ra2 = *(const uint4*)(Ag + 2 * a32); ra3 = *(const uint4*)(Ag + 3 * a32);
  rb0 = *(const uint4*)(Bg); rb1 = *(const uint4*)(Bg + b32);
  if (NJ == 4) { rb2 = *(const uint4*)(Bg + 2 * b32); rb3 = *(const uint4*)(Bg + 3 * b32); }
  {
    u16* wa = sA + lrow * LSTR + lkc * 8;
    u16* wb = sB + lrow * LSTR + lkc * 8;
    *(uint4*)(wa) = ra0; *(uint4*)(wa + 32 * LSTR) = ra1; *(uint4*)(wa + 64 * LSTR) = ra2; *(uint4*)(wa + 96 * LSTR) = ra3;
    *(uint4*)(wb) = rb0; *(uint4*)(wb + 32 * LSTR) = rb1;
    if (NJ == 4) { *(uint4*)(wb + 64 * LSTR) = rb2; *(uint4*)(wb + 96 * LSTR) = rb3; }
  }
  __syncthreads();
  for (int kt = 0; kt < nk; ++kt) {
    const int buf = kt & 1;
    const bool more = (kt + 1 < nk);
    if (more) {
      const u16* Ak = Ag + (kt + 1) * 64;
      const u16* Bk = Bg + (kt + 1) * 64;
      ra0 = *(const uint4*)(Ak); ra1 = *(const uint4*)(Ak + a32); ra2 = *(const uint4*)(Ak + 2 * a32); ra3 = *(const uint4*)(Ak + 3 * a32);
      rb0 = *(const uint4*)(Bk); rb1 = *(const uint4*)(Bk + b32);
      if (NJ == 4) { rb2 = *(const uint4*)(Bk + 2 * b32); rb3 = *(const uint4*)(Bk + 3 * b32); }
    }
    __builtin_amdgcn_sched_barrier(0);
    const u16* a = sA + buf * 128 * LSTR + (wm * 64 + (lane & 15)) * LSTR + (lane >> 4) * 8;
    const u16* b = sB + buf * 128 * LSTR + (wn * (NJ * 16) + (lane & 15)) * LSTR + (lane >> 4) * 8;
#pragma unroll
    for (int ks = 0; ks < 2; ++ks) {
      bf16x8 af[4], bfr[NJ];
#pragma unroll
      for (int i = 0; i < 4; ++i) af[i] = *(const bf16x8*)(a + i * 16 * LSTR + ks * 32);
#pragma unroll
      for (int j = 0; j < NJ; ++j) bfr[j] = *(const bf16x8*)(b + j * 16 * LSTR + ks * 32);
#pragma unroll
      for (int i = 0; i < 4; ++i)
#pragma unroll
        for (int j = 0; j < NJ; ++j) acc[i][j] = mfma16(af[i], bfr[j], acc[i][j]);
    }
    __builtin_amdgcn_sched_barrier(0);
    if (more) {
      const int nb = buf ^ 1;
      u16* wa = sA + nb * 128 * LSTR + lrow * LSTR + lkc * 8;
      u16* wb = sB + nb * 128 * LSTR + lrow * LSTR + lkc * 8;
      *(uint4*)(wa) = ra0; *(uint4*)(wa + 32 * LSTR) = ra1; *(uint4*)(wa + 64 * LSTR) = ra2; *(uint4*)(wa + 96 * LSTR) = ra3;
      *(uint4*)(wb) = rb0; *(uint4*)(wb + 32 * LSTR) = rb1;
      if (NJ == 4) { *(uint4*)(wb + 64 * LSTR) = rb2; *(uint4*)(wb + 96 * LSTR) = rb3; }
    }
    __syncthreads();
  }
}

#define ZERO_ACC(acc)                                  \
  _Pragma("unroll") for (int i_ = 0; i_ < 4; ++i_)     \
  _Pragma("unroll") for (int j_ = 0; j_ < 4; ++j_) { acc[i_][j_] = (f32x4){0.f, 0.f, 0.f, 0.f}; }

#define CONV_ITEMS 7136
__device__ __forceinline__ void convert_tile(const Params& p, int l, int item, float* tile) {
  const int tid = TIDX;
  int id, loc;
  if (item < 1408) { id = 0; loc = item; }
  else if (item < 2112) { id = 1; loc = item - 1408; }
  else if (item < 3520) { id = 2; loc = item - 2112; }
  else if (item < 4224) { id = 3; loc = item - 3520; }
  else if (item < 6240) { id = 4; loc = item - 4224; }
  else if (item < 6624) { id = 5; loc = item - 6240; }
  else if (item < 6880) { id = 6; loc = item - 6624; }
  else { id = 7; loc = item - 6880; }
  int KT = 16;
  if (id == 1 || id == 3) KT = 44; else if (id == 5) KT = 24; else if (id == 7) KT = 32;
  const int nt = loc / KT, kt = loc % KT;
  const int n0 = nt * 64, k0 = kt * 64;
  const int tn = tid & 63, tk = tid >> 6;
  const int n = n0 + tn;
  const float* src = nullptr; size_t ldsrc = 0; bool zero = false;
  u16* dst = nullptr; int lddst = 0;
  char* ws = p.ws;
  if (id == 0 || id == 2) {
    const int f = id >> 1;
    const int pp = n >> 5, s = (n >> 4) & 1, i = n & 15;
    src = (s ? p.wu : p.wg) + (size_t)(l * 2 + f) * 1024 * DFF + (pp * 16 + i);
    ldsrc = DFF; dst = (u16*)(ws + (f ? W_GU1 : W_GU0)); lddst = 1024;
  } else if (id == 1 || id == 3) {
    const int f = id >> 1;
    src = p.wd + (size_t)(l * 2 + f) * DFF * 1024 + n;
    ldsrc = 1024; dst = (u16*)(ws + (f ? W_D1 : W_D0)); lddst = DFF;
  } else if (id == 4) {
    int col = n;
    if (n >= 4888 && n < 4992) { zero = true; col = 0; }
    else if (n >= 4992) col = n - 104;
    src = p.win + (size_t)l * 1024 * 7960 + col;
    ldsrc = 7960; dst = (u16*)(ws + W_IN); lddst = 1024;
  } else if (id == 5) {
    src = p.wbr + (size_t)l * 1536 * 1024 + n;
    ldsrc = 1024; dst = (u16*)(ws + W_BR); lddst = 1536;
  } else if (id == 6) {
    src = p.wout + (size_t)l * 1024 * 1024 + n;
    ldsrc = 1024; dst = (u16*)(ws + W_OUT); lddst = 1024;
  } else {
    const int m = n >> 8, nn = n & 255;
    src = p.cw1 + (size_t)(l * 2 + m) * 2048 * 256 + nn;
    ldsrc = 256; dst = (u16*)(ws + W_C1); lddst = 2048;
  }
#pragma unroll 4
  for (int it = 0; it < 16; ++it) {
    const int k = it * 4 + tk;
    tile[k * 65 + tn] = zero ? 0.f : src[(size_t)(k0 + k) * ldsrc];
  }
  __syncthreads();
#pragma unroll 4
  for (int it = 0; it < 16; ++it) {
    const int nn = it * 4 + tk, kk = tid & 63;
    dst[(size_t)(n0 + nn) * lddst + k0 + kk] = f2bf(tile[kk * 65 + nn]);
  }
  __syncthreads();
}

__device__ __forceinline__ void phase_convert(const Params& p, int l, float* tile) {
  for (int it = BIDX; it < CONV_ITEMS; it += gridDim.x) convert_tile(p, l, it, tile);
}

__device__ __forceinline__ void phase_norm(const Params& p, int mode, const float* D, const float* gD, float scale,
                           const float* gH, bool writeH) {
  const int lane = TIDX & 63, wave = TIDX >> 6;
  u16* H = (u16*)(p.ws + OFF_H);
  for (int it = BIDX; it < T_TOK / 4; it += gridDim.x) {
    const int row = it * 4 + wave;
    const float* xs = (mode == 0 ? p.x_in : p.x) + (size_t)row * DM;
    float4 xv[4];
#pragma unroll
    for (int i = 0; i < 4; ++i) xv[i] = *(const float4*)(xs + i * 256 + lane * 4);
    if (mode == 1) {
      float4 dv[4];
      float ss = 0.f;
#pragma unroll
      for (int i = 0; i < 4; ++i) {
        dv[i] = *(const float4*)(D + (size_t)row * DM + i * 256 + lane * 4);
        ss += dv[i].x * dv[i].x + dv[i].y * dv[i].y + dv[i].z * dv[i].z + dv[i].w * dv[i].w;
      }
      ss = wave_sum(ss);
      const float r = rsqrtf(ss * (1.0f / DM) + EPSN) * scale;
#pragma unroll
      for (int i = 0; i < 4; ++i) {
        const float4 g = *(const float4*)(gD + i * 256 + lane * 4);
        xv[i].x += dv[i].x * r * g.x; xv[i].y += dv[i].y * r * g.y;
        xv[i].z += dv[i].z * r * g.z; xv[i].w += dv[i].w * r * g.w;
      }
    }
#pragma unroll
    for (int i = 0; i < 4; ++i) *(float4*)(p.x + (size_t)row * DM + i * 256 + lane * 4) = xv[i];
    if (writeH) {
      float ss = 0.f;
#pragma unroll
      for (int i = 0; i < 4; ++i) ss += xv[i].x * xv[i].x + xv[i].y * xv[i].y + xv[i].z * xv[i].z + xv[i].w * xv[i].w;
      ss = wave_sum(ss);
      const float r = rsqrtf(ss * (1.0f / DM) + EPSN);
#pragma unroll
      for (int i = 0; i < 4; ++i) {
        const float4 g = *(const float4*)(gH + i * 256 + lane * 4);
        uint2 o;
        o.x = (u32)f2bf(xv[i].x * r * g.x) | ((u32)f2bf(xv[i].y * r * g.y) << 16);
        o.y = (u32)f2bf(xv[i].z * r * g.z) | ((u32)f2bf(xv[i].w * r * g.w) << 16);
        *(uint2*)(H + (size_t)row * DM + i * 256 + lane * 4) = o;
      }
    }
  }
}

__device__ __forceinline__ void phase_rope_table(const Params& p) {
  float2* cs = (float2*)(p.ws + OFF_ROPE);
  const size_t nth = (size_t)gridDim.x * blockDim.x;
  for (size_t e = (size_t)BIDX * blockDim.x + TIDX; e < (size_t)T_TOK * 32; e += nth) {
    const int t = (int)(e >> 5), i = (int)(e & 31);
    const float inv = powf(10000.0f, -(float)i * (2.0f / 64.0f));
    const float ang = (float)p.pos[t] * inv;
    double rev = (double)ang * 0.15915494309189535;
    rev -= floor(rev);
    const float fr = (float)rev;
    cs[e] = make_float2(__builtin_amdgcn_cosf(fr), __builtin_amdgcn_sinf(fr));
  }
}

__device__ __forceinline__ void phase_ffn_up(const Params& p, const u16* Wgu, u16* smem) {
  const u16* H = (const u16*)(p.ws + OFF_H);
  u16* act = (u16*)(p.ws + OFF_ACT);
  const int lane = TIDX & 63, wave = TIDX >> 6;
  const int wm = wave >> 1, wn = wave & 1;
  const int bid_ = BIDX;
  for (int lt = bid_ >> 3; lt < 16 * 44; lt += (gridDim.x >> 3)) {
    const int rest_ = lt >> 3;
    const int nt = rest_ % 44, mt = (bid_ & 7) * 16 + (rest_ / 44) * 8 + (lt & 7);
    f32x4 acc[4][4];
    ZERO_ACC(acc);
    gemm_acc<4>(acc, H, 1024, Wgu, 1024, 0, 1024, mt * 128, nt * 128, smem);
#pragma unroll
    for (int i = 0; i < 4; ++i)
#pragma unroll
      for (int jp = 0; jp < 2; ++jp) {
        const int col = (nt * 4 + wn * 2 + jp) * 16 + (lane & 15);
#pragma unroll
        for (int r = 0; r < 4; ++r) {
          const int row = mt * 128 + wm * 64 + i * 16 + (lane >> 4) * 4 + r;
          const float g = acc[i][2 * jp][r], u = acc[i][2 * jp + 1][r];
          act[(size_t)row * DFF + col] = f2bf(siluf_(g) * u);
        }
      }
  }
}

__device__ __forceinline__ void phase_gemm_f32(const u16* A, int lda, const u16* Bt, int ldb, int K, int MT, int NT,
                               float* out, int ldo, u16* smem) {
  const int lane = TIDX & 63, wave = TIDX >> 6;
  const int wm = wave >> 1, wn = wave & 1;
  const int bid_ = BIDX;
  for (int lt = bid_ >> 3; lt < (MT >> 3) * NT; lt += (gridDim.x >> 3)) {
    const int rest_ = lt >> 3;
    const int nt = rest_ % NT, mt = (bid_ & 7) * (MT >> 3) + (rest_ / NT) * 8 + (lt & 7);
    f32x4 acc[4][4];
    ZERO_ACC(acc);
    gemm_acc<4>(acc, A, lda, Bt, ldb, 0, K, mt * 128, nt * 128, smem);
#pragma unroll
    for (int i = 0; i < 4; ++i)
#pragma unroll
      for (int j = 0; j < 4; ++j) {
        const int col = nt * 128 + wn * 64 + j * 16 + (lane & 15);
#pragma unroll
        for (int r = 0; r < 4; ++r) {
          const int row = mt * 128 + wm * 64 + i * 16 + (lane >> 4) * 4 + r;
          out[(size_t)row * ldo + col] = acc[i][j][r];
        }
      }
  }
}

__device__ __forceinline__ void phase_win(const Params& p, int part, u16* smem) {
  const u16* H = (const u16*)(p.ws + OFF_H);
  const u16* W = (const u16*)(p.ws + W_IN);
  const int lane = TIDX & 63, wave = TIDX >> 6;
  const int wm = wave >> 1, wn = wave & 1;
  const int NT = part ? 40 : 23;
  const int bid_ = BIDX;
  for (int lt = bid_ >> 3; lt < 16 * NT; lt += (gridDim.x >> 3)) {
    const int rest_ = lt >> 3;
    const int nl = rest_ % NT, mt = (bid_ & 7) * 16 + (rest_ / NT) * 8 + (lt & 7);
    int ct;
    if (part == 0) ct = (nl < 12) ? nl : (28 + nl - 12);
    else ct = (nl < 16) ? (12 + nl) : (39 + nl - 16);
    u16* dst; int ld, cb;
    if (ct < 12) { dst = (u16*)(p.ws + OFF_UCONV); ld = 1536; cb = ct * 128; }
    else if (ct < 28) { dst = (u16*)(p.ws + OFF_UHG); ld = 2048; cb = (ct - 12) * 128; }
    else if (ct < 39) { dst = (u16*)(p.ws + OFF_UNSA); ld = 1408; cb = (ct - 28) * 128; }
    else { dst = (u16*)(p.ws + OFF_UMG); ld = 3072; cb = (ct - 39) * 128; }
    f32x4 acc[4][4];
    ZERO_ACC(acc);
    gemm_acc<4>(acc, H, 1024, W, 1024, 0, 1024, mt * 128, ct * 128, smem);
#pragma unroll
    for (int i = 0; i < 4; ++i)
#pragma unroll
      for (int j = 0; j < 4; ++j) {
        const int col = cb + wn * 64 + j * 16 + (lane & 15);
#pragma unroll
        for (int r = 0; r < 4; ++r) {
          const int row = mt * 128 + wm * 64 + i * 16 + (lane >> 4) * 4 + r;
          dst[(size_t)row * ld + col] = f2bf(acc[i][j][r]);
        }
      }
  }
}

__device__ __forceinline__ void phase_cmp1(const Params& p, u16* smem) {
  const int lane = TIDX & 63, wave = TIDX >> 6;
  const int wm = wave >> 1, wn = wave & 1;
  for (int it = BIDX; it < 64; it += gridDim.x) {
    const int m = it >> 5, mt = (it >> 1) & 15, nt = it & 1;
    const u16* A = (const u16*)(p.ws + OFF_CMPA) + (size_t)m * 2048 * 2048;
    const u16* Bt = (const u16*)(p.ws + W_C1) + (size_t)m * 256 * 2048;
    u16* Hc = (u16*)(p.ws + OFF_HC) + (size_t)m * 2048 * 256;
    f32x4 acc[4][4];
    ZERO_ACC(acc);
    gemm_acc<4>(acc, A, 2048, Bt, 2048, 0, 2048, mt * 128, nt * 128, smem);
#pragma unroll
    for (int i = 0; i < 4; ++i)
#pragma unroll
      for (int j = 0; j < 4; ++j) {
        const int col = nt * 128 + wn * 64 + j * 16 + (lane & 15);
#pragma unroll
        for (int r = 0; r < 4; ++r) {
          const int row = mt * 128 + wm * 64 + i * 16 + (lane >> 4) * 4 + r;
          const float x = acc[i][j][r];
          const float u = 0.7978845608028654f * (x + 0.044715f * x * x * x);
          Hc[(size_t)row * 256 + col] = f2bf(x * sigmoidf_(2.0f * u));
        }
      }
  }
}

__device__ __forceinline__ void phase_cmp2(const Params& p, int l) {
  const u16* Hc = (const u16*)(p.ws + OFF_HC);
  u16* kcmp = (u16*)(p.ws + OFF_KCMP);
  u16* vcmpT = (u16*)(p.ws + OFF_VCMP);
  const size_t nth = (size_t)gridDim.x * blockDim.x;
  for (size_t e = (size_t)BIDX * blockDim.x + TIDX; e < (size_t)2 * 2048 * 64; e += nth) {
    const int m = (int)(e >> 17);
    const int rem = (int)(e & 131071);
    const int row = rem >> 6, d = rem & 63;
    if (row < 2044) {
      const u16* hr = Hc + ((size_t)m * 2048 + row) * 256;
      const float* w2 = p.cw2 + (size_t)(l * 2 + m) * 256 * 64 + d;
      float acc = 0.f;
#pragma unroll 8
      for (int k = 0; k < 256; ++k) acc += bf2f(hr[k]) * w2[k * 64];
      const int b = row / 1022, r2 = row % 1022;
      const int n = r2 >> 1, kh = r2 & 1;
      if (m == 0) kcmp[((size_t)(b * 2 + kh) * 512 + n) * 64 + d] = f2bf(acc);
      else vcmpT[((size_t)(b * 2 + kh) * 64 + d) * 512 + n] = f2bf(acc);
    } else {
      const int bk = row - 2044;
      if (m == 0) kcmp[((size_t)bk * 512 + 511) * 64 + d] = 0;
      else vcmpT[((size_t)bk * 64 + d) * 512 + 511] = 0;
    }
  }
}

__device__ __forceinline__ void phase_merge(const Params& p, u16* smem) {
  const u16* Y = (const u16*)(p.ws + OFF_Y);
  const u16* W = (const u16*)(p.ws + W_BR);
  const u16* MG = (const u16*)(p.ws + OFF_UMG);
  u16* outp = (u16*)(p.ws + OFF_H);
  const int lane = TIDX & 63, wave = TIDX >> 6;
  const int wm = wave >> 1, wn = wave & 1;
  const int bid_ = BIDX;
  for (int lt = bid_ >> 3; lt < 16 * 16; lt += (gridDim.x >> 3)) {
    const int rest_ = lt >> 3;
    const int nt = rest_ & 15, mt = (bid_ & 7) * 16 + (rest_ >> 4) * 8 + (lt & 7);
    f32x4 tot[4][2];
#pragma unroll
    for (int i = 0; i < 4; ++i)
#pragma unroll
      for (int j = 0; j < 2; ++j) tot[i][j] = (f32x4){0.f, 0.f, 0.f, 0.f};
    for (int n = 0; n < 3; ++n) {
      f32x4 acc[4][2];
#pragma unroll
      for (int i = 0; i < 4; ++i)
#pragma unroll
        for (int j = 0; j < 2; ++j) acc[i][j] = (f32x4){0.f, 0.f, 0.f, 0.f};
      gemm_acc<2>(acc, Y, 1536, W, 1536, n * 512, n * 512 + 512, mt * 128, nt * 64, smem);
#pragma unroll
      for (int i = 0; i < 4; ++i)
#pragma unroll
        for (int j = 0; j < 2; ++j) {
          const int col = nt * 64 + wn * 32 + j * 16 + (lane & 15);
#pragma unroll
          for (int r = 0; r < 4; ++r) {
            const int row = mt * 128 + wm * 64 + i * 16 + (lane >> 4) * 4 + r;
            const float g = sigmoidf_(bf2f(MG[(size_t)row * 3072 + n * 1024 + col]));
            tot[i][j][r] += g * acc[i][j][r];
          }
        }
    }
#pragma unroll
    for (int i = 0; i < 4; ++i)
#pragma unroll
      for (int j = 0; j < 2; ++j) {
        const int col = nt * 64 + wn * 32 + j * 16 + (lane & 15);
#pragma unroll
        for (int r = 0; r < 4; ++r) {
          const int row = mt * 128 + wm * 64 + i * 16 + (lane >> 4) * 4 + r;
          outp[(size_t)row * 1024 + col] = f2bf(tot[i][j][r]);
        }
      }
  }
}

__device__ __forceinline__ void phase_prep(const Params& p, int l) {
  const u16* Uc = (const u16*)(p.ws + OFF_UCONV);
  const u16* Un = (const u16*)(p.ws + OFF_UNSA);
  u16* Y = (u16*)(p.ws + OFF_Y);
  u16* qr = (u16*)(p.ws + OFF_QR);
  u16* KR = (u16*)(p.ws + OFF_KR);
  u16* VT = (u16*)(p.ws + OFF_VT);
  u16* CA = (u16*)(p.ws + OFF_CMPA);
  float* gates = (float*)(p.ws + OFF_GATES);
  const float2* cs = (const float2*)(p.ws + OFF_ROPE);
  const int tid = TIDX;
  const size_t nth = (size_t)gridDim.x * blockDim.x;
  const size_t gt = (size_t)BIDX * blockDim.x + tid;
  for (size_t e = gt; e < (size_t)T_TOK * 512; e += nth) {
    const int t = (int)(e >> 9), c = (int)(e & 511);
    const int s = t & (SEQL - 1);
    const float w0 = p.convw[(l * 3 + 0) * 512 + c], w1 = p.convw[(l * 3 + 1) * 512 + c], w2 = p.convw[(l * 3 + 2) * 512 + c];
    const u16* r2 = Uc + (size_t)t * 1536;
    const float v2 = bf2f(r2[512 + c]) * bf2f(r2[1024 + c]);
    float v1 = 0.f, v0 = 0.f;
    if (s >= 1) { const u16* r1 = r2 - 1536; v1 = bf2f(r1[512 + c]) * bf2f(r1[1024 + c]); }
    if (s >= 2) { const u16* r0 = r2 - 3072; v0 = bf2f(r0[512 + c]) * bf2f(r0[1024 + c]); }
    Y[(size_t)t * 1536 + c] = f2bf(bf2f(r2[c]) * (w0 * v0 + w1 * v1 + w2 * v2));
  }
  for (size_t e = gt; e < (size_t)2 * 4 * 2048; e += nth) {
    const int m = (int)(e >> 13), rem = (int)(e & 8191);
    CA[((size_t)m * 2048 + 2044) * 2048 + rem] = 0;
  }
  const float* pek = p.pe + (size_t)(l * 2 + 0) * 2048;
  const float* pev = p.pe + (size_t)(l * 2 + 1) * 2048;
  for (int it = BIDX; it < 1024; it += gridDim.x) {
    const int b = it >> 9, ch = it & 511;
    const int s0 = ch * 16, t0 = b * SEQL + s0;
    for (int idx = tid; idx < 4096; idx += 256) {
      const int i = idx >> 8, pr = idx & 255;
      const int head = pr >> 5, d = pr & 31;
      const int t = t0 + i;
      const float2 c_s = cs[(size_t)t * 32 + d];
      const float x1 = bf2f(Un[(size_t)t * 1408 + head * 64 + d]);
      const float x2 = bf2f(Un[(size_t)t * 1408 + head * 64 + 32 + d]);
      qr[(size_t)t * 512 + head * 64 + d] = f2bf(x1 * c_s.x - x2 * c_s.y);
      qr[(size_t)t * 512 + head * 64 + 32 + d] = f2bf(x2 * c_s.x + x1 * c_s.y);
    }
    for (int idx = tid; idx < 3072; idx += 256) {
      const int i = idx / 192, rem = idx % 192;
      const int m = rem >> 6, hp = rem & 63;
      const int kh = hp >> 5, d = hp & 31;
      const int t = t0 + i;
      const float2 c_s = cs[(size_t)t * 32 + d];
      const int col = 512 + m * 256 + kh * 64;
      const float x1 = bf2f(Un[(size_t)t * 1408 + col + d]);
      const float x2 = bf2f(Un[(size_t)t * 1408 + col + 32 + d]);
      const float o1 = x1 * c_s.x - x2 * c_s.y, o2 = x2 * c_s.x + x1 * c_s.y;
      u16* kd = KR + (size_t)m * 2097152 + ((size_t)(b * 2 + kh) * SEQL + s0 + i) * 64;
      kd[d] = f2bf(o1); kd[32 + d] = f2bf(o2);
      if (m == 0) {
        if (ch <= 510) {
          u16* a = CA + ((size_t)((b * 511 + ch) * 2 + kh)) * 2048 + i * 64;
          a[d] = f2bf(o1 + pek[i * 64 + d]); a[32 + d] = f2bf(o2 + pek[i * 64 + 32 + d]);
        }
        if (ch >= 1) {
          u16* a = CA + ((size_t)((b * 511 + ch - 1) * 2 + kh)) * 2048 + (16 + i) * 64;
          a[d] = f2bf(o1 + pek[(16 + i) * 64 + d]); a[32 + d] = f2bf(o2 + pek[(16 + i) * 64 + 32 + d]);
        }
      }
    }
    for (int idx = tid; idx < 2048; idx += 256) {
      const int i = idx >> 7, cc = idx & 127;
      const int kh = cc >> 6, d = cc & 63;
      const int t = t0 + i;
      const float v = bf2f(Un[(size_t)t * 1408 + 640 + cc]);
      u16* CAv = CA + (size_t)2048 * 2048;
      if (ch <= 510) CAv[((size_t)((b * 511 + ch) * 2 + kh)) * 2048 + i * 64 + d] = f2bf(v + pev[i * 64 + d]);
      if (ch >= 1) CAv[((size_t)((b * 511 + ch - 1) * 2 + kh)) * 2048 + (16 + i) * 64 + d] = f2bf(v + pev[(16 + i) * 64 + d]);
    }
    for (int idx = tid; idx < 4096; idx += 256) {
      const int i = idx & 15, cc = idx >> 4;
      const int m = cc >> 7, c2 = cc & 127;
      const int kh = c2 >> 6, d = c2 & 63;
      VT[(size_t)m * 2097152 + ((size_t)(b * 2 + kh) * 64 + d) * SEQL + s0 + i] =
          Un[(size_t)(t0 + i) * 1408 + 896 + m * 256 + c2];
    }
    for (int idx = tid; idx < 384; idx += 256) {
      const int i = idx / 24, gI = idx % 24;
      gates[(size_t)(t0 + i) * 24 + gI] = sigmoidf_(bf2f(Un[(size_t)(t0 + i) * 1408 + 1280 + gI]));
    }
  }
}

template <class MaskF>
__device__ __forceinline__ void qk_tile32(const u16* __restrict__ Kp, const bf16x8 (&qf)[2], float scale,
                                          MaskF maskf, int lane, f32x4 (&st)[2]) {
  const int c16 = lane & 15, q = lane >> 4;
#pragma unroll
  for (int kt = 0; kt < 2; ++kt) {
    const u16* kr = Kp + (kt * 16 + c16) * 64 + q * 8;
    const bf16x8 k0 = *(const bf16x8*)(kr);
    const bf16x8 k1 = *(const bf16x8*)(kr + 32);
    f32x4 z = {0.f, 0.f, 0.f, 0.f};
    z = mfma16(k0, qf[0], z);
    z = mfma16(k1, qf[1], z);
#pragma unroll
    for (int r = 0; r < 4; ++r) st[kt][r] = maskf(kt * 16 + q * 4 + r) ? z[r] * scale : -1e30f;
  }
}

__device__ __forceinline__ void pv_tile32(const u16* __restrict__ Vp, int ldv, const f32x4 (&pr)[2], int lane,
                                          f32x4 (&o)[4]) {
  const int c16 = lane & 15, q = lane >> 4;
  bf16x8 pb;
#pragma unroll
  for (int j = 0; j < 4; ++j) { pb[j] = (short)f2bf(pr[0][j]); pb[4 + j] = (short)f2bf(pr[1][j]); }
#pragma unroll
  for (int dt = 0; dt < 4; ++dt) {
    const u16* vr = Vp + (size_t)(dt * 16 + c16) * ldv + q * 4;
    const bf16x4 va = *(const bf16x4*)(vr);
    const bf16x4 vb = *(const bf16x4*)(vr + 16);
    bf16x8 vf;
    vf[0] = va[0]; vf[1] = va[1]; vf[2] = va[2]; vf[3] = va[3];
    vf[4] = vb[0]; vf[5] = vb[1]; vf[6] = vb[2]; vf[7] = vb[3];
    o[dt] = mfma16(vf, pb, o[dt]);
  }
}

template <class MaskF>
__device__ __forceinline__ void attn_tile32(const u16* __restrict__ Kp, const u16* __restrict__ Vp, int ldv,
                                            const bf16x8 (&qf)[2], float scale, MaskF maskf, int lane,
                                            float& m, float& lsum, f32x4 (&o)[4]) {
  f32x4 st[2];
  qk_tile32(Kp, qf, scale, maskf, lane, st);
  float mx = -1e30f;
#pragma unroll
  for (int kt = 0; kt < 2; ++kt)
#pragma unroll
    for (int r = 0; r < 4; ++r) mx = fmaxf(mx, st[kt][r]);
  mx = fmaxf(mx, __shfl_xor(mx, 16));
  mx = fmaxf(mx, __shfl_xor(mx, 32));
  const float mnew = fmaxf(m, mx);
  const float alpha = __expf(m - mnew);
  float ps = 0.f;
#pragma unroll
  for (int kt = 0; kt < 2; ++kt)
#pragma unroll
    for (int r = 0; r < 4; ++r) {
      const float pv = (st[kt][r] > -1e29f) ? __expf(st[kt][r] - mnew) : 0.f;
      st[kt][r] = pv;
      ps += pv;
    }
  lsum = lsum * alpha + ps;
  m = mnew;
#pragma unroll
  for (int dt = 0; dt < 4; ++dt) o[dt] *= alpha;
  pv_tile32(Vp, ldv, st, lane, o);
}

__device__ __forceinline__ void phase_cmp_attn(const Params& p) {
  const u16* qr = (const u16*)(p.ws + OFF_QR);
  const u16* kcmp = (const u16*)(p.ws + OFF_KCMP);
  const u16* vcmpT = (const u16*)(p.ws + OFF_VCMP);
  u16* ocmp = (u16*)(p.ws + OFF_OCMP);
  float* imp = (float*)(p.ws + OFF_IMP);
  const int lane = TIDX & 63, wave = TIDX >> 6;
  const int c16 = lane & 15, q = lane >> 4;
  const int tq = c16 >> 2, g = c16 & 3;
  const float scale = 0.125f;
  for (int it = BIDX; it < 2048; it += gridDim.x) {
    const int b = it >> 10, kh = (it >> 9) & 1, grp = it & 511;
    const int s0 = (grp * 4 + wave) * 4;
    const int s = s0 + tq;
    const int t = b * SEQL + s;
    const int head = kh * 4 + g;
    bf16x8 qf[2];
    qf[0] = *(const bf16x8*)(qr + (size_t)t * 512 + head * 64 + q * 8);
    qf[1] = *(const bf16x8*)(qr + (size_t)t * 512 + head * 64 + 32 + q * 8);
    const int nvalid = (s >= 31) ? (((s - 31) >> 4) + 1) : 0;
    const int slast = s0 + 3;
    const int nvmax = (slast >= 31) ? (((slast - 31) >> 4) + 1) : 0;
    const int ntile = (nvmax + 31) >> 5;
    const u16* Kb = kcmp + (size_t)(b * 2 + kh) * 512 * 64;
    const u16* Vb = vcmpT + (size_t)(b * 2 + kh) * 64 * 512;
    float m = -1e30f, lsum = 0.f;
    for (int tl = 0; tl < ntile; ++tl) {
      const int n0 = tl * 32;
      f32x4 st[2];
      qk_tile32(Kb + (size_t)n0 * 64, qf, scale, [&](int ko) { return (n0 + ko) < nvalid; }, lane, st);
      float mx = -1e30f;
#pragma unroll
      for (int kt = 0; kt < 2; ++kt)
#pragma unroll
        for (int r = 0; r < 4; ++r) mx = fmaxf(mx, st[kt][r]);
      mx = fmaxf(mx, __shfl_xor(mx, 16));
      mx = fmaxf(mx, __shfl_xor(mx, 32));
      const float mnew = fmaxf(m, mx);
      float ps = 0.f;
#pragma unroll
      for (int kt = 0; kt < 2; ++kt)
#pragma unroll
        for (int r = 0; r < 4; ++r) ps += (st[kt][r] > -1e29f) ? __expf(st[kt][r] - mnew) : 0.f;
      lsum = lsum * __expf(m - mnew) + ps;
      m = mnew;
    }
    lsum += __shfl_xor(lsum, 16);
    lsum += __shfl_xor(lsum, 32);
    const float invl = (lsum > 0.f) ? 1.0f / lsum : 0.f;
    f32x4 o[4];
#pragma unroll
    for (int dt = 0; dt < 4; ++dt) o[dt] = (f32x4){0.f, 0.f, 0.f, 0.f};
    float carry = 0.f;
    float* impr = imp + ((size_t)(b * 2 + kh) * SEQL + s) * 128;
    for (int tl = 0; tl < ntile; ++tl) {
      const int n0 = tl * 32;
      f32x4 st[2];
      qk_tile32(Kb + (size_t)n0 * 64, qf, scale, [&](int ko) { return (n0 + ko) < nvalid; }, lane, st);
#pragma unroll
      for (int kt = 0; kt < 2; ++kt)
#pragma unroll
        for (int r = 0; r < 4; ++r) st[kt][r] = (st[kt][r] > -1e29f) ? __expf(st[kt][r] - m) * invl : 0.f;
      pv_tile32(Vb + n0, 512, st, lane, o);
      float main0 = 0.f, main1 = 0.f, e0 = 0.f, e1 = 0.f;
#pragma unroll
      for (int r = 0; r < 4; ++r) {
        float a0 = st[0][r], a1 = st[1][r];
        a0 += __shfl_xor(a0, 1); a0 += __shfl_xor(a0, 2);
        a1 += __shfl_xor(a1, 1); a1 += __shfl_xor(a1, 2);
        main0 += a0; main1 += a1;
        if (r == 3) { e0 = a0; e1 = a1; }
      }
      const float e0_up = __shfl(e0, (lane + 48) & 63);
      const float e1_up = __shfl(e1, (lane + 48) & 63);
      const float pe0 = (q > 0) ? e0_up : carry;
      const float pe1 = (q > 0) ? e1_up : e0_up;
      carry = e1_up;
      if (g == 0) {
        impr[(n0 >> 2) + q] = main0 + pe0;
        impr[(n0 >> 2) + 4 + q] = main1 + pe1;
      }
    }
#pragma unroll
    for (int dt = 0; dt < 4; ++dt) {
      uint2 w;
      w.x = (u32)f2bf(o[dt][0]) | ((u32)f2bf(o[dt][1]) << 16);
      w.y = (u32)f2bf(o[dt][2]) | ((u32)f2bf(o[dt][3]) << 16);
      *(uint2*)(ocmp + (size_t)t * 512 + head * 64 + dt * 16 + q * 4) = w;
    }
  }
}

__device__ __forceinline__ void phase_slc_win(const Params& p) {
  const u16* qr = (const u16*)(p.ws + OFF_QR);
  const u16* KS = (const u16*)(p.ws + OFF_KR) + (size_t)1 * 2097152;
  const u16* KW = (const u16*)(p.ws + OFF_KR) + (size_t)2 * 2097152;
  const u16* VS = (const u16*)(p.ws + OFF_VT);
  const u16* VW = (const u16*)(p.ws + OFF_VT) + (size_t)2097152;
  const u16* ocmp = (const u16*)(p.ws + OFF_OCMP);
  const float* imp = (const float*)(p.ws + OFF_IMP);
  const float* gates = (const float*)(p.ws + OFF_GATES);
  u16* Y = (u16*)(p.ws + OFF_Y);
  const int lane = TIDX & 63, wave = TIDX >> 6;
  const int c16 = lane & 15, q = lane >> 4;
  const int tq = c16 >> 2, g = c16 & 3;
  const float scale = 0.125f;
  for (int it = BIDX; it < 2048; it += gridDim.x) {
    const int b = it >> 10, kh = (it >> 9) & 1, grp = it & 511;
    const int s0 = (grp * 4 + wave) * 4;
    const int s = s0 + tq;
    const int t = b * SEQL + s;
    const int head = kh * 4 + g;
    bf16x8 qf[2];
    qf[0] = *(const bf16x8*)(qr + (size_t)t * 512 + head * 64 + q * 8);
    qf[1] = *(const bf16x8*)(qr + (size_t)t * 512 + head * 64 + 32 + q * 8);
    const size_t kvb = (size_t)(b * 2 + kh);
    const u16* Kw = KW + kvb * SEQL * 64;
    const u16* Vw = VW + kvb * 64 * SEQL;
    const u16* Ks = KS + kvb * SEQL * 64;
    const u16* Vs = VS + kvb * 64 * SEQL;
    float mw = -1e30f, lw = 0.f;
    f32x4 ow[4];
#pragma unroll
    for (int dt = 0; dt < 4; ++dt) ow[dt] = (f32x4){0.f, 0.f, 0.f, 0.f};
    {
      int lo = s0 - 511; if (lo < 0) lo = 0;
      lo &= ~31;
      for (int k0 = lo; k0 <= s0 + 3; k0 += 32) {
        attn_tile32(Kw + (size_t)k0 * 64, Vw + k0, SEQL, qf, scale,
                    [&](int ko) { const int ks = k0 + ko; return (ks <= s) && (ks + 512 > s); }, lane, mw, lw, ow);
      }
    }
    float ms = -1e30f, ls = 0.f;
    f32x4 os[4];
#pragma unroll
    for (int dt = 0; dt < 4; ++dt) os[dt] = (f32x4){0.f, 0.f, 0.f, 0.f};
    const int cur = s0 >> 6;
    const int nforced = (cur < 2 ? cur : 2) + 1;
    const int ncand = cur - 2;
    const int nsel = ncand <= 0 ? 0 : (ncand < 13 ? ncand : 13);
    for (int tk = -1; tk < 4; ++tk) {
      const int nblk = (tk < 0) ? nforced : nsel;
      const bool mine = (tk < 0) || (tq == tk);
      float v0 = -1.f, v1 = -1.f;
      if (tk >= 0 && ncand > 13) {
        const float* ir = imp + (kvb * SEQL + s0 + tk) * 128;
        v0 = (lane >= 1 && lane <= ncand) ? ir[lane] : -1.f;
        v1 = (lane + 64 <= ncand) ? ir[lane + 64] : -1.f;
      }
      for (int bi = 0; bi < nblk; ++bi) {
        int j;
        if (tk < 0) j = (bi == 0) ? 0 : (cur - (nforced - 1 - bi));
        else if (ncand <= 13) j = 1 + bi;
        else {
          float bv; int bx;
          if (v0 >= v1) { bv = v0; bx = lane; } else { bv = v1; bx = lane + 64; }
#pragma unroll
          for (int off = 32; off; off >>= 1) {
            const float ov = __shfl_xor(bv, off);
            const int oi = __shfl_xor(bx, off);
            if (ov > bv || (ov == bv && oi < bx)) { bv = ov; bx = oi; }
          }
          j = __builtin_amdgcn_readfirstlane(bx);
          if (j == lane) v0 = -2.f;
          if (j == lane + 64) v1 = -2.f;
        }
        for (int hh = 0; hh < 2; ++hh) {
          const int k0 = j * 64 + hh * 32;
          attn_tile32(Ks + (size_t)k0 * 64, Vs + k0, SEQL, qf, scale,
                      [&](int ko) { return mine && ((k0 + ko) <= s); }, lane, ms, ls, os);
        }
      }
    }
    lw += __shfl_xor(lw, 16); lw += __shfl_xor(lw, 32);
    ls += __shfl_xor(ls, 16); ls += __shfl_xor(ls, 32);
    const float iw = (lw > 0.f) ? 1.0f / lw : 0.f;
    const float is = (ls > 0.f) ? 1.0f / ls : 0.f;
    const float g0 = gates[(size_t)t * 24 + kh * 12 + g * 3 + 0];
    const float g1 = gates[(size_t)t * 24 + kh * 12 + g * 3 + 1] * is;
    const float g2 = gates[(size_t)t * 24 + kh * 12 + g * 3 + 2] * iw;
#pragma unroll
    for (int dt = 0; dt < 4; ++dt) {
      const uint2 oc = *(const uint2*)(ocmp + (size_t)t * 512 + head * 64 + dt * 16 + q * 4);
      const float c0 = bf2f((u16)(oc.x & 0xffff)), c1 = bf2f((u16)(oc.x >> 16));
      const float c2 = bf2f((u16)(oc.y & 0xffff)), c3 = bf2f((u16)(oc.y >> 16));
      const float y0 = g0 * c0 + g1 * os[dt][0] + g2 * ow[dt][0];
      const float y1 = g0 * c1 + g1 * os[dt][1] + g2 * ow[dt][1];
      const float y2 = g0 * c2 + g1 * os[dt][2] + g2 * ow[dt][2];
      const float y3 = g0 * c3 + g1 * os[dt][3] + g2 * ow[dt][3];
      uint2 w;
      w.x = (u32)f2bf(y0) | ((u32)f2bf(y1) << 16);
      w.y = (u32)f2bf(y2) | ((u32)f2bf(y3) << 16);
      *(uint2*)(Y + (size_t)t * 1536 + 1024 + head * 64 + dt * 16 + q * 4) = w;
    }
  }
}

#define BCS 132
__device__ __forceinline__ float hg_lb(const Params& p, int l, int ch) {
  if (l == 0) return 0.f;
  const float a0 = p.lb_logits[ch], a1 = p.lb_logits[512 + ch], a2 = p.lb_logits[1024 + ch], a3 = p.lb_logits[1536 + ch];
  const float mx = fmaxf(fmaxf(a0, a1), fmaxf(a2, a3));
  const float e0 = __expf(a0 - mx), e1 = __expf(a1 - mx), e2 = __expf(a2 - mx), e3 = __expf(a3 - mx);
  const float inv = 1.0f / (e0 + e1 + e2 + e3);
  float sacc = e1;
  if (l >= 2) sacc += e2;
  if (l >= 3) sacc += e3;
  return sacc * inv;
}

__device__ __forceinline__ void hg_bcum(const Params& p, int l, const u16* Uhg, int t0, int h, float* bc, float* lbs) {
  const int tid = TIDX;
  const int d = tid & 127;
  const float lbv = hg_lb(p, l, h * 128 + d);
  if (tid < 128) lbs[d] = lbv;
  for (int idx = tid; idx < 64 * 128; idx += 256) {
    const int s = idx >> 7;
    const float z = bf2f(Uhg[(size_t)(t0 + s) * 2048 + 512 + h * 128 + d]);
    const float f = lbv + (1.0f - lbv) * sigmoidf_(z);
    bc[s * BCS + d] = __logf(fmaxf(f, 1e-30f));
  }
  __syncthreads();
  if (tid < 128) {
    float run = 0.f;
    for (int s = 0; s < 64; ++s) { run += bc[s * BCS + d]; bc[s * BCS + d] = run; }
  }
  __syncthreads();
}

__device__ __forceinline__ void phase_hg_local(const Params& p, int l, char* smem) {
  const u16* Uhg = (const u16*)(p.ws + OFF_UHG);
  float* states = (float*)(p.ws + OFF_STATES);
  float* gdec = (float*)(p.ws + OFF_GDEC);
  float* bc = (float*)smem;
  float* lbs = (float*)(smem + 33792);
  u16* KT = (u16*)(smem + 33792 + 512);
  u16* VTs = (u16*)(smem + 33792 + 512 + 18432);
  const int tid = TIDX, lane = tid & 63, wave = tid >> 6;
  const int c16 = lane & 15, q = lane >> 4;
  for (int it = BIDX; it < 1024; it += gridDim.x) {
    const int b = it >> 9, h = (it >> 7) & 3, c = it & 127;
    const int t0 = b * SEQL + c * 64;
    hg_bcum(p, l, Uhg, t0, h, bc, lbs);
    {
      const int d = tid & 127;
      const float lbv = lbs[d];
      const float bl = bc[63 * BCS + d];
      for (int idx = tid; idx < 64 * 128; idx += 256) {
        const int s = idx >> 7;
        const float z = bf2f(Uhg[(size_t)(t0 + s) * 2048 + 512 + h * 128 + d]);
        const float kk = (1.0f - lbv) * sigmoidf_(-z);
        KT[d * 72 + s] = f2bf(kk * __expf(bl - bc[s * BCS + d]));
        VTs[d * 72 + s] = Uhg[(size_t)(t0 + s) * 2048 + 1024 + h * 128 + d];
      }
      if (tid < 128) gdec[(size_t)it * 128 + d] = __expf(bl);
    }
    __syncthreads();
    f32x4 acc[2][8];
#pragma unroll
    for (int i = 0; i < 2; ++i)
#pragma unroll
      for (int j = 0; j < 8; ++j) acc[i][j] = (f32x4){0.f, 0.f, 0.f, 0.f};
#pragma unroll
    for (int ks = 0; ks < 2; ++ks) {
      bf16x8 af[2];
#pragma unroll
      for (int i = 0; i < 2; ++i) af[i] = *(const bf16x8*)(VTs + (wave * 32 + i * 16 + c16) * 72 + ks * 32 + q * 8);
#pragma unroll
      for (int j = 0; j < 8; ++j) {
        const bf16x8 bfr = *(const bf16x8*)(KT + (j * 16 + c16) * 72 + ks * 32 + q * 8);
#pragma unroll
        for (int i = 0; i < 2; ++i) acc[i][j] = mfma16(af[i], bfr, acc[i][j]);
      }
    }
    float* st = states + (size_t)it * 16384;
#pragma unroll
    for (int i = 0; i < 2; ++i)
#pragma unroll
      for (int j = 0; j < 8; ++j)
#pragma unroll
        for (int r = 0; r < 4; ++r) st[(wave * 32 + i * 16 + q * 4 + r) * 128 + j * 16 + c16] = acc[i][j][r];
    __syncthreads();
  }
}

__device__ __forceinline__ void phase_hg_scan(const Params& p) {
  float* __restrict__ states = (float*)(p.ws + OFF_STATES);
  const float* __restrict__ gdec = (const float*)(p.ws + OFF_GDEC);
  const size_t nth = (size_t)gridDim.x * blockDim.x;
  for (size_t e = (size_t)BIDX * blockDim.x + TIDX; e < (size_t)8 * 16384; e += nth) {
    const int bh = (int)(e >> 14), vd = (int)(e & 16383), d = vd & 127;
    float S = 0.f;
    for (int c0 = 0; c0 < 128; c0 += 16) {
      float Lv[16], gv[16];
#pragma unroll
      for (int i = 0; i < 16; ++i) {
        const size_t item = (size_t)bh * 128 + c0 + i;
        Lv[i] = states[item * 16384 + vd];
        gv[i] = gdec[item * 128 + d];
      }
#pragma unroll
      for (int i = 0; i < 16; ++i) {
        const size_t item = (size_t)bh * 128 + c0 + i;
        S = gv[i] * S + Lv[i];
        states[item * 16384 + vd] = S;
      }
    }
  }
}

__device__ __forceinline__ void phase_hg_out(const Params& p, int l, char* smem) {
  const u16* Uhg = (const u16*)(p.ws + OFF_UHG);
  const float* states = (const float*)(p.ws + OFF_STATES);
  u16* Y = (u16*)(p.ws + OFF_Y);
  float* bc = (float*)smem;
  float* lbs = (float*)(smem + 33792);
  u16* VTs = (u16*)(smem + 33792 + 512);
  const int tid = TIDX, lane = tid & 63, wave = tid >> 6;
  const int c16 = lane & 15, q = lane >> 4;
  for (int it = BIDX; it < 1024; it += gridDim.x) {
    const int b = it >> 9, h = (it >> 7) & 3, c = it & 127;
    const int t0 = b * SEQL + c * 64;
    hg_bcum(p, l, Uhg, t0, h, bc, lbs);
    {
      const int d = tid & 127;
      for (int idx = tid; idx < 64 * 128; idx += 256) {
        const int s = idx >> 7;
        VTs[d * 72 + s] = Uhg[(size_t)(t0 + s) * 2048 + 1024 + h * 128 + d];
      }
    }
    __syncthreads();
    const int tt = wave * 16 + c16;
    const bool hi = (wave >= 2);
    bf16x8 Qt[4], Qh[4];
#pragma unroll
    for (int ks = 0; ks < 4; ++ks) {
      const int d0 = ks * 32 + q * 8;
      const bf16x8 qraw = *(const bf16x8*)(Uhg + (size_t)(t0 + tt) * 2048 + h * 128 + d0);
#pragma unroll
      for (int j = 0; j < 8; ++j) {
        const float qv = siluf_(bf2f((u16)qraw[j]));
        const float bt = bc[tt * BCS + d0 + j];
        const float rr = hi ? bc[31 * BCS + d0 + j] : 0.f;
        Qt[ks][j] = (short)f2bf(qv * __expf(bt - rr));
        Qh[ks][j] = (short)f2bf(qv * __expf(bt));
      }
    }
    f32x4 at[4];
#pragma unroll
    for (int st = 0; st < 4; ++st) {
      at[st] = (f32x4){0.f, 0.f, 0.f, 0.f};
      if (st <= wave) {
        f32x4 a = {0.f, 0.f, 0.f, 0.f};
        const int srow = st * 16 + c16;
#pragma unroll
        for (int ks = 0; ks < 4; ++ks) {
          const int d0 = ks * 32 + q * 8;
          const bf16x8 zraw = *(const bf16x8*)(Uhg + (size_t)(t0 + srow) * 2048 + 512 + h * 128 + d0);
          bf16x8 kf;
#pragma unroll
          for (int j = 0; j < 8; ++j) {
            const float z = bf2f((u16)zraw[j]);
            const float kk = (1.0f - lbs[d0 + j]) * sigmoidf_(-z);
            const float rr = hi ? bc[31 * BCS + d0 + j] : 0.f;
            const float ex = fminf(rr - bc[srow * BCS + d0 + j], 80.f);
            kf[j] = (short)f2bf(kk * __expf(ex));
          }
          a = mfma16(kf, Qt[ks], a);
        }
#pragma unroll
        for (int r = 0; r < 4; ++r) at[st][r] = ((st * 16 + q * 4 + r) <= tt) ? a[r] : 0.f;
      }
    }
    bf16x8 pb[2];
#pragma unroll
    for (int sp = 0; sp < 2; ++sp)
#pragma unroll
      for (int j = 0; j < 4; ++j) {
        pb[sp][j] = (short)f2bf(at[2 * sp][j]);
        pb[sp][4 + j] = (short)f2bf(at[2 * sp + 1][j]);
      }
    f32x4 o[8];
    float ss = 0.f;
    const float* Sp = states + (size_t)(it - 1) * 16384;
#pragma unroll
    for (int vt = 0; vt < 8; ++vt) {
      f32x4 acc = {0.f, 0.f, 0.f, 0.f};
#pragma unroll
      for (int sp = 0; sp < 2; ++sp) {
        if (2 * sp <= wave) {
          const u16* vr = VTs + (vt * 16 + c16) * 72 + sp * 32 + q * 4;
          const bf16x4 va = *(const bf16x4*)(vr);
          const bf16x4 vb = *(const bf16x4*)(vr + 16);
          bf16x8 vf;
          vf[0] = va[0]; vf[1] = va[1]; vf[2] = va[2]; vf[3] = va[3];
          vf[4] = vb[0]; vf[5] = vb[1]; vf[6] = vb[2]; vf[7] = vb[3];
          acc = mfma16(vf, pb[sp], acc);
        }
      }
      if (c > 0) {
#pragma unroll
        for (int ks = 0; ks < 4; ++ks) {
          const float* sr = Sp + (size_t)(vt * 16 + c16) * 128 + ks * 32 + q * 8;
          const float4 s0v = *(const float4*)(sr);
          const float4 s1v = *(const float4*)(sr + 4);
          bf16x8 sf;
          sf[0] = (short)f2bf(s0v.x); sf[1] = (short)f2bf(s0v.y); sf[2] = (short)f2bf(s0v.z); sf[3] = (short)f2bf(s0v.w);
          sf[4] = (short)f2bf(s1v.x); sf[5] = (short)f2bf(s1v.y); sf[6] = (short)f2bf(s1v.z); sf[7] = (short)f2bf(s1v.w);
          acc = mfma16(sf, Qh[ks], acc);
        }
      }
      o[vt] = acc;
#pragma unroll
      for (int r = 0; r < 4; ++r) ss += acc[r] * acc[r];
    }
    ss += __shfl_xor(ss, 16);
    ss += __shfl_xor(ss, 32);
    const float rinv = rsqrtf(ss * (1.0f / 128.0f) + EPSN);
    const size_t trow = (size_t)(t0 + tt);
#pragma unroll
    for (int vt = 0; vt < 8; ++vt) {
      const int v0 = vt * 16 + q * 4;
      const uint2 graw = *(const uint2*)(Uhg + trow * 2048 + 1536 + h * 128 + v0);
      const float4 gn = *(const float4*)(p.gnorm + l * 128 + v0);
      const float y0 = o[vt][0] * rinv * gn.x * siluf_(bf2f((u16)(graw.x & 0xffff)));
      const float y1 = o[vt][1] * rinv * gn.y * siluf_(bf2f((u16)(graw.x >> 16)));
      const float y2 = o[vt][2] * rinv * gn.z * siluf_(bf2f((u16)(graw.y & 0xffff)));
      const float y3 = o[vt][3] * rinv * gn.w * siluf_(bf2f((u16)(graw.y >> 16)));
      uint2 w;
      w.x = (u32)f2bf(y0) | ((u32)f2bf(y1) << 16);
      w.y = (u32)f2bf(y2) | ((u32)f2bf(y3) << 16);
      *(uint2*)(Y + trow * 1536 + 512 + h * 128 + v0) = w;
    }
    __syncthreads();
  }
}

#define SMEM_BYTES 73728
#ifndef REPMASK
#define REPMASK 0
#endif
#define NREP(st) (((st) >= 0 && (st) != 2 && (st) != 7 && (st) != 11 && (st) != 14 && ((REPMASK >> (st)) & 1)) ? 2 : 1)
__global__ void __launch_bounds__(256, 2) mega(Params p) {
  cg::grid_group grid = cg::this_grid();
  __shared__ __attribute__((aligned(16))) char smem[SMEM_BYTES];
  u16* sm16 = (u16*)smem;
  char* ws = p.ws;
  for (int gs = -1; gs < 60; ++gs) {
    const int l = (gs < 0) ? 0 : gs / 15;
    const int st = (gs < 0) ? -1 : gs % 15;
    const float* g = p.gains + (size_t)l * 6 * 1024;
    for (int rep_ = 0; rep_ < NREP(st); ++rep_) {
    if (st == 0 || st == 12) {
      phase_ffn_up(p, (const u16*)(ws + (st == 0 ? W_GU0 : W_GU1)), sm16);
    } else if (st == 1 || st == 10 || st == 13) {
      const u16* A = (const u16*)(ws + (st == 10 ? OFF_H : OFF_ACT));
      const u16* Bt = (const u16*)(ws + (st == 10 ? W_OUT : (st == 1 ? W_D0 : W_D1)));
      const int K = (st == 10) ? 1024 : DFF;
      float* outp = (float*)(ws + (st == 10 ? OFF_D2 : OFF_D));
      phase_gemm_f32(A, K, Bt, K, K, 128, 8, outp, 1024, sm16);
    } else if (st == -1 || st == 2 || st == 11 || st == 14) {
      if (st == -1) phase_rope_table(p);
      const int mode = (st == -1) ? 0 : 1;
      const float* D = (const float*)(ws + (st == 11 ? OFF_D2 : OFF_D));
      const float* gD = g + (st == 2 ? 1 : (st == 11 ? 3 : 5)) * 1024;
      const float scale = (st == 11) ? 1.0f : 0.5f;
      const float* gH = (st == -1) ? g : g + (st == 2 ? 2 : (st == 11 ? 4 : 6)) * 1024;
      const bool writeH = !(st == 14 && l == 3);
      phase_norm(p, mode, D, gD, scale, gH, writeH);
      if (st == -1 || (st == 14 && l < 3)) phase_convert(p, (st == -1) ? 0 : l + 1, (float*)smem);
    } else if (st == 3 || st == 5) {
      if (st == 5) phase_cmp1(p, sm16);
      phase_win(p, st == 5 ? 1 : 0, sm16);
    } else if (st == 4) {
      phase_prep(p, l);
    } else if (st == 6) {
      phase_cmp2(p, l);
      phase_hg_local(p, l, smem);
    } else if (st == 7) {
      phase_cmp_attn(p);
      phase_hg_scan(p);
    } else if (st == 8) {
      phase_slc_win(p);
      phase_hg_out(p, l, smem);
    } else if (st == 9) {
      phase_merge(p, sm16);
    }
    }
    if (gs < 59) grid.sync();
  }
}

extern "C" void kernel_launch(void* const* d_in, const int* in_sizes, int n_in,
                              void* d_out, int out_size, void* d_ws, size_t ws_size,
                              hipStream_t stream) {
  static int grid_blocks = 0;
  if (!grid_blocks) {
    int dev = 0, cus = 0, per_cu = 0;
    hipGetDevice(&dev);
    hipDeviceGetAttribute(&cus, hipDeviceAttributeMultiprocessorCount, dev);
    hipOccupancyMaxActiveBlocksPerMultiprocessor(&per_cu, mega, 256, 0);
    if (per_cu > 2) per_cu = 2;
    if (per_cu < 1) per_cu = 1;
    grid_blocks = cus * per_cu;
  }
  if (ws_size < (size_t)WS_NEEDED) {
    fprintf(stderr, "workspace too small: %zu < %zu\n", ws_size, (size_t)WS_NEEDED);
    return;
  }
  Params p{};
  p.x_in = (const float*)d_in[0];
  p.pos = (const int*)d_in[1];
  p.lb_logits = (const float*)d_in[2];
  p.gains = (const float*)d_in[3];
  p.wg = (const float*)d_in[4];
  p.wu = (const float*)d_in[5];
  p.wd = (const float*)d_in[6];
  p.win = (const float*)d_in[7];
  p.convw = (const float*)d_in[8];
  p.gnorm = (const float*)d_in[9];
  p.pe = (const float*)d_in[10];
  p.cw1 = (const float*)d_in[11];
  p.cw2 = (const float*)d_in[12];
  p.wbr = (const float*)d_in[13];
  p.wout = (const float*)d_in[14];
  p.x = (float*)d_out;
  p.ws = (char*)d_ws;
  void* args[] = {&p};
  hipError_t e = hipLaunchCooperativeKernel((void*)mega, dim3(grid_blocks), dim3(256), args, 0, stream);
  if (e != hipSuccess) fprintf(stderr, "coop launch failed: %s (grid %d)\n", hipGetErrorString(e), grid_blocks);
}
```

```cpp
#include <hip/hip_runtime.h>
#include <hip/hip_cooperative_groups.h>
#include <cstdio>
namespace cg = cooperative_groups;

typedef unsigned short u16;
typedef unsigned int u32;
typedef __attribute__((ext_vector_type(8))) short bf16x8;
typedef __attribute__((ext_vector_type(4))) short bf16x4;
typedef __attribute__((ext_vector_type(4))) float f32x4;

#define T_TOK 16384
#define SEQL 8192
#define DM 1024
#define DFF 2816
#define EPSN 1e-6f

#define W_GU0 0ul
#define W_D0 11534336ul
#define W_GU1 17301504ul
#define W_D1 28835840ul
#define W_IN 34603008ul
#define W_BR 51118080ul
#define W_OUT 54263808ul
#define W_C1 56360960ul
#define OFF_H 58458112ul
#define OFF_ACT 92012544ul
#define OFF_STATES OFF_ACT
#define OFF_KR (OFF_ACT + 67108864ul)
#define OFF_VT (OFF_KR + 12582912ul)
#define OFF_D 184287232ul
#define OFF_Y OFF_D
#define OFF_IMP (OFF_D + 50331648ul)
#define OFF_U1 251396096ul
#define OFF_UCONV OFF_U1
#define OFF_UNSA (OFF_U1 + 50331648ul)
#define OFF_UHG OFF_U1
#define OFF_D2 OFF_U1
#define OFF_UMG 347865088ul
#define OFF_QR 448528384ul
#define OFF_CMPA (OFF_QR + 16777216ul)
#define OFF_OCMP (OFF_CMPA + 16777216ul)
#define OFF_ROPE 498860032ul
#define OFF_HC (OFF_ROPE + 4194304ul)
#define OFF_GATES (OFF_HC + 2097152ul)
#define OFF_GDEC (OFF_GATES + 1572864ul)
#define OFF_KCMP (OFF_GDEC + 524288ul)
#define OFF_VCMP (OFF_KCMP + 262144ul)
#define OFF_BAR (OFF_VCMP + 262144ul)
#define WS_NEEDED (OFF_BAR + 16384ul)

struct Params {
  const float* x_in; const int* pos; const float* lb_logits; const float* gains;
  const float* wg; const float* wu; const float* wd; const float* win; const float* convw;
  const float* gnorm; const float* pe; const float* cw1; const float* cw2; const float* wbr; const float* wout;
  float* x; char* ws;
};

__device__ __forceinline__ int opaque_tid() { int t = threadIdx.x; asm volatile("" : "+v"(t)); return t; }
__device__ __forceinline__ int opaque_bid() { int t = blockIdx.x; asm volatile("" : "+s"(t)); return t; }
#define TIDX opaque_tid()
#define BIDX opaque_bid()

__device__ __forceinline__ u16 f2bf(float f) {
  u32 u = __float_as_uint(f);
  u += 0x7fffu + ((u >> 16) & 1u);
  return (u16)(u >> 16);
}
__device__ __forceinline__ float bf2f(u16 h) { return __uint_as_float(((u32)h) << 16); }
__device__ __forceinline__ float sigmoidf_(float x) { return 1.0f / (1.0f + __expf(-x)); }
__device__ __forceinline__ float siluf_(float x) { return x / (1.0f + __expf(-x)); }
__device__ __forceinline__ float wave_sum(float v) {
#pragma unroll
  for (int o = 32; o; o >>= 1) v += __shfl_xor(v, o);
  return v;
}
__device__ __forceinline__ f32x4 mfma16(bf16x8 a, bf16x8 b, f32x4 c) {
  return __builtin_amdgcn_mfma_f32_16x16x32_bf16(a, b, c, 0, 0, 0);
}

#define LSTR 72
template <int NJ>
__device__ __forceinline__ void gemm_acc(f32x4 (&acc)[4][NJ], const u16* __restrict__ A, int lda,
                                         const u16* __restrict__ Bt, int ldb, int kbeg, int kend,
                                         int row0, int col0, u16* smem) {
  const int tid = TIDX;
  const int lane = tid & 63, wave = tid >> 6;
  const int wm = wave >> 1, wn = wave & 1;
  u16* sA = smem;
  u16* sB = smem + 2 * 128 * LSTR;
  const int lrow = tid >> 3, lkc = tid & 7;
  const u16* Ag = A + (size_t)(row0 + lrow) * lda + kbeg + lkc * 8;
  const u16* Bg = Bt + (size_t)(col0 + lrow) * ldb + kbeg + lkc * 8;
  const size_t a32 = (size_t)32 * lda, b32 = (size_t)32 * ldb;
  uint4 ra0, ra1, ra2, ra3, rb0, rb1, rb2, rb3;
  const int nk = (kend - kbeg) >> 6;
  ra0 = *(const uint4*)(Ag); ra1 = *(const uint4*)(Ag + a32); ra2 = *(const uint4*)(Ag + 2 * a32); ra3 = *(const uint4*)(Ag + 3 * a32);
  rb0 = *(const uint4*)(Bg); rb1 = *(const uint4*)(Bg + b32);
  if (NJ == 4) { rb2 = *(const uint4*)(Bg + 2 * b32); rb3 = *(const uint4*)(Bg + 3 * b32); }
  {
    u16* wa = sA + lrow * LSTR + lkc * 8;
    u16* wb = sB + lrow * LSTR + lkc * 8;
    *(uint4*)(wa) = ra0; *(uint4*)(wa + 32 * LSTR) = ra1; *(uint4*)(wa + 64 * LSTR) = ra2; *(uint4*)(wa + 96 * LSTR) = ra3;
    *(uint4*)(wb) = rb0; *(uint4*)(wb + 32 * LSTR) = rb1;
    if (NJ == 4) { *(uint4*)(wb + 64 * LSTR) = rb2; *(uint4*)(wb + 96 * LSTR) = rb3; }
  }
  __syncthreads();
  for (int kt = 0; kt < nk; ++kt) {
    const int buf = kt & 1;
    const bool more = (kt + 1 < nk);
    if (more) {
      const u16* Ak = Ag + (kt + 1) * 64;
      const u16* Bk = Bg + (kt + 1) * 64;
      ra0 = *(const uint4*)(Ak); ra1 = *(const uint4*)(Ak + a32); ra2 = *(const uint4*)(Ak + 2 * a32); ra3 = *(const uint4*)(Ak + 3 * a32);
      rb0 = *(const uint4*)(Bk); rb1 = *(const uint4*)(Bk + b32);
      if (NJ == 4) { rb2 = *(const uint4*)(Bk + 2 * b32); rb3 = *(const uint4*)(Bk + 3 * b32); }
    }
    __builtin_amdgcn_sched_barrier(0);
    const u16* a = sA + buf * 128 * LSTR + (wm * 64 + (lane & 15)) * LSTR + (lane >> 4) * 8;
    const u16* b = sB + buf * 128 * LSTR + (wn * (NJ * 16) + (lane & 15)) * LSTR + (lane >> 4) * 8;
#pragma unroll
    for (int ks = 0; ks < 2; ++ks) {
      bf16x8 af[4], bfr[NJ];
#pragma unroll
      for (int i = 0; i < 4; ++i) af[i] = *(const bf16x8*)(a + i * 16 * LSTR + ks * 32);
#pragma unroll
      for (int j = 0; j < NJ; ++j) bfr[j] = *(const bf16x8*)(b + j * 16 * LSTR + ks * 32);
#pragma unroll
      for (int i = 0; i < 4; ++i)
#pragma unroll
        for (int j = 0; j < NJ; ++j) acc[i][j] = mfma16(af[i], bfr[j], acc[i][j]);
    }
    __builtin_amdgcn_sched_barrier(0);
    if (more) {
      const int nb = buf ^ 1;
      u16* wa = sA + nb * 128 * LSTR + lrow * LSTR + lkc * 8;
      u16* wb = sB + nb * 128 * LSTR + lrow * LSTR + lkc * 8;
      *(uint4*)(wa) = ra0; *(uint4*)(wa + 32 * LSTR) = ra1; *(uint4*)(wa + 64 * LSTR) = ra2; *(uint4*)(wa + 96 * LSTR) = ra3;
      *(uint4*)(wb) = rb0; *(uint4*)(wb + 32 * LSTR) = rb1;
      if (NJ == 4) { *(uint4*)(wb + 64 * LSTR) = rb2; *(uint4*)(wb + 96 * LSTR) = rb3; }
    }
    __syncthreads();
  }
}

#define ZERO_ACC(acc)                                  \
  _Pragma("unroll") for (int i_ = 0; i_ < 4; ++i_)     \
  _Pragma("unroll") for (int j_ = 0; j_ < 4; ++j_) { acc[i_][j_] = (f32x4){0.f, 0.f, 0.f, 0.f}; }

#define CONV_ITEMS 7136
__device__ __forceinline__ void convert_tile(const Params& p, int l, int item, float* tile) {
  const int tid = TIDX;
  int id, loc;
  if (item < 1408) { id = 0; loc = item; }
  else if (item < 2112) { id = 1; loc = item - 1408; }
  else if (item < 3520) { id = 2; loc = item - 2112; }
  else if (item < 4224) { id = 3; loc = item - 3520; }
  else if (item < 6240) { id = 4; loc = item - 4224; }
  else if (item < 6624) { id = 5; loc = item - 6240; }
  else if (item < 6880) { id = 6; loc = item - 6624; }
  else { id = 7; loc = item - 6880; }
  int KT = 16;
  if (id == 1 || id == 3) KT = 44; else if (id == 5) KT = 24; else if (id == 7) KT = 32;
  const int nt = loc / KT, kt = loc % KT;
  const int n0 = nt * 64, k0 = kt * 64;
  const int tn = tid & 63, tk = tid >> 6;
  const int n = n0 + tn;
  const float* src = nullptr; size_t ldsrc = 0; bool zero = false;
  u16* dst = nullptr; int lddst = 0;
  char* ws = p.ws;
  if (id == 0 || id == 2) {
    const int f = id >> 1;
    const int pp = n >> 5, s = (n >> 4) & 1, i = n & 15;
    src = (s ? p.wu : p.wg) + (size_t)(l * 2 + f) * 1024 * DFF + (pp * 16 + i);
    ldsrc = DFF; dst = (u16*)(ws + (f ? W_GU1 : W_GU0)); lddst = 1024;
  } else if (id == 1 || id == 3) {
    const int f = id >> 1;
    src = p.wd + (size_t)(l * 2 + f) * DFF * 1024 + n;
    ldsrc = 1024; dst = (u16*)(ws + (f ? W_D1 : W_D0)); lddst = DFF;
  } else if (id == 4) {
    int col = n;
    if (n >= 4888 && n < 4992) { zero = true; col = 0; }
    else if (n >= 4992) col = n - 104;
    src = p.win + (size_t)l * 1024 * 7960 + col;
    ldsrc = 7960; dst = (u16*)(ws + W_IN); lddst = 1024;
  } else if (id == 5) {
    src = p.wbr + (size_t)l * 1536 * 1024 + n;
    ldsrc = 1024; dst = (u16*)(ws + W_BR); lddst = 1536;
  } else if (id == 6) {
    src = p.wout + (size_t)l * 1024 * 1024 + n;
    ldsrc = 1024; dst = (u16*)(ws + W_OUT); lddst = 1024;
  } else {
    const int m = n >> 8, nn = n & 255;
    src = p.cw1 + (size_t)(l * 2 + m) * 2048 * 256 + nn;
    ldsrc = 256; dst = (u16*)(ws + W_C1); lddst = 2048;
  }
#pragma unroll 4
  for (int it = 0; it < 16; ++it) {
    const int k = it * 4 + tk;
    tile[k * 65 + tn] = zero ? 0.f : src[(size_t)(k0 + k) * ldsrc];
  }
  __syncthreads();
#pragma unroll 4
  for (int it = 0; it < 16; ++it) {
    const int nn = it * 4 + tk, kk = tid & 63;
    dst[(size_t)(n0 + nn) * lddst + k0 + kk] = f2bf(tile[kk * 65 + nn]);
  }
  __syncthreads();
}

__device__ __forceinline__ void phase_convert(const Params& p, int l, float* tile) {
  for (int it = BIDX; it < CONV_ITEMS; it += gridDim.x) convert_tile(p, l, it, tile);
}

__device__ __forceinline__ void phase_norm(const Params& p, int mode, const float* D, const float* gD, float scale,
                           const float* gH, bool writeH) {
  const int lane = TIDX & 63, wave = TIDX >> 6;
  u16* H = (u16*)(p.ws + OFF_H);
  for (int it = BIDX; it < T_TOK / 4; it += gridDim.x) {
    const int row = it * 4 + wave;
    const float* xs = (mode == 0 ? p.x_in : p.x) + (size_t)row * DM;
    float4 xv[4];
#pragma unroll
    for (int i = 0; i < 4; ++i) xv[i] = *(const float4*)(xs + i * 256 + lane * 4);
    if (mode == 1) {
      float4 dv[4];
      float ss = 0.f;
#pragma unroll
      for (int i = 0; i < 4; ++i) {
        dv[i] = *(const float4*)(D + (size_t)row * DM + i * 256 + lane * 4);
        ss += dv[i].x * dv[i].x + dv[i].y * dv[i].y + dv[i].z * dv[i].z + dv[i].w * dv[i].w;
      }
      ss = wave_sum(ss);
      const float r = rsqrtf(ss * (1.0f / DM) + EPSN) * scale;
#pragma unroll
      for (int i = 0; i < 4; ++i) {
        const float4 g = *(const float4*)(gD + i * 256 + lane * 4);
        xv[i].x += dv[i].x * r * g.x; xv[i].y += dv[i].y * r * g.y;
        xv[i].z += dv[i].z * r * g.z; xv[i].w += dv[i].w * r * g.w;
      }
    }
#pragma unroll
    for (int i = 0; i < 4; ++i) *(float4*)(p.x + (size_t)row * DM + i * 256 + lane * 4) = xv[i];
    if (writeH) {
      float ss = 0.f;
#pragma unroll
      for (int i = 0; i < 4; ++i) ss += xv[i].x * xv[i].x + xv[i].y * xv[i].y + xv[i].z * xv[i].z + xv[i].w * xv[i].w;
      ss = wave_sum(ss);
      const float r = rsqrtf(ss * (1.0f / DM) + EPSN);
#pragma unroll
      for (int i = 0; i < 4; ++i) {
        const float4 g = *(const float4*)(gH + i * 256 + lane * 4);
        uint2 o;
        o.x = (u32)f2bf(xv[i].x * r * g.x) | ((u32)f2bf(xv[i].y * r * g.y) << 16);
        o.y = (u32)f2bf(xv[i].z * r * g.z) | ((u32)f2bf(xv[i].w * r * g.w) << 16);
        *(uint2*)(H + (size_t)row * DM + i * 256 + lane * 4) = o;
      }
    }
  }
}

__device__ __forceinline__ void phase_rope_table(const Params& p) {
  float2* cs = (float2*)(p.ws + OFF_ROPE);
  const size_t nth = (size_t)gridDim.x * blockDim.x;
  for (size_t e = (size_t)BIDX * blockDim.x + TIDX; e < (size_t)T_TOK * 32; e += nth) {
    const int t = (int)(e >> 5), i = (int)(e & 31);
    const float inv = powf(10000.0f, -(float)i * (2.0f / 64.0f));
    const float ang = (float)p.pos[t] * inv;
    double rev = (double)ang * 0.15915494309189535;
    rev -= floor(rev);
    const float fr = (float)rev;
    cs[e] = make_float2(__builtin_amdgcn_cosf(fr), __builtin_amdgcn_sinf(fr));
  }
}

__device__ __forceinline__ void phase_ffn_up(const Params& p, const u16* Wgu, u16* smem) {
  const u16* H = (const u16*)(p.ws + OFF_H);
  u16* act = (u16*)(p.ws + OFF_ACT);
  const int lane = TIDX & 63, wave = TIDX >> 6;
  const int wm = wave >> 1, wn = wave & 1;
  const int bid_ = BIDX;
  for (int lt = bid_ >> 3; lt < 16 * 44; lt += (gridDim.x >> 3)) {
    const int rest_ = lt >> 3;
    const int nt = rest_ % 44, mt = (bid_ & 7) * 16 + (rest_ / 44) * 8 + (lt & 7);
    f32x4 acc[4][4];
    ZERO_ACC(acc);
    gemm_acc<4>(acc, H, 1024, Wgu, 1024, 0, 1024, mt * 128, nt * 128, smem);
#pragma unroll
    for (int i = 0; i < 4; ++i)
#pragma unroll
      for (int jp = 0; jp < 2; ++jp) {
        const int col = (nt * 4 + wn * 2 + jp) * 16 + (lane & 15);
#pragma unroll
        for (int r = 0; r < 4; ++r) {
          const int row = mt * 128 + wm * 64 + i * 16 + (lane >> 4) * 4 + r;
          const float g = acc[i][2 * jp][r], u = acc[i][2 * jp + 1][r];
          act[(size_t)row * DFF + col] = f2bf(siluf_(g) * u);
        }
      }
  }
}

__device__ __forceinline__ void phase_gemm_f32(const u16* A, int lda, const u16* Bt, int ldb, int K, int MT, int NT,
                               float* out, int ldo, u16* smem) {
  const int lane = TIDX & 63, wave = TIDX >> 6;
  const int wm = wave >> 1, wn = wave & 1;
  const int bid_ = BIDX;
  for (int lt = bid_ >> 3; lt < (MT >> 3) * NT; lt += (gridDim.x >> 3)) {
    const int rest_ = lt >> 3;
    const int nt = rest_ % NT, mt = (bid_ & 7) * (MT >> 3) + (rest_ / NT) * 8 + (lt & 7);
    f32x4 acc[4][4];
    ZERO_ACC(acc);
    gemm_acc<4>(acc, A, lda, Bt, ldb, 0, K, mt * 128, nt * 128, smem);
#pragma unroll
    for (int i = 0; i < 4; ++i)
#pragma unroll
      for (int j = 0; j < 4; ++j) {
        const int col = nt * 128 + wn * 64 + j * 16 + (lane & 15);
#pragma unroll
        for (int r = 0; r < 4; ++r) {
          const int row = mt * 128 + wm * 64 + i * 16 + (lane >> 4) * 4 + r;
          out[(size_t)row * ldo + col] = acc[i][j][r];
        }
      }
  }
}

__device__ __forceinline__ void phase_win(const Params& p, int part, u16* smem) {
  const u16* H = (const u16*)(p.ws + OFF_H);
  const u16* W = (const u16*)(p.ws + W_IN);
  const int lane = TIDX & 63, wave = TIDX >> 6;
  const int wm = wave >> 1, wn = wave & 1;
  const int NT = part ? 40 : 23;
  const int bid_ = BIDX;
  for (int lt = bid_ >> 3; lt < 16 * NT; lt += (gridDim.x >> 3)) {
    const int rest_ = lt >> 3;
    const int nl = rest_ % NT, mt = (bid_ & 7) * 16 + (rest_ / NT) * 8 + (lt & 7);
    int ct;
    if (part == 0) ct = (nl < 12) ? nl : (28 + nl - 12);
    else ct = (nl < 16) ? (12 + nl) : (39 + nl - 16);
    u16* dst; int ld, cb;
    if (ct < 12) { dst = (u16*)(p.ws + OFF_UCONV); ld = 1536; cb = ct * 128; }
    else if (ct < 28) { dst = (u16*)(p.ws + OFF_UHG); ld = 2048; cb = (ct - 12) * 128; }
    else if (ct < 39) { dst = (u16*)(p.ws + OFF_UNSA); ld = 1408; cb = (ct - 28) * 128; }
    else { dst = (u16*)(p.ws + OFF_UMG); ld = 3072; cb = (ct - 39) * 128; }
    f32x4 acc[4][4];
    ZERO_ACC(acc);
    gemm_acc<4>(acc, H, 1024, W, 1024, 0, 1024, mt * 128, ct * 128, smem);
#pragma unroll
    for (int i = 0; i < 4; ++i)
#pragma unroll
      for (int j = 0; j < 4; ++j) {
        const int col = cb + wn * 64 + j * 16 + (lane & 15);
#pragma unroll
        for (int r = 0; r < 4; ++r) {
          const int row = mt * 128 + wm * 64 + i * 16 + (lane >> 4) * 4 + r;
          dst[(size_t)row * ld + col] = f2bf(acc[i][j][r]);
        }
      }
  }
}

__device__ __forceinline__ void phase_cmp1(const Params& p, u16* smem) {
  const int lane = TIDX & 63, wave = TIDX >> 6;
  const int wm = wave >> 1, wn = wave & 1;
  for (int it = BIDX; it < 64; it += gridDim.x) {
    const int m = it >> 5, mt = (it >> 1) & 15, nt = it & 1;
    const u16* A = (const u16*)(p.ws + OFF_CMPA) + (size_t)m * 2048 * 2048;
    const u16* Bt = (const u16*)(p.ws + W_C1) + (size_t)m * 256 * 2048;
    u16* Hc = (u16*)(p.ws + OFF_HC) + (size_t)m * 2048 * 256;
    f32x4 acc[4][4];
    ZERO_ACC(acc);
    gemm_acc<4>(acc, A, 2048, Bt, 2048, 0, 2048, mt * 128, nt * 128, smem);
#pragma unroll
    for (int i = 0; i < 4; ++i)
#pragma unroll
      for (int j = 0; j < 4; ++j) {
        const int col = nt * 128 + wn * 64 + j * 16 + (lane & 15);
#pragma unroll
        for (int r = 0; r < 4; ++r) {
          const int row = mt * 128 + wm * 64 + i * 16 + (lane >> 4) * 4 + r;
          const float x = acc[i][j][r];
          const float u = 0.7978845608028654f * (x + 0.044715f * x * x * x);
          Hc[(size_t)row * 256 + col] = f2bf(x * sigmoidf_(2.0f * u));
        }
      }
  }
}

__device__ __forceinline__ void phase_cmp2(const Params& p, int l) {
  const u16* Hc = (const u16*)(p.ws + OFF_HC);
  u16* kcmp = (u16*)(p.ws + OFF_KCMP);
  u16* vcmpT = (u16*)(p.ws + OFF_VCMP);
  const size_t nth = (size_t)gridDim.x * blockDim.x;
  for (size_t e = (size_t)BIDX * blockDim.x + TIDX; e < (size_t)2 * 2048 * 64; e += nth) {
    const int m = (int)(e >> 17);
    const int rem = (int)(e & 131071);
    const int row = rem >> 6, d = rem & 63;
    if (row < 2044) {
      const u16* hr = Hc + ((size_t)m * 2048 + row) * 256;
      const float* w2 = p.cw2 + (size_t)(l * 2 + m) * 256 * 64 + d;
      float acc = 0.f;
#pragma unroll 8
      for (int k = 0; k < 256; ++k) acc += bf2f(hr[k]) * w2[k * 64];
      const int b = row / 1022, r2 = row % 1022;
      const int n = r2 >> 1, kh = r2 & 1;
      if (m == 0) kcmp[((size_t)(b * 2 + kh) * 512 + n) * 64 + d] = f2bf(acc);
      else vcmpT[((size_t)(b * 2 + kh) * 64 + d) * 512 + n] = f2bf(acc);
    } else {
      const int bk = row - 2044;
      if (m == 0) kcmp[((size_t)bk * 512 + 511) * 64 + d] = 0;
      else vcmpT[((size_t)bk * 64 + d) * 512 + 511] = 0;
    }
  }
}

__device__ __forceinline__ void phase_merge(const Params& p, u16* smem) {
  const u16* Y = (const u16*)(p.ws + OFF_Y);
  const u16* W = (const u16*)(p.ws + W_BR);
  const u16* MG = (const u16*)(p.ws + OFF_UMG);
  u16* outp = (u16*)(p.ws + OFF_H);
  const int lane = TIDX & 63, wave = TIDX >> 6;
  const int wm = wave >> 1, wn = wave & 1;
  const int bid_ = BIDX;
  for (int lt = bid_ >> 3; lt < 16 * 16; lt += (gridDim.x >> 3)) {
    const int rest_ = lt >> 3;
    const int nt = rest_ & 15, mt = (bid_ & 7) * 16 + (rest_ >> 4) * 8 + (lt & 7);
    f32x4 tot[4][2];
#pragma unroll
    for (int i = 0; i < 4; ++i)
#pragma unroll
      for (int j = 0; j < 2; ++j) tot[i][j] = (f32x4){0.f, 0.f, 0.f, 0.f};
    for (int n = 0; n < 3; ++n) {
      f32x4 acc[4][2];
#pragma unroll
      for (int i = 0; i < 4; ++i)
#pragma unroll
        for (int j = 0; j < 2; ++j) acc[i][j] = (f32x4){0.f, 0.f, 0.f, 0.f};
      gemm_acc<2>(acc, Y, 1536, W, 1536, n * 512, n * 512 + 512, mt * 128, nt * 64, smem);
#pragma unroll
      for (int i = 0; i < 4; ++i)
#pragma unroll
        for (int j = 0; j < 2; ++j) {
          const int col = nt * 64 + wn * 32 + j * 16 + (lane & 15);
#pragma unroll
          for (int r = 0; r < 4; ++r) {
            const int row = mt * 128 + wm * 64 + i * 16 + (lane >> 4) * 4 + r;
            const float g = sigmoidf_(bf2f(MG[(size_t)row * 3072 + n * 1024 + col]));
            tot[i][j][r] += g * acc[i][j][r];
          }
        }
    }
#pragma unroll
    for (int i = 0; i < 4; ++i)
#pragma unroll
      for (int j = 0; j < 2; ++j) {
        const int col = nt * 64 + wn * 32 + j * 16 + (lane & 15);
#pragma unroll
        for (int r = 0; r < 4; ++r) {
          const int row = mt * 128 + wm * 64 + i * 16 + (lane >> 4) * 4 + r;
          outp[(size_t)row * 1024 + col] = f2bf(tot[i][j][r]);
        }
      }
  }
}

__device__ __forceinline__ void phase_prep(const Params& p, int l) {
  const u16* Uc = (const u16*)(p.ws + OFF_UCONV);
  const u16* Un = (const u16*)(p.ws + OFF_UNSA);
  u16* Y = (u16*)(p.ws + OFF_Y);
  u16* qr = (u16*)(p.ws + OFF_QR);
  u16* KR = (u16*)(p.ws + OFF_KR);
  u16* VT = (u16*)(p.ws + OFF_VT);
  u16* CA = (u16*)(p.ws + OFF_CMPA);
  float* gates = (float*)(p.ws + OFF_GATES);
  const float2* cs = (const float2*)(p.ws + OFF_ROPE);
  const int tid = TIDX;
  const size_t nth = (size_t)gridDim.x * blockDim.x;
  const size_t gt = (size_t)BIDX * blockDim.x + tid;
  for (size_t e = gt; e < (size_t)T_TOK * 512; e += nth) {
    const int t = (int)(e >> 9), c = (int)(e & 511);
    const int s = t & (SEQL - 1);
    const float w0 = p.convw[(l * 3 + 0) * 512 + c], w1 = p.convw[(l * 3 + 1) * 512 + c], w2 = p.convw[(l * 3 + 2) * 512 + c];
    const u16* r2 = Uc + (size_t)t * 1536;
    const float v2 = bf2f(r2[512 + c]) * bf2f(r2[1024 + c]);
    float v1 = 0.f, v0 = 0.f;
    if (s >= 1) { const u16* r1 = r2 - 1536; v1 = bf2f(r1[512 + c]) * bf2f(r1[1024 + c]); }
    if (s >= 2) { const u16* r0 = r2 - 3072; v0 = bf2f(r0[512 + c]) * bf2f(r0[1024 + c]); }
    Y[(size_t)t * 1536 + c] = f2bf(bf2f(r2[c]) * (w0 * v0 + w1 * v1 + w2 * v2));
  }
  for (size_t e = gt; e < (size_t)2 * 4 * 2048; e += nth) {
    const int m = (int)(e >> 13), rem = (int)(e & 8191);
    CA[((size_t)m * 2048 + 2044) * 2048 + rem] = 0;
  }
  const float* pek = p.pe + (size_t)(l * 2 + 0) * 2048;
  const float* pev = p.pe + (size_t)(l * 2 + 1) * 2048;
  for (int it = BIDX; it < 1024; it += gridDim.x) {
    const int b = it >> 9, ch = it & 511;
    const int s0 = ch * 16, t0 = b * SEQL + s0;
    for (int idx = tid; idx < 4096; idx += 256) {
      const int i = idx >> 8, pr = idx & 255;
      const int head = pr >> 5, d = pr & 31;
      const int t = t0 + i;
      const float2 c_s = cs[(size_t)t * 32 + d];
      const float x1 = bf2f(Un[(size_t)t * 1408 + head * 64 + d]);
      const float x2 = bf2f(Un[(size_t)t * 1408 + head * 64 + 32 + d]);
      qr[(size_t)t * 512 + head * 64 + d] = f2bf(x1 * c_s.x - x2 * c_s.y);
      qr[(size_t)t * 512 + head * 64 + 32 + d] = f2bf(x2 * c_s.x + x1 * c_s.y);
    }
    for (int idx = tid; idx < 3072; idx += 256) {
      const int i = idx / 192, rem = idx % 192;
      const int m = rem >> 6, hp = rem & 63;
      const int kh = hp >> 5, d = hp & 31;
      const int t = t0 + i;
      const float2 c_s = cs[(size_t)t * 32 + d];
      const int col = 512 + m * 256 + kh * 64;
      const float x1 = bf2f(Un[(size_t)t * 1408 + col + d]);
      const float x2 = bf2f(Un[(size_t)t * 1408 + col + 32 + d]);
      const float o1 = x1 * c_s.x - x2 * c_s.y, o2 = x2 * c_s.x + x1 * c_s.y;
      u16* kd = KR + (size_t)m * 2097152 + ((size_t)(b * 2 + kh) * SEQL + s0 + i) * 64;
      kd[d] = f2bf(o1); kd[32 + d] = f2bf(o2);
      if (m == 0) {
        if (ch <= 510) {
          u16* a = CA + ((size_t)((b * 511 + ch) * 2 + kh)) * 2048 + i * 64;
          a[d] = f2bf(o1 + pek[i * 64 + d]); a[32 + d] = f2bf(o2 + pek[i * 64 + 32 + d]);
        }
        if (ch >= 1) {
          u16* a = CA + ((size_t)((b * 511 + ch - 1) * 2 + kh)) * 2048 + (16 + i) * 64;
          a[d] = f2bf(o1 + pek[(16 + i) * 64 + d]); a[32 + d] = f2bf(o2 + pek[(16 + i) * 64 + 32 + d]);
        }
      }
    }
    for (int idx = tid; idx < 2048; idx += 256) {
      const int i = idx >> 7, cc = idx & 127;
      const int kh = cc >> 6, d = cc & 63;
      const int t = t0 + i;
      const float v = bf2f(Un[(size_t)t * 1408 + 640 + cc]);
      u16* CAv = CA + (size_t)2048 * 2048;
      if (ch <= 510) CAv[((size_t)((b * 511 + ch) * 2 + kh)) * 2048 + i * 64 + d] = f2bf(v + pev[i * 64 + d]);
      if (ch >= 1) CAv[((size_t)((b * 511 + ch - 1) * 2 + kh)) * 2048 + (16 + i) * 64 + d] = f2bf(v + pev[(16 + i) * 64 + d]);
    }
    for (int idx = tid; idx < 4096; idx += 256) {
      const int i = idx & 15, cc = idx >> 4;
      const int m = cc >> 7, c2 = cc & 127;
      const int kh = c2 >> 6, d = c2 & 63;
      VT[(size_t)m * 2097152 + ((size_t)(b * 2 + kh) * 64 + d) * SEQL + s0 + i] =
          Un[(size_t)(t0 + i) * 1408 + 896 + m * 256 + c2];
    }
    for (int idx = tid; idx < 384; idx += 256) {
      const int i = idx / 24, gI = idx % 24;
      gates[(size_t)(t0 + i) * 24 + gI] = sigmoidf_(bf2f(Un[(size_t)(t0 + i) * 1408 + 1280 + gI]));
    }
  }
}

typedef unsigned long long u64;

__device__ __forceinline__ void k_load64(bf16x8 (&kq)[8], const u16* __restrict__ Kp, int lane) {
  const int c16 = lane & 15, q = lane >> 4;
#pragma unroll
  for (int kt = 0; kt < 4; ++kt) {
    const u16* kr = Kp + (kt * 16 + c16) * 64 + q * 8;
    kq[2 * kt] = *(const bf16x8*)(kr);
    kq[2 * kt + 1] = *(const bf16x8*)(kr + 32);
  }
}
__device__ __forceinline__ void v_load64(bf16x4 (&vq)[16], const u16* __restrict__ Vp, int ldv, int lane) {
  const int c16 = lane & 15, q = lane >> 4;
#pragma unroll
  for (int dt = 0; dt < 4; ++dt) {
    const u16* vr = Vp + (size_t)(dt * 16 + c16) * ldv + q * 4;
    vq[4 * dt + 0] = *(const bf16x4*)(vr);
    vq[4 * dt + 1] = *(const bf16x4*)(vr + 16);
    vq[4 * dt + 2] = *(const bf16x4*)(vr + 32);
    vq[4 * dt + 3] = *(const bf16x4*)(vr + 48);
  }
}
template <class MaskF>
__device__ __forceinline__ void qk64(const bf16x8 (&kq)[8], const bf16x8 (&qf)[2], float scale, MaskF maskf, int lane,
                                     f32x4 (&st)[4]) {
  const int q = lane >> 4;
#pragma unroll
  for (int kt = 0; kt < 4; ++kt) {
    f32x4 z = {0.f, 0.f, 0.f, 0.f};
    z = mfma16(kq[2 * kt], qf[0], z);
    z = mfma16(kq[2 * kt + 1], qf[1], z);
#pragma unroll
    for (int r = 0; r < 4; ++r) st[kt][r] = maskf(kt * 16 + q * 4 + r) ? z[r] * scale : -1e30f;
  }
}
__device__ __forceinline__ void pv64(const bf16x4 (&vq)[16], const f32x4 (&pr)[4], f32x4 (&o)[4]) {
#pragma unroll
  for (int hf = 0; hf < 2; ++hf) {
    bf16x8 pb;
#pragma unroll
    for (int j = 0; j < 4; ++j) { pb[j] = (short)f2bf(pr[2 * hf][j]); pb[4 + j] = (short)f2bf(pr[2 * hf + 1][j]); }
#pragma unroll
    for (int dt = 0; dt < 4; ++dt) {
      const bf16x8 vf = __builtin_shufflevector(vq[4 * dt + 2 * hf], vq[4 * dt + 2 * hf + 1], 0, 1, 2, 3, 4, 5, 6, 7);
      o[dt] = mfma16(vf, pb, o[dt]);
    }
  }
}
__device__ __forceinline__ void softmax_update(f32x4 (&st)[4], float& m, float& lsum, f32x4 (&o)[4]) {
  float mx = -1e30f;
#pragma unroll
  for (int kt = 0; kt < 4; ++kt)
#pragma unroll
    for (int r = 0; r < 4; ++r) mx = fmaxf(mx, st[kt][r]);
  mx = fmaxf(mx, __shfl_xor(mx, 16));
  mx = fmaxf(mx, __shfl_xor(mx, 32));
  const float mnew = fmaxf(m, mx);
  const float alpha = __expf(m - mnew);
  float ps = 0.f;
#pragma unroll
  for (int kt = 0; kt < 4; ++kt)
#pragma unroll
    for (int r = 0; r < 4; ++r) {
      const float pv = (st[kt][r] > -1e29f) ? __expf(st[kt][r] - mnew) : 0.f;
      st[kt][r] = pv;
      ps += pv;
    }
  lsum = lsum * alpha + ps;
  m = mnew;
#pragma unroll
  for (int dt = 0; dt < 4; ++dt) o[dt] *= alpha;
}

#define SB0 __builtin_amdgcn_sched_barrier(0)

__device__ __forceinline__ void phase_nsa_attn(const Params& p, char* smem) {
  const u16* qr = (const u16*)(p.ws + OFF_QR);
  const u16* kcmp = (const u16*)(p.ws + OFF_KCMP);
  const u16* vcmpT = (const u16*)(p.ws + OFF_VCMP);
  const u16* KS = (const u16*)(p.ws + OFF_KR) + (size_t)1 * 2097152;
  const u16* KW = (const u16*)(p.ws + OFF_KR) + (size_t)2 * 2097152;
  const u16* VS = (const u16*)(p.ws + OFF_VT);
  const u16* VW = (const u16*)(p.ws + OFF_VT) + (size_t)2097152;
  const float* gates = (const float*)(p.ws + OFF_GATES);
  u16* Y = (u16*)(p.ws + OFF_Y);
  const int tid = TIDX;
  const int lane = tid & 63, wave = tid >> 6;
  const int c16 = lane & 15, q = lane >> 4;
  const int tq = c16 >> 2, g = c16 & 3;
  const float scale = 0.125f;
  float* impl = (float*)smem + wave * 512;
  for (int it = BIDX; it < 2048; it += gridDim.x) {
    const int b = it >> 10, kh = (it >> 9) & 1, grp = it & 511;
    const int s0 = (grp * 4 + wave) * 4;
    const int s = s0 + tq;
    const int t = b * SEQL + s;
    const int head = kh * 4 + g;
    bf16x8 qf[2];
    qf[0] = *(const bf16x8*)(qr + (size_t)t * 512 + head * 64 + q * 8);
    qf[1] = *(const bf16x8*)(qr + (size_t)t * 512 + head * 64 + 32 + q * 8);
    const float gt0 = gates[(size_t)t * 24 + kh * 12 + g * 3 + 0];
    const float gt1 = gates[(size_t)t * 24 + kh * 12 + g * 3 + 1];
    const float gt2 = gates[(size_t)t * 24 + kh * 12 + g * 3 + 2];
    const size_t kvb = (size_t)(b * 2 + kh);
    f32x4 y[4];
#pragma unroll
    for (int dt = 0; dt < 4; ++dt) y[dt] = (f32x4){0.f, 0.f, 0.f, 0.f};
    bf16x8 kA[8];
    bf16x4 vA[16];

    {
      const int nvalid = (s >= 31) ? (((s - 31) >> 4) + 1) : 0;
      const int slast = s0 + 3;
      const int nvmax = (slast >= 31) ? (((slast - 31) >> 4) + 1) : 0;
      const int ntile = (nvmax + 63) >> 6;
      const u16* Kb = kcmp + kvb * 512 * 64;
      const u16* Vb = vcmpT + kvb * 64 * 512;
      if (ntile > 0) {
        float m = -1e30f, lsum = 0.f;
        k_load64(kA, Kb, lane);
        for (int i = 0; i < ntile; ++i) {
          const int n0 = i * 64;
          const int nn = (i + 1 < ntile ? i + 1 : i) * 64;
          f32x4 st[4];
          qk64(kA, qf, scale, [&](int ko) { return (n0 + ko) < nvalid; }, lane, st);
          SB0;
          k_load64(kA, Kb + (size_t)nn * 64, lane);
          SB0;
          float mx = -1e30f;
#pragma unroll
          for (int kt = 0; kt < 4; ++kt)
#pragma unroll
            for (int r = 0; r < 4; ++r) mx = fmaxf(mx, st[kt][r]);
          mx = fmaxf(mx, __shfl_xor(mx, 16));
          mx = fmaxf(mx, __shfl_xor(mx, 32));
          const float mnew = fmaxf(m, mx);
          float ps = 0.f;
#pragma unroll
          for (int kt = 0; kt < 4; ++kt)
#pragma unroll
            for (int r = 0; r < 4; ++r) ps += (st[kt][r] > -1e29f) ? __expf(st[kt][r] - mnew) : 0.f;
          lsum = lsum * __expf(m - mnew) + ps;
          m = mnew;
        }
        lsum += __shfl_xor(lsum, 16);
        lsum += __shfl_xor(lsum, 32);
        const float invl = (lsum > 0.f) ? 1.0f / lsum : 0.f;
        f32x4 o[4];
#pragma unroll
        for (int dt = 0; dt < 4; ++dt) o[dt] = (f32x4){0.f, 0.f, 0.f, 0.f};
        float carry = 0.f;
        k_load64(kA, Kb, lane);
        v_load64(vA, Vb, 512, lane);
        for (int i = 0; i < ntile; ++i) {
          const int n0 = i * 64;
          const int nn = (i + 1 < ntile ? i + 1 : i) * 64;
          f32x4 st[4];
          qk64(kA, qf, scale, [&](int ko) { return (n0 + ko) < nvalid; }, lane, st);
          SB0;
          k_load64(kA, Kb + (size_t)nn * 64, lane);
          SB0;
#pragma unroll
          for (int kt = 0; kt < 4; ++kt)
#pragma unroll
            for (int r = 0; r < 4; ++r) st[kt][r] = (st[kt][r] > -1e29f) ? __expf(st[kt][r] - m) * invl : 0.f;
          pv64(vA, st, o);
          SB0;
          v_load64(vA, Vb + nn, 512, lane);
          SB0;
          float mainv[4], ev[4], eup[4];
#pragma unroll
          for (int kt = 0; kt < 4; ++kt) {
            float acc = 0.f, last = 0.f;
#pragma unroll
            for (int r = 0; r < 4; ++r) {
              float a = st[kt][r];
              a += __shfl_xor(a, 1);
              a += __shfl_xor(a, 2);
              acc += a;
              last = a;
            }
            mainv[kt] = acc; ev[kt] = last;
          }
#pragma unroll
          for (int kt = 0; kt < 4; ++kt) eup[kt] = __shfl(ev[kt], (lane + 48) & 63);
#pragma unroll
          for (int kt = 0; kt < 4; ++kt) {
            const float pe = (q > 0) ? eup[kt] : (kt > 0 ? eup[kt > 0 ? kt - 1 : 0] : carry);
            if (g == 0) impl[tq * 128 + (n0 >> 2) + kt * 4 + q] = mainv[kt] + pe;
          }
          carry = eup[3];
        }
#pragma unroll
        for (int dt = 0; dt < 4; ++dt) y[dt] += o[dt] * gt0;
      }
    }

    {
      const u16* Kw = KW + kvb * SEQL * 64;
      const u16* Vw = VW + kvb * 64 * SEQL;
      float m = -1e30f, lsum = 0.f;
      f32x4 o[4];
#pragma unroll
      for (int dt = 0; dt < 4; ++dt) o[dt] = (f32x4){0.f, 0.f, 0.f, 0.f};
      int lo = s0 - 511; if (lo < 0) lo = 0;
      lo &= ~63;
      const int ntile = ((s0 + 3 - lo) >> 6) + 1;
      k_load64(kA, Kw + (size_t)lo * 64, lane);
      v_load64(vA, Vw + lo, SEQL, lane);
      for (int i = 0; i < ntile; ++i) {
        const int k0 = lo + i * 64;
        const int kx = lo + (i + 1 < ntile ? i + 1 : i) * 64;
        f32x4 st[4];
        qk64(kA, qf, scale, [&](int ko) { const int ks = k0 + ko; return (ks <= s) && (ks + 512 > s); }, lane, st);
        SB0;
        k_load64(kA, Kw + (size_t)kx * 64, lane);
        SB0;
        softmax_update(st, m, lsum, o);
        pv64(vA, st, o);
        SB0;
        v_load64(vA, Vw + kx, SEQL, lane);
        SB0;
      }
      lsum += __shfl_xor(lsum, 16);
      lsum += __shfl_xor(lsum, 32);
      const float sc = (lsum > 0.f) ? gt2 / lsum : 0.f;
#pragma unroll
      for (int dt = 0; dt < 4; ++dt) y[dt] += o[dt] * sc;
    }

    {
      const u16* Ks = KS + kvb * SEQL * 64;
      const u16* Vs = VS + kvb * 64 * SEQL;
      const int cur = s0 >> 6;
      const int ncand = cur - 2;
      u64 mk0[5], mk1[5];
#pragma unroll
      for (int i = 0; i < 5; ++i) { mk0[i] = 0; mk1[i] = 0; }
      if (ncand <= 13) {
        mk0[0] = (cur >= 63) ? ~0ull : ((1ull << (cur + 1)) - 1ull);
      } else {
        mk0[0] = 1ull;
        if (cur - 1 < 64) mk0[0] |= 1ull << (cur - 1); else mk1[0] |= 1ull << (cur - 1 - 64);
        if (cur < 64) mk0[0] |= 1ull << cur; else mk1[0] |= 1ull << (cur - 64);
        u32 b0[4], b1[4], T[4];
#pragma unroll
        for (int tk = 0; tk < 4; ++tk) {
          const float* ir = impl + tk * 128;
          b0[tk] = (lane >= 1 && lane <= ncand) ? (__float_as_uint(ir[lane]) + 1u) : 0u;
          b1[tk] = (lane + 64 <= ncand) ? (__float_as_uint(ir[lane + 64]) + 1u) : 0u;
          T[tk] = 0u;
        }
        for (int bit = 30; bit >= 0; --bit) {
#pragma unroll
          for (int tk = 0; tk < 4; ++tk) {
            const u32 cand = T[tk] | (1u << bit);
            const int c = __builtin_popcountll(__builtin_amdgcn_ballot_w64(b0[tk] >= cand)) +
                          __builtin_popcountll(__builtin_amdgcn_ballot_w64(b1[tk] >= cand));
            if (c >= 13) T[tk] = cand;
          }
        }
#pragma unroll
        for (int tk = 0; tk < 4; ++tk) {
          u64 g0 = __builtin_amdgcn_ballot_w64(b0[tk] > T[tk]);
          u64 g1 = __builtin_amdgcn_ballot_w64(b1[tk] > T[tk]);
          u64 e0 = __builtin_amdgcn_ballot_w64(b0[tk] == T[tk]);
          u64 e1 = __builtin_amdgcn_ballot_w64(b1[tk] == T[tk]);
          int need = 13 - __builtin_popcountll(g0) - __builtin_popcountll(g1);
          while (need > 0 && (e0 | e1)) {
            if (e0) { const u64 low = e0 & (~e0 + 1ull); g0 |= low; e0 ^= low; }
            else { const u64 low = e1 & (~e1 + 1ull); g1 |= low; e1 ^= low; }
            --need;
          }
          mk0[tk + 1] = g0; mk1[tk + 1] = g1;
        }
      }
      int ntot = 0;
#pragma unroll
      for (int i = 0; i < 5; ++i) ntot += __builtin_popcountll(mk0[i]) + __builtin_popcountll(mk1[i]);
      int gi = 0;
      u64 c0 = mk0[0], c1 = mk1[0];
      int jn = 0, gn = 0;
      auto advance = [&]() {
        while ((c0 | c1) == 0ull && gi < 4) {
          ++gi;
          c0 = (gi == 1) ? mk0[1] : (gi == 2) ? mk0[2] : (gi == 3) ? mk0[3] : mk0[4];
          c1 = (gi == 1) ? mk1[1] : (gi == 2) ? mk1[2] : (gi == 3) ? mk1[3] : mk1[4];
        }
        if (c0) { jn = __builtin_ctzll(c0); c0 &= c0 - 1ull; }
        else if (c1) { jn = 64 + __builtin_ctzll(c1); c1 &= c1 - 1ull; }
        gn = gi;
      };
      float m = -1e30f, lsum = 0.f;
      f32x4 o[4];
#pragma unroll
      for (int dt = 0; dt < 4; ++dt) o[dt] = (f32x4){0.f, 0.f, 0.f, 0.f};
      advance();
      k_load64(kA, Ks + (size_t)jn * 4096, lane);
      v_load64(vA, Vs + jn * 64, SEQL, lane);
      for (int i = 0; i < ntot; ++i) {
        const int j = jn, gc = gn;
        if (i + 1 < ntot) advance();
        const bool mine = (gc == 0) || (tq == gc - 1);
        const int k0 = j * 64;
        f32x4 st[4];
        qk64(kA, qf, scale, [&](int ko) { return mine && ((k0 + ko) <= s); }, lane, st);
        SB0;
        k_load64(kA, Ks + (size_t)jn * 4096, lane);
        SB0;
        softmax_update(st, m, lsum, o);
        pv64(vA, st, o);
        SB0;
        v_load64(vA, Vs + jn * 64, SEQL, lane);
        SB0;
      }
      lsum += __shfl_xor(lsum, 16);
      lsum += __shfl_xor(lsum, 32);
      const float sc = (lsum > 0.f) ? gt1 / lsum : 0.f;
#pragma unroll
      for (int dt = 0; dt < 4; ++dt) y[dt] += o[dt] * sc;
    }

#pragma unroll
    for (int dt = 0; dt < 4; ++dt) {
      uint2 w;
      w.x = (u32)f2bf(y[dt][0]) | ((u32)f2bf(y[dt][1]) << 16);
      w.y = (u32)f2bf(y[dt][2]) | ((u32)f2bf(y[dt][3]) << 16);
      *(uint2*)(Y + (size_t)t * 1536 + 1024 + head * 64 + dt * 16 + q * 4) = w;
    }
  }
}

#define BCS 132
__device__ __forceinline__ float hg_lb(const Params& p, int l, int ch) {
  if (l == 0) return 0.f;
  const float a0 = p.lb_logits[ch], a1 = p.lb_logits[512 + ch], a2 = p.lb_logits[1024 + ch], a3 = p.lb_logits[1536 + ch];
  const float mx = fmaxf(fmaxf(a0, a1), fmaxf(a2, a3));
  const float e0 = __expf(a0 - mx), e1 = __expf(a1 - mx), e2 = __expf(a2 - mx), e3 = __expf(a3 - mx);
  const float inv = 1.0f / (e0 + e1 + e2 + e3);
  float sacc = e1;
  if (l >= 2) sacc += e2;
  if (l >= 3) sacc += e3;
  return sacc * inv;
}

__device__ __forceinline__ void hg_bcum(const Params& p, int l, const u16* Uhg, int t0, int h, float* bc, float* lbs) {
  const int tid = TIDX;
  const int d = tid & 127;
  const float lbv = hg_lb(p, l, h * 128 + d);
  if (tid < 128) lbs[d] = lbv;
  for (int idx = tid; idx < 64 * 128; idx += 256) {
    const int s = idx >> 7;
    const float z = bf2f(Uhg[(size_t)(t0 + s) * 2048 + 512 + h * 128 + d]);
    const float f = lbv + (1.0f - lbv) * sigmoidf_(z);
    bc[s * BCS + d] = __logf(fmaxf(f, 1e-30f));
  }
  __syncthreads();
  if (tid < 128) {
    float run = 0.f;
    for (int s = 0; s < 64; ++s) { run += bc[s * BCS + d]; bc[s * BCS + d] = run; }
  }
  __syncthreads();
}

__device__ __forceinline__ void phase_hg_local(const Params& p, int l, char* smem) {
  const u16* Uhg = (const u16*)(p.ws + OFF_UHG);
  float* states = (float*)(p.ws + OFF_STATES);
  float* gdec = (float*)(p.ws + OFF_GDEC);
  float* bc = (float*)smem;
  float* lbs = (float*)(smem + 33792);
  u16* KT = (u16*)(smem + 33792 + 512);
  u16* VTs = (u16*)(smem + 33792 + 512 + 18432);
  const int tid = TIDX, lane = tid & 63, wave = tid >> 6;
  const int c16 = lane & 15, q = lane >> 4;
  for (int it = BIDX; it < 1024; it += gridDim.x) {
    const int b = it >> 9, h = (it >> 7) & 3, c = it & 127;
    const int t0 = b * SEQL + c * 64;
    hg_bcum(p, l, Uhg, t0, h, bc, lbs);
    {
      const int d = tid & 127;
      const float lbv = lbs[d];
      const float bl = bc[63 * BCS + d];
      for (int idx = tid; idx < 64 * 128; idx += 256) {
        const int s = idx >> 7;
        const float z = bf2f(Uhg[(size_t)(t0 + s) * 2048 + 512 + h * 128 + d]);
        const float kk = (1.0f - lbv) * sigmoidf_(-z);
        KT[d * 72 + s] = f2bf(kk * __expf(bl - bc[s * BCS + d]));
        VTs[d * 72 + s] = Uhg[(size_t)(t0 + s) * 2048 + 1024 + h * 128 + d];
      }
      if (tid < 128) gdec[(size_t)it * 128 + d] = __expf(bl);
    }
    __syncthreads();
    f32x4 acc[2][8];
#pragma unroll
    for (int i = 0; i < 2; ++i)
#pragma unroll
      for (int j = 0; j < 8; ++j) acc[i][j] = (f32x4){0.f, 0.f, 0.f, 0.f};
#pragma unroll
    for (int ks = 0; ks < 2; ++ks) {
      bf16x8 af[2];
#pragma unroll
      for (int i = 0; i < 2; ++i) af[i] = *(const bf16x8*)(VTs + (wave * 32 + i * 16 + c16) * 72 + ks * 32 + q * 8);
#pragma unroll
      for (int j = 0; j < 8; ++j) {
        const bf16x8 bfr = *(const bf16x8*)(KT + (j * 16 + c16) * 72 + ks * 32 + q * 8);
#pragma unroll
        for (int i = 0; i < 2; ++i) acc[i][j] = mfma16(af[i], bfr, acc[i][j]);
      }
    }
    float* st = states + (size_t)it * 16384;
#pragma unroll
    for (int i = 0; i < 2; ++i)
#pragma unroll
      for (int j = 0; j < 8; ++j)
#pragma unroll
        for (int r = 0; r < 4; ++r) st[(wave * 32 + i * 16 + q * 4 + r) * 128 + j * 16 + c16] = acc[i][j][r];
    __syncthreads();
  }
}

__device__ __forceinline__ void phase_hg_scan(const Params& p) {
  float* __restrict__ states = (float*)(p.ws + OFF_STATES);
  const float* __restrict__ gdec = (const float*)(p.ws + OFF_GDEC);
  const size_t nth = (size_t)gridDim.x * blockDim.x;
  for (size_t e = (size_t)BIDX * blockDim.x + TIDX; e < (size_t)8 * 16384; e += nth) {
    const int bh = (int)(e >> 14), vd = (int)(e & 16383), d = vd & 127;
    float S = 0.f;
    for (int c0 = 0; c0 < 128; c0 += 16) {
      float Lv[16], gv[16];
#pragma unroll
      for (int i = 0; i < 16; ++i) {
        const size_t item = (size_t)bh * 128 + c0 + i;
        Lv[i] = states[item * 16384 + vd];
        gv[i] = gdec[item * 128 + d];
      }
#pragma unroll
      for (int i = 0; i < 16; ++i) {
        const size_t item = (size_t)bh * 128 + c0 + i;
        S = gv[i] * S + Lv[i];
        states[item * 16384 + vd] = S;
      }
    }
  }
}

__device__ __forceinline__ void phase_hg_out(const Params& p, int l, char* smem) {
  const u16* Uhg = (const u16*)(p.ws + OFF_UHG);
  const float* states = (const float*)(p.ws + OFF_STATES);
  u16* Y = (u16*)(p.ws + OFF_Y);
  float* bc = (float*)smem;
  float* lbs = (float*)(smem + 33792);
  u16* VTs = (u16*)(smem + 33792 + 512);
  const int tid = TIDX, lane = tid & 63, wave = tid >> 6;
  const int c16 = lane & 15, q = lane >> 4;
  for (int it = BIDX; it < 1024; it += gridDim.x) {
    const int b = it >> 9, h = (it >> 7) & 3, c = it & 127;
    const int t0 = b * SEQL + c * 64;
    hg_bcum(p, l, Uhg, t0, h, bc, lbs);
    {
      const int d = tid & 127;
      for (int idx = tid; idx < 64 * 128; idx += 256) {
        const int s = idx >> 7;
        VTs[d * 72 + s] = Uhg[(size_t)(t0 + s) * 2048 + 1024 + h * 128 + d];
      }
    }
    __syncthreads();
    const int tt = wave * 16 + c16;
    const bool hi = (wave >= 2);
    bf16x8 Qt[4], Qh[4];
#pragma unroll
    for (int ks = 0; ks < 4; ++ks) {
      const int d0 = ks * 32 + q * 8;
      const bf16x8 qraw = *(const bf16x8*)(Uhg + (size_t)(t0 + tt) * 2048 + h * 128 + d0);
#pragma unroll
      for (int j = 0; j < 8; ++j) {
        const float qv = siluf_(bf2f((u16)qraw[j]));
        const float bt = bc[tt * BCS + d0 + j];
        const float rr = hi ? bc[31 * BCS + d0 + j] : 0.f;
        Qt[ks][j] = (short)f2bf(qv * __expf(bt - rr));
        Qh[ks][j] = (short)f2bf(qv * __expf(bt));
      }
    }
    f32x4 at[4];
#pragma unroll
    for (int st = 0; st < 4; ++st) {
      at[st] = (f32x4){0.f, 0.f, 0.f, 0.f};
      if (st <= wave) {
        f32x4 a = {0.f, 0.f, 0.f, 0.f};
        const int srow = st * 16 + c16;
#pragma unroll
        for (int ks = 0; ks < 4; ++ks) {
          const int d0 = ks * 32 + q * 8;
          const bf16x8 zraw = *(const bf16x8*)(Uhg + (size_t)(t0 + srow) * 2048 + 512 + h * 128 + d0);
          bf16x8 kf;
#pragma unroll
          for (int j = 0; j < 8; ++j) {
            const float z = bf2f((u16)zraw[j]);
            const float kk = (1.0f - lbs[d0 + j]) * sigmoidf_(-z);
            const float rr = hi ? bc[31 * BCS + d0 + j] : 0.f;
            const float ex = fminf(rr - bc[srow * BCS + d0 + j], 80.f);
            kf[j] = (short)f2bf(kk * __expf(ex));
          }
          a = mfma16(kf, Qt[ks], a);
        }
#pragma unroll
        for (int r = 0; r < 4; ++r) at[st][r] = ((st * 16 + q * 4 + r) <= tt) ? a[r] : 0.f;
      }
    }
    bf16x8 pb[2];
#pragma unroll
    for (int sp = 0; sp < 2; ++sp)
#pragma unroll
      for (int j = 0; j < 4; ++j) {
        pb[sp][j] = (short)f2bf(at[2 * sp][j]);
        pb[sp][4 + j] = (short)f2bf(at[2 * sp + 1][j]);
      }
    f32x4 o[8];
    float ss = 0.f;
    const float* Sp = states + (size_t)(it - 1) * 16384;
#pragma unroll
    for (int vt = 0; vt < 8; ++vt) {
      f32x4 acc = {0.f, 0.f, 0.f, 0.f};
#pragma unroll
      for (int sp = 0; sp < 2; ++sp) {
        if (2 * sp <= wave) {
          const u16* vr = VTs + (vt * 16 + c16) * 72 + sp * 32 + q * 4;
          const bf16x4 va = *(const bf16x4*)(vr);
          const bf16x4 vb = *(const bf16x4*)(vr + 16);
          bf16x8 vf;
          vf[0] = va[0]; vf[1] = va[1]; vf[2] = va[2]; vf[3] = va[3];
          vf[4] = vb[0]; vf[5] = vb[1]; vf[6] = vb[2]; vf[7] = vb[3];
          acc = mfma16(vf, pb[sp], acc);
        }
      }
      if (c > 0) {
#pragma unroll
        for (int ks = 0; ks < 4; ++ks) {
          const float* sr = Sp + (size_t)(vt * 16 + c16) * 128 + ks * 32 + q * 8;
          const float4 s0v = *(const float4*)(sr);
          const float4 s1v = *(const float4*)(sr + 4);
          bf16x8 sf;
          sf[0] = (short)f2bf(s0v.x); sf[1] = (short)f2bf(s0v.y); sf[2] = (short)f2bf(s0v.z); sf[3] = (short)f2bf(s0v.w);
          sf[4] = (short)f2bf(s1v.x); sf[5] = (short)f2bf(s1v.y); sf[6] = (short)f2bf(s1v.z); sf[7] = (short)f2bf(s1v.w);
          acc = mfma16(sf, Qh[ks], acc);
        }
      }
      o[vt] = acc;
#pragma unroll
      for (int r = 0; r < 4; ++r) ss += acc[r] * acc[r];
    }
    ss += __shfl_xor(ss, 16);
    ss += __shfl_xor(ss, 32);
    const float rinv = rsqrtf(ss * (1.0f / 128.0f) + EPSN);
    const size_t trow = (size_t)(t0 + tt);
#pragma unroll
    for (int vt = 0; vt < 8; ++vt) {
      const int v0 = vt * 16 + q * 4;
      const uint2 graw = *(const uint2*)(Uhg + trow * 2048 + 1536 + h * 128 + v0);
      const float4 gn = *(const float4*)(p.gnorm + l * 128 + v0);
      const float y0 = o[vt][0] * rinv * gn.x * siluf_(bf2f((u16)(graw.x & 0xffff)));
      const float y1 = o[vt][1] * rinv * gn.y * siluf_(bf2f((u16)(graw.x >> 16)));
      const float y2 = o[vt][2] * rinv * gn.z * siluf_(bf2f((u16)(graw.y & 0xffff)));
      const float y3 = o[vt][3] * rinv * gn.w * siluf_(bf2f((u16)(graw.y >> 16)));
      uint2 w;
      w.x = (u32)f2bf(y0) | ((u32)f2bf(y1) << 16);
      w.y = (u32)f2bf(y2) | ((u32)f2bf(y3) << 16);
      *(uint2*)(Y + trow * 1536 + 512 + h * 128 + v0) = w;
    }
    __syncthreads();
  }
}


#define XB_TMO      128
#define XB_XCNT(j)  (256  + 64 * (j))
#define XB_XSUB(j)  (1280 + 64 * (j))
#define XB_XGEN(j)  (2304 + 64 * (j))
#define XB_TOP      3328
#define XB_TOPGEN   3392
#define XCD_BAR_WORDS 3456
#define XB_SPIN_CAP (1u << 18)
#define LAS __attribute__((address_space(3)))

__device__ __forceinline__ unsigned xb_ld(unsigned* p)              { return __hip_atomic_load(p, __ATOMIC_RELAXED, __HIP_MEMORY_SCOPE_AGENT); }
__device__ __forceinline__ unsigned xb_add(unsigned* p, unsigned v) { return __hip_atomic_fetch_add(p, v, __ATOMIC_RELAXED, __HIP_MEMORY_SCOPE_AGENT); }
__device__ __forceinline__ unsigned xb_xcc_id() { return (unsigned)__builtin_amdgcn_s_getreg((3 << 11) | 20) & 0xFu; }
#define XB_SPIN(cond, bar) do { unsigned _sp = 0; while (cond) { __builtin_amdgcn_s_sleep(1); \
    if ((++_sp & 255u) == 0u) { if (xb_ld(&(bar)[XB_TMO])) break; if (_sp > XB_SPIN_CAP) { atomicAdd(&(bar)[XB_TMO], 1u); break; } } } } while (0)

struct XcdBarrier { unsigned* bar; unsigned x; volatile LAS unsigned* st; };

__device__ __forceinline__ XcdBarrier xcd_barrier_post(unsigned* bar, volatile LAS unsigned* st) {
    XcdBarrier b; b.bar = bar; b.x = xb_xcc_id(); b.st = st;
    if (threadIdx.x == 0) (void)xb_add(&bar[XB_XCNT(b.x)], 1u);
    return b;
}
__device__ __forceinline__ void xcd_barrier_complete(unsigned* bar, unsigned x, unsigned& nloc, unsigned& nx) {
    const unsigned G = gridDim.x * gridDim.y * gridDim.z;
    unsigned sum, cnt, mine, sp = 0u;
    for (;;) {
        sum = 0u; cnt = 0u; mine = 0u;
#pragma unroll
        for (unsigned j = 0; j < 16; ++j) { const unsigned c = xb_ld(&bar[XB_XCNT(j)]); sum += c; cnt += (c > 0u) ? 1u : 0u; mine = (j == x) ? c : mine; }
        if (sum == G) break;
        __builtin_amdgcn_s_sleep(1);
        if ((++sp & 255u) == 0u) { if (xb_ld(&bar[XB_TMO])) break; if (sp > XB_SPIN_CAP) { atomicAdd(&bar[XB_TMO], 1u); break; } }
    }
    nloc = mine > 0u ? mine : 1u; nx = cnt > 0u ? cnt : 1u;
}
__device__ __forceinline__ void xcd_barrier(const XcdBarrier& b) {
    asm volatile("s_waitcnt vmcnt(0)" ::: "memory");
    __syncthreads();
    if (threadIdx.x == 0) {
        unsigned* bar = b.bar;
        __builtin_amdgcn_s_waitcnt(0);
        unsigned nloc = b.st[0], nx = b.st[1];
        if (nloc == 0u) { xcd_barrier_complete(bar, b.x, nloc, nx); b.st[0] = nloc; b.st[1] = nx; }
        const unsigned old = xb_add(&bar[XB_XSUB(b.x)], 1u);
        const unsigned gen = old / nloc;
        if (old + 1u == (gen + 1u) * nloc) {
            __builtin_amdgcn_fence(__ATOMIC_RELEASE, "agent");
            asm volatile("s_waitcnt vmcnt(0)" ::: "memory");
            const unsigned og = xb_add(&bar[XB_TOP], 1u);
            const unsigned tg = og / nx;
            if (og + 1u == (tg + 1u) * nx) xb_add(&bar[XB_TOPGEN], 1u);
            else XB_SPIN(xb_ld(&bar[XB_TOPGEN]) == tg, bar);
            __builtin_amdgcn_fence(__ATOMIC_ACQUIRE, "agent");
            xb_add(&bar[XB_XGEN(b.x)], 1u);
            asm volatile("s_waitcnt vmcnt(0)" ::: "memory");
        } else {
            XB_SPIN(xb_ld(&bar[XB_XGEN(b.x)]) == gen, bar);
            __builtin_amdgcn_fence(__ATOMIC_ACQUIRE, "agent");
            asm volatile("s_waitcnt vmcnt(0)" ::: "memory");
        }
    }
    __syncthreads();
}

#define SMEM_BYTES 73728
#ifndef XREP
#define XREP 0
#endif
#ifndef REPMASK
#define REPMASK 0
#endif
#define NREP(st) (((st) >= 0 && (st) != 2 && (st) != 7 && (st) != 11 && (st) != 14 && ((REPMASK >> (st)) & 1)) ? 2 : 1)
__global__ void __launch_bounds__(256, 2) mega(Params p) {
  cg::grid_group grid = cg::this_grid();
  __shared__ __attribute__((aligned(16))) char smem[SMEM_BYTES];
  __shared__ uint4 xb_words;
  u16* sm16 = (u16*)smem;
  char* ws = p.ws;
  if (threadIdx.x == 0) xb_words = make_uint4(0u, 0u, 0u, 0u);
  __syncthreads();
  XcdBarrier xb = xcd_barrier_post((unsigned*)(ws + OFF_BAR), (volatile LAS unsigned*)&xb_words);
  for (int gs = -1; gs < 60; ++gs) {
    const int l = (gs < 0) ? 0 : gs / 15;
    const int st = (gs < 0) ? -1 : gs % 15;
    const float* g = p.gains + (size_t)l * 6 * 1024;
    for (int rep_ = 0; rep_ < NREP(st); ++rep_) {
    if (st == 0 || st == 12) {
      phase_ffn_up(p, (const u16*)(ws + (st == 0 ? W_GU0 : W_GU1)), sm16);
    } else if (st == 1 || st == 10 || st == 13) {
      const u16* A = (const u16*)(ws + (st == 10 ? OFF_H : OFF_ACT));
      const u16* Bt = (const u16*)(ws + (st == 10 ? W_OUT : (st == 1 ? W_D0 : W_D1)));
      const int K = (st == 10) ? 1024 : DFF;
      float* outp = (float*)(ws + (st == 10 ? OFF_D2 : OFF_D));
      phase_gemm_f32(A, K, Bt, K, K, 128, 8, outp, 1024, sm16);
    } else if (st == -1 || st == 2 || st == 11 || st == 14) {
      if (st == -1) phase_rope_table(p);
      const int mode = (st == -1) ? 0 : 1;
      const float* D = (const float*)(ws + (st == 11 ? OFF_D2 : OFF_D));
      const float* gD = g + (st == 2 ? 1 : (st == 11 ? 3 : 5)) * 1024;
      const float scale = (st == 11) ? 1.0f : 0.5f;
      const float* gH = (st == -1) ? g : g + (st == 2 ? 2 : (st == 11 ? 4 : 6)) * 1024;
      const bool writeH = !(st == 14 && l == 3);
      phase_norm(p, mode, D, gD, scale, gH, writeH);
      if (st == -1 || (st == 14 && l < 3)) phase_convert(p, (st == -1) ? 0 : l + 1, (float*)smem);
    } else if (st == 3 || st == 5) {
      if (st == 5) phase_cmp1(p, sm16);
      phase_win(p, st == 5 ? 1 : 0, sm16);
    } else if (st == 4) {
      phase_prep(p, l);
    } else if (st == 6) {
      phase_cmp2(p, l);
      phase_hg_local(p, l, smem);
    } else if (st == 7) {
      for (int r2_ = 0; r2_ < (XREP == 1 ? 2 : 1); ++r2_) phase_nsa_attn(p, smem);
      phase_hg_scan(p);
    } else if (st == 8) {
      phase_hg_out(p, l, smem);
    } else if (st == 9) {
      phase_merge(p, sm16);
    }
    }
    if (gs < 0) grid.sync();
    else if (gs < 59) xcd_barrier(xb);
    if (XREP == 2 && gs < 59) xcd_barrier(xb);
  }
}

extern "C" void kernel_launch(void* const* d_in, const int* in_sizes, int n_in,
                              void* d_out, int out_size, void* d_ws, size_t ws_size,
                              hipStream_t stream) {
  static int grid_blocks = 0;
  if (!grid_blocks) {
    int dev = 0, cus = 0, per_cu = 0;
    hipGetDevice(&dev);
    hipDeviceGetAttribute(&cus, hipDeviceAttributeMultiprocessorCount, dev);
    hipOccupancyMaxActiveBlocksPerMultiprocessor(&per_cu, mega, 256, 0);
    if (per_cu > 2) per_cu = 2;
    if (per_cu < 1) per_cu = 1;
    grid_blocks = cus * per_cu;
  }
  if (ws_size < (size_t)WS_NEEDED) {
    fprintf(stderr, "workspace too small: %zu < %zu\n", ws_size, (size_t)WS_NEEDED);
    return;
  }
  Params p{};
  p.x_in = (const float*)d_in[0];
  p.pos = (const int*)d_in[1];
  p.lb_logits = (const float*)d_in[2];
  p.gains = (const float*)d_in[3];
  p.wg = (const float*)d_in[4];
  p.wu = (const float*)d_in[5];
  p.wd = (const float*)d_in[6];
  p.win = (const float*)d_in[7];
  p.convw = (const float*)d_in[8];
  p.gnorm = (const float*)d_in[9];
  p.pe = (const float*)d_in[10];
  p.cw1 = (const float*)d_in[11];
  p.cw2 = (const float*)d_in[12];
  p.wbr = (const float*)d_in[13];
  p.wout = (const float*)d_in[14];
  p.x = (float*)d_out;
  p.ws = (char*)d_ws;
  hipMemsetAsync((char*)d_ws + OFF_BAR, 0, 16384, stream);
  void* args[] = {&p};
  hipError_t e = hipLaunchCooperativeKernel((void*)mega, dim3(grid_blocks), dim3(256), args, 0, stream);
  if (e != hipSuccess) fprintf(stderr, "coop launch failed: %s (grid %d)\n", hipGetErrorString(e), grid_blocks);
}
```

```cpp
#include <hip/hip_runtime.h>
#include <hip/hip_cooperative_groups.h>
#include <cstdio>
namespace cg = cooperative_groups;

typedef unsigned short u16;
typedef unsigned int u32;
typedef __attribute__((ext_vector_type(8))) short bf16x8;
typedef __attribute__((ext_vector_type(4))) short bf16x4;
typedef __attribute__((ext_vector_type(4))) float f32x4;

#define T_TOK 16384
#define SEQL 8192
#define DM 1024
#define DFF 2816
#define EPSN 1e-6f

#define W_GU0 0ul
#define W_D0 11534336ul
#define W_GU1 17301504ul
#define W_D1 28835840ul
#define W_IN 34603008ul
#define W_BR 51118080ul
#define W_OUT 54263808ul
#define W_C1 56360960ul
#define OFF_H 58458112ul
#define OFF_ACT 92012544ul
#define OFF_STATES OFF_ACT
#define OFF_KR (OFF_ACT + 67108864ul)
#define OFF_VT (OFF_KR + 12582912ul)
#define OFF_D 184287232ul
#define OFF_Y OFF_D
#define OFF_IMP (OFF_D + 50331648ul)
#define OFF_U1 251396096ul
#define OFF_UCONV OFF_U1
#define OFF_UNSA (OFF_U1 + 50331648ul)
#define OFF_UHG OFF_U1
#define OFF_D2 OFF_U1
#define OFF_UMG 347865088ul
#define OFF_QR 448528384ul
#define OFF_CMPA (OFF_QR + 16777216ul)
#define OFF_OCMP (OFF_CMPA + 16777216ul)
#define OFF_ROPE 498860032ul
#define OFF_HC (OFF_ROPE + 4194304ul)
#define OFF_GATES (OFF_HC + 2097152ul)
#define OFF_GDEC (OFF_GATES + 1572864ul)
#define OFF_KCMP (OFF_GDEC + 524288ul)
#define OFF_VCMP (OFF_KCMP + 262144ul)
#define OFF_BAR (OFF_VCMP + 262144ul)
#define WS_NEEDED (OFF_BAR + 16384ul)

struct Params {
  const float* x_in; const int* pos; const float* lb_logits; const float* gains;
  const float* wg; const float* wu; const float* wd; const float* win; const float* convw;
  const float* gnorm; const float* pe; const float* cw1; const float* cw2; const float* wbr; const float* wout;
  float* x; char* ws;
};

__device__ __forceinline__ int opaque_tid() { int t = threadIdx.x; asm volatile("" : "+v"(t)); return t; }
__device__ __forceinline__ int opaque_bid() { int t = blockIdx.x; asm volatile("" : "+s"(t)); return t; }
#define TIDX opaque_tid()
#define BIDX opaque_bid()

__device__ __forceinline__ u16 f2bf(float f) {
  u32 u = __float_as_uint(f);
  u += 0x7fffu + ((u >> 16) & 1u);
  return (u16)(u >> 16);
}
__device__ __forceinline__ float bf2f(u16 h) { return __uint_as_float(((u32)h) << 16); }
__device__ __forceinline__ float sigmoidf_(float x) { return 1.0f / (1.0f + __expf(-x)); }
__device__ __forceinline__ float siluf_(float x) { return x / (1.0f + __expf(-x)); }
__device__ __forceinline__ float wave_sum(float v) {
#pragma unroll
  for (int o = 32; o; o >>= 1) v += __shfl_xor(v, o);
  return v;
}
__device__ __forceinline__ int kfrag_off(int key, int d);
__device__ __forceinline__ int vfrag_off(int d, int key);
__device__ __forceinline__ f32x4 mfma16(bf16x8 a, bf16x8 b, f32x4 c) {
  return __builtin_amdgcn_mfma_f32_16x16x32_bf16(a, b, c, 0, 0, 0);
}

#define LSTR 72
template <int NJ>
__device__ __forceinline__ void gemm_acc(f32x4 (&acc)[4][NJ], const u16* __restrict__ A, int lda,
                                         const u16* __restrict__ Bt, int ldb, int kbeg, int kend,
                                         int row0, int col0, u16* smem) {
  const int tid = TIDX;
  const int lane = tid & 63, wave = tid >> 6;
  const int wm = wave >> 1, wn = wave & 1;
  u16* sA = smem;
  u16* sB = smem + 2 * 128 * LSTR;
  const int lrow = tid >> 3, lkc = tid & 7;
  const u16* Ag = A + (size_t)(row0 + lrow) * lda + kbeg + lkc * 8;
  const u16* Bg = Bt + (size_t)(col0 + lrow) * ldb + kbeg + lkc * 8;
  const size_t a32 = (size_t)32 * lda, b32 = (size_t)32 * ldb;
  uint4 ra0, ra1, ra2, ra3, rb0, rb1, rb2, rb3;
  const int nk = (kend - kbeg) >> 6;
  ra0 = *(const uint4*)(Ag); ra1 = *(const uint4*)(Ag + a32); ra2 = *(const uint4*)(Ag + 2 * a32); ra3 = *(const uint4*)(Ag + 3 * a32);
  rb0 = *(const uint4*)(Bg); rb1 = *(const uint4*)(Bg + b32);
  if (NJ == 4) { rb2 = *(const uint4*)(Bg + 2 * b32); rb3 = *(const uint4*)(Bg + 3 * b32); }
  {
    u16* wa = sA + lrow * LSTR + lkc * 8;
    u16* wb = sB + lrow * LSTR + lkc * 8;
    *(uint4*)(wa) = ra0; *(uint4*)(wa + 32 * LSTR) = ra1; *(uint4*)(wa + 64 * LSTR) = ra2; *(uint4*)(wa + 96 * LSTR) = ra3;
    *(uint4*)(wb) = rb0; *(uint4*)(wb + 32 * LSTR) = rb1;
    if (NJ == 4) { *(uint4*)(wb + 64 * LSTR) = rb2; *(uint4*)(wb + 96 * LSTR) = rb3; }
  }
  __syncthreads();
  for (int kt = 0; kt < nk; ++kt) {
    const int buf = kt & 1;
    const bool more = (kt + 1 < nk);
    if (more) {
      const u16* Ak = Ag + (kt + 1) * 64;
      const u16* Bk = Bg + (kt + 1) * 64;
      ra0 = *(const uint4*)(Ak); ra1 = *(const uint4*)(Ak + a32); ra2 = *(const uint4*)(Ak + 2 * a32); ra3 = *(const uint4*)(Ak + 3 * a32);
      rb0 = *(const uint4*)(Bk); rb1 = *(const uint4*)(Bk + b32);
      if (NJ == 4) { rb2 = *(const uint4*)(Bk + 2 * b32); rb3 = *(const uint4*)(Bk + 3 * b32); }
    }
    __builtin_amdgcn_sched_barrier(0);
    const u16* a = sA + buf * 128 * LSTR + (wm * 64 + (lane & 15)) * LSTR + (lane >> 4) * 8;
    const u16* b = sB + buf * 128 * LSTR + (wn * (NJ * 16) + (lane & 15)) * LSTR + (lane >> 4) * 8;
#pragma unroll
    for (int ks = 0; ks < 2; ++ks) {
      bf16x8 af[4], bfr[NJ];
#pragma unroll
      for (int i = 0; i < 4; ++i) af[i] = *(const bf16x8*)(a + i * 16 * LSTR + ks * 32);
#pragma unroll
      for (int j = 0; j < NJ; ++j) bfr[j] = *(const bf16x8*)(b + j * 16 * LSTR + ks * 32);
#pragma unroll
      for (int i = 0; i < 4; ++i)
#pragma unroll
        for (int j = 0; j < NJ; ++j) acc[i][j] = mfma16(af[i], bfr[j], acc[i][j]);
    }
    __builtin_amdgcn_sched_barrier(0);
    if (more) {
      const int nb = buf ^ 1;
      u16* wa = sA + nb * 128 * LSTR + lrow * LSTR + lkc * 8;
      u16* wb = sB + nb * 128 * LSTR + lrow * LSTR + lkc * 8;
      *(uint4*)(wa) = ra0; *(uint4*)(wa + 32 * LSTR) = ra1; *(uint4*)(wa + 64 * LSTR) = ra2; *(uint4*)(wa + 96 * LSTR) = ra3;
      *(uint4*)(wb) = rb0; *(uint4*)(wb + 32 * LSTR) = rb1;
      if (NJ == 4) { *(uint4*)(wb + 64 * LSTR) = rb2; *(uint4*)(wb + 96 * LSTR) = rb3; }
    }
    __syncthreads();
  }
}

#define ZERO_ACC(acc)                                  \
  _Pragma("unroll") for (int i_ = 0; i_ < 4; ++i_)     \
  _Pragma("unroll") for (int j_ = 0; j_ < 4; ++j_) { acc[i_][j_] = (f32x4){0.f, 0.f, 0.f, 0.f}; }

#define CONV_ITEMS 7136
__device__ __forceinline__ void convert_tile(const Params& p, int l, int item, float* tile) {
  const int tid = TIDX;
  int id, loc;
  if (item < 1408) { id = 0; loc = item; }
  else if (item < 2112) { id = 1; loc = item - 1408; }
  else if (item < 3520) { id = 2; loc = item - 2112; }
  else if (item < 4224) { id = 3; loc = item - 3520; }
  else if (item < 6240) { id = 4; loc = item - 4224; }
  else if (item < 6624) { id = 5; loc = item - 6240; }
  else if (item < 6880) { id = 6; loc = item - 6624; }
  else { id = 7; loc = item - 6880; }
  int KT = 16;
  if (id == 1 || id == 3) KT = 44; else if (id == 5) KT = 24; else if (id == 7) KT = 32;
  const int nt = loc / KT, kt = loc % KT;
  const int n0 = nt * 64, k0 = kt * 64;
  const int tn = tid & 63, tk = tid >> 6;
  const int n = n0 + tn;
  const float* src = nullptr; size_t ldsrc = 0; bool zero = false;
  u16* dst = nullptr; int lddst = 0;
  char* ws = p.ws;
  if (id == 0 || id == 2) {
    const int f = id >> 1;
    const int pp = n >> 5, s = (n >> 4) & 1, i = n & 15;
    src = (s ? p.wu : p.wg) + (size_t)(l * 2 + f) * 1024 * DFF + (pp * 16 + i);
    ldsrc = DFF; dst = (u16*)(ws + (f ? W_GU1 : W_GU0)); lddst = 1024;
  } else if (id == 1 || id == 3) {
    const int f = id >> 1;
    src = p.wd + (size_t)(l * 2 + f) * DFF * 1024 + n;
    ldsrc = 1024; dst = (u16*)(ws + (f ? W_D1 : W_D0)); lddst = DFF;
  } else if (id == 4) {
    int col = n;
    if (n >= 4888 && n < 4992) { zero = true; col = 0; }
    else if (n >= 4992) col = n - 104;
    src = p.win + (size_t)l * 1024 * 7960 + col;
    ldsrc = 7960; dst = (u16*)(ws + W_IN); lddst = 1024;
  } else if (id == 5) {
    src = p.wbr + (size_t)l * 1536 * 1024 + n;
    ldsrc = 1024; dst = (u16*)(ws + W_BR); lddst = 1536;
  } else if (id == 6) {
    src = p.wout + (size_t)l * 1024 * 1024 + n;
    ldsrc = 1024; dst = (u16*)(ws + W_OUT); lddst = 1024;
  } else {
    const int m = n >> 8, nn = n & 255;
    src = p.cw1 + (size_t)(l * 2 + m) * 2048 * 256 + nn;
    ldsrc = 256; dst = (u16*)(ws + W_C1); lddst = 2048;
  }
#pragma unroll 4
  for (int it = 0; it < 16; ++it) {
    const int k = it * 4 + tk;
    tile[k * 65 + tn] = zero ? 0.f : src[(size_t)(k0 + k) * ldsrc];
  }
  __syncthreads();
#pragma unroll 4
  for (int it = 0; it < 16; ++it) {
    const int nn = it * 4 + tk, kk = tid & 63;
    dst[(size_t)(n0 + nn) * lddst + k0 + kk] = f2bf(tile[kk * 65 + nn]);
  }
  __syncthreads();
}

__device__ __forceinline__ void phase_convert(const Params& p, int l, float* tile) {
  for (int it = BIDX; it < CONV_ITEMS; it += gridDim.x) convert_tile(p, l, it, tile);
}

__device__ __forceinline__ void phase_norm(const Params& p, int mode, const float* D, const float* gD, float scale,
                           const float* gH, bool writeH) {
  const int lane = TIDX & 63, wave = TIDX >> 6;
  u16* H = (u16*)(p.ws + OFF_H);
  for (int it = BIDX; it < T_TOK / 4; it += gridDim.x) {
    const int row = it * 4 + wave;
    const float* xs = (mode == 0 ? p.x_in : p.x) + (size_t)row * DM;
    float4 xv[4];
#pragma unroll
    for (int i = 0; i < 4; ++i) xv[i] = *(const float4*)(xs + i * 256 + lane * 4);
    if (mode == 1) {
      float4 dv[4];
      float ss = 0.f;
#pragma unroll
      for (int i = 0; i < 4; ++i) {
        dv[i] = *(const float4*)(D + (size_t)row * DM + i * 256 + lane * 4);
        ss += dv[i].x * dv[i].x + dv[i].y * dv[i].y + dv[i].z * dv[i].z + dv[i].w * dv[i].w;
      }
      ss = wave_sum(ss);
      const float r = rsqrtf(ss * (1.0f / DM) + EPSN) * scale;
#pragma unroll
      for (int i = 0; i < 4; ++i) {
        const float4 g = *(const float4*)(gD + i * 256 + lane * 4);
        xv[i].x += dv[i].x * r * g.x; xv[i].y += dv[i].y * r * g.y;
        xv[i].z += dv[i].z * r * g.z; xv[i].w += dv[i].w * r * g.w;
      }
    }
#pragma unroll
    for (int i = 0; i < 4; ++i) *(float4*)(p.x + (size_t)row * DM + i * 256 + lane * 4) = xv[i];
    if (writeH) {
      float ss = 0.f;
#pragma unroll
      for (int i = 0; i < 4; ++i) ss += xv[i].x * xv[i].x + xv[i].y * xv[i].y + xv[i].z * xv[i].z + xv[i].w * xv[i].w;
      ss = wave_sum(ss);
      const float r = rsqrtf(ss * (1.0f / DM) + EPSN);
#pragma unroll
      for (int i = 0; i < 4; ++i) {
        const float4 g = *(const float4*)(gH + i * 256 + lane * 4);
        uint2 o;
        o.x = (u32)f2bf(xv[i].x * r * g.x) | ((u32)f2bf(xv[i].y * r * g.y) << 16);
        o.y = (u32)f2bf(xv[i].z * r * g.z) | ((u32)f2bf(xv[i].w * r * g.w) << 16);
        *(uint2*)(H + (size_t)row * DM + i * 256 + lane * 4) = o;
      }
    }
  }
}

__device__ __forceinline__ void phase_rope_table(const Params& p) {
  float2* cs = (float2*)(p.ws + OFF_ROPE);
  const size_t nth = (size_t)gridDim.x * blockDim.x;
  for (size_t e = (size_t)BIDX * blockDim.x + TIDX; e < (size_t)T_TOK * 32; e += nth) {
    const int t = (int)(e >> 5), i = (int)(e & 31);
    const float inv = powf(10000.0f, -(float)i * (2.0f / 64.0f));
    const float ang = (float)p.pos[t] * inv;
    double rev = (double)ang * 0.15915494309189535;
    rev -= floor(rev);
    const float fr = (float)rev;
    cs[e] = make_float2(__builtin_amdgcn_cosf(fr), __builtin_amdgcn_sinf(fr));
  }
}

__device__ __forceinline__ void phase_ffn_up(const Params& p, const u16* Wgu, u16* smem) {
  const u16* H = (const u16*)(p.ws + OFF_H);
  u16* act = (u16*)(p.ws + OFF_ACT);
  const int lane = TIDX & 63, wave = TIDX >> 6;
  const int wm = wave >> 1, wn = wave & 1;
  const int bid_ = BIDX;
  for (int lt = bid_ >> 3; lt < 16 * 44; lt += (gridDim.x >> 3)) {
    const int rest_ = lt >> 3;
    const int nt = rest_ % 44, mt = (bid_ & 7) * 16 + (rest_ / 44) * 8 + (lt & 7);
    f32x4 acc[4][4];
    ZERO_ACC(acc);
    gemm_acc<4>(acc, H, 1024, Wgu, 1024, 0, 1024, mt * 128, nt * 128, smem);
#pragma unroll
    for (int i = 0; i < 4; ++i)
#pragma unroll
      for (int jp = 0; jp < 2; ++jp) {
        const int col = (nt * 4 + wn * 2 + jp) * 16 + (lane & 15);
#pragma unroll
        for (int r = 0; r < 4; ++r) {
          const int row = mt * 128 + wm * 64 + i * 16 + (lane >> 4) * 4 + r;
          const float g = acc[i][2 * jp][r], u = acc[i][2 * jp + 1][r];
          act[(size_t)row * DFF + col] = f2bf(siluf_(g) * u);
        }
      }
  }
}

__device__ __forceinline__ void phase_gemm_f32(const u16* A, int lda, const u16* Bt, int ldb, int K, int MT, int NT,
                               float* out, int ldo, u16* smem) {
  const int lane = TIDX & 63, wave = TIDX >> 6;
  const int wm = wave >> 1, wn = wave & 1;
  const int bid_ = BIDX;
  for (int lt = bid_ >> 3; lt < (MT >> 3) * NT; lt += (gridDim.x >> 3)) {
    const int rest_ = lt >> 3;
    const int nt = rest_ % NT, mt = (bid_ & 7) * (MT >> 3) + (rest_ / NT) * 8 + (lt & 7);
    f32x4 acc[4][4];
    ZERO_ACC(acc);
    gemm_acc<4>(acc, A, lda, Bt, ldb, 0, K, mt * 128, nt * 128, smem);
#pragma unroll
    for (int i = 0; i < 4; ++i)
#pragma unroll
      for (int j = 0; j < 4; ++j) {
        const int col = nt * 128 + wn * 64 + j * 16 + (lane & 15);
#pragma unroll
        for (int r = 0; r < 4; ++r) {
          const int row = mt * 128 + wm * 64 + i * 16 + (lane >> 4) * 4 + r;
          out[(size_t)row * ldo + col] = acc[i][j][r];
        }
      }
  }
}

__device__ __forceinline__ void phase_win(const Params& p, int part, u16* smem) {
  const u16* H = (const u16*)(p.ws + OFF_H);
  const u16* W = (const u16*)(p.ws + W_IN);
  const int lane = TIDX & 63, wave = TIDX >> 6;
  const int wm = wave >> 1, wn = wave & 1;
  const int NT = part ? 40 : 23;
  const int bid_ = BIDX;
  for (int lt = bid_ >> 3; lt < 16 * NT; lt += (gridDim.x >> 3)) {
    const int rest_ = lt >> 3;
    const int nl = rest_ % NT, mt = (bid_ & 7) * 16 + (rest_ / NT) * 8 + (lt & 7);
    int ct;
    if (part == 0) ct = (nl < 12) ? nl : (28 + nl - 12);
    else ct = (nl < 16) ? (12 + nl) : (39 + nl - 16);
    u16* dst; int ld, cb;
    if (ct < 12) { dst = (u16*)(p.ws + OFF_UCONV); ld = 1536; cb = ct * 128; }
    else if (ct < 28) { dst = (u16*)(p.ws + OFF_UHG); ld = 2048; cb = (ct - 12) * 128; }
    else if (ct < 39) { dst = (u16*)(p.ws + OFF_UNSA); ld = 1408; cb = (ct - 28) * 128; }
    else { dst = (u16*)(p.ws + OFF_UMG); ld = 3072; cb = (ct - 39) * 128; }
    f32x4 acc[4][4];
    ZERO_ACC(acc);
    gemm_acc<4>(acc, H, 1024, W, 1024, 0, 1024, mt * 128, ct * 128, smem);
#pragma unroll
    for (int i = 0; i < 4; ++i)
#pragma unroll
      for (int j = 0; j < 4; ++j) {
        const int col = cb + wn * 64 + j * 16 + (lane & 15);
#pragma unroll
        for (int r = 0; r < 4; ++r) {
          const int row = mt * 128 + wm * 64 + i * 16 + (lane >> 4) * 4 + r;
          dst[(size_t)row * ld + col] = f2bf(acc[i][j][r]);
        }
      }
  }
}

__device__ __forceinline__ void phase_cmp1(const Params& p, u16* smem) {
  const int lane = TIDX & 63, wave = TIDX >> 6;
  const int wm = wave >> 1, wn = wave & 1;
  for (int it = BIDX; it < 64; it += gridDim.x) {
    const int m = it >> 5, mt = (it >> 1) & 15, nt = it & 1;
    const u16* A = (const u16*)(p.ws + OFF_CMPA) + (size_t)m * 2048 * 2048;
    const u16* Bt = (const u16*)(p.ws + W_C1) + (size_t)m * 256 * 2048;
    u16* Hc = (u16*)(p.ws + OFF_HC) + (size_t)m * 2048 * 256;
    f32x4 acc[4][4];
    ZERO_ACC(acc);
    gemm_acc<4>(acc, A, 2048, Bt, 2048, 0, 2048, mt * 128, nt * 128, smem);
#pragma unroll
    for (int i = 0; i < 4; ++i)
#pragma unroll
      for (int j = 0; j < 4; ++j) {
        const int col = nt * 128 + wn * 64 + j * 16 + (lane & 15);
#pragma unroll
        for (int r = 0; r < 4; ++r) {
          const int row = mt * 128 + wm * 64 + i * 16 + (lane >> 4) * 4 + r;
          const float x = acc[i][j][r];
          const float u = 0.7978845608028654f * (x + 0.044715f * x * x * x);
          Hc[(size_t)row * 256 + col] = f2bf(x * sigmoidf_(2.0f * u));
        }
      }
  }
}

__device__ __forceinline__ void phase_cmp2(const Params& p, int l) {
  const u16* Hc = (const u16*)(p.ws + OFF_HC);
  u16* kcmp = (u16*)(p.ws + OFF_KCMP);
  u16* vcmpT = (u16*)(p.ws + OFF_VCMP);
  const size_t nth = (size_t)gridDim.x * blockDim.x;
  for (size_t e = (size_t)BIDX * blockDim.x + TIDX; e < (size_t)2 * 2048 * 64; e += nth) {
    const int m = (int)(e >> 17);
    const int rem = (int)(e & 131071);
    const int row = rem >> 6, d = rem & 63;
    if (row < 2044) {
      const u16* hr = Hc + ((size_t)m * 2048 + row) * 256;
      const float* w2 = p.cw2 + (size_t)(l * 2 + m) * 256 * 64 + d;
      float acc = 0.f;
#pragma unroll 8
      for (int k = 0; k < 256; ++k) acc += bf2f(hr[k]) * w2[k * 64];
      const int b = row / 1022, r2 = row % 1022;
      const int n = r2 >> 1, kh = r2 & 1;
      if (m == 0) kcmp[((size_t)(b * 2 + kh) * 8 + (n >> 6)) * 4096 + kfrag_off(n & 63, d)] = f2bf(acc);
      else vcmpT[((size_t)(b * 2 + kh) * 8 + (n >> 6)) * 4096 + vfrag_off(d, n & 63)] = f2bf(acc);
    } else {
      const int bk = row - 2044;
      if (m == 0) kcmp[((size_t)bk * 8 + 7) * 4096 + kfrag_off(63, d)] = 0;
      else vcmpT[((size_t)bk * 8 + 7) * 4096 + vfrag_off(d, 63)] = 0;
    }
  }
}

__device__ __forceinline__ void phase_merge(const Params& p, u16* smem) {
  const u16* Y = (const u16*)(p.ws + OFF_Y);
  const u16* W = (const u16*)(p.ws + W_BR);
  const u16* MG = (const u16*)(p.ws + OFF_UMG);
  u16* outp = (u16*)(p.ws + OFF_H);
  const int lane = TIDX & 63, wave = TIDX >> 6;
  const int wm = wave >> 1, wn = wave & 1;
  const int bid_ = BIDX;
  for (int lt = bid_ >> 3; lt < 16 * 16; lt += (gridDim.x >> 3)) {
    const int rest_ = lt >> 3;
    const int nt = rest_ & 15, mt = (bid_ & 7) * 16 + (rest_ >> 4) * 8 + (lt & 7);
    f32x4 tot[4][2];
#pragma unroll
    for (int i = 0; i < 4; ++i)
#pragma unroll
      for (int j = 0; j < 2; ++j) tot[i][j] = (f32x4){0.f, 0.f, 0.f, 0.f};
    for (int n = 0; n < 3; ++n) {
      f32x4 acc[4][2];
#pragma unroll
      for (int i = 0; i < 4; ++i)
#pragma unroll
        for (int j = 0; j < 2; ++j) acc[i][j] = (f32x4){0.f, 0.f, 0.f, 0.f};
      gemm_acc<2>(acc, Y, 1536, W, 1536, n * 512, n * 512 + 512, mt * 128, nt * 64, smem);
#pragma unroll
      for (int i = 0; i < 4; ++i)
#pragma unroll
        for (int j = 0; j < 2; ++j) {
          const int col = nt * 64 + wn * 32 + j * 16 + (lane & 15);
#pragma unroll
          for (int r = 0; r < 4; ++r) {
            const int row = mt * 128 + wm * 64 + i * 16 + (lane >> 4) * 4 + r;
            const float g = sigmoidf_(bf2f(MG[(size_t)row * 3072 + n * 1024 + col]));
            tot[i][j][r] += g * acc[i][j][r];
          }
        }
    }
#pragma unroll
    for (int i = 0; i < 4; ++i)
#pragma unroll
      for (int j = 0; j < 2; ++j) {
        const int col = nt * 64 + wn * 32 + j * 16 + (lane & 15);
#pragma unroll
        for (int r = 0; r < 4; ++r) {
          const int row = mt * 128 + wm * 64 + i * 16 + (lane >> 4) * 4 + r;
          outp[(size_t)row * 1024 + col] = f2bf(tot[i][j][r]);
        }
      }
  }
}

__device__ __forceinline__ void phase_prep(const Params& p, int l) {
  const u16* Uc = (const u16*)(p.ws + OFF_UCONV);
  const u16* Un = (const u16*)(p.ws + OFF_UNSA);
  u16* Y = (u16*)(p.ws + OFF_Y);
  u16* qr = (u16*)(p.ws + OFF_QR);
  u16* KR = (u16*)(p.ws + OFF_KR);
  u16* VT = (u16*)(p.ws + OFF_VT);
  u16* CA = (u16*)(p.ws + OFF_CMPA);
  float* gates = (float*)(p.ws + OFF_GATES);
  const float2* cs = (const float2*)(p.ws + OFF_ROPE);
  const int tid = TIDX;
  const size_t nth = (size_t)gridDim.x * blockDim.x;
  const size_t gt = (size_t)BIDX * blockDim.x + tid;
  for (size_t e = gt; e < (size_t)T_TOK * 512; e += nth) {
    const int t = (int)(e >> 9), c = (int)(e & 511);
    const int s = t & (SEQL - 1);
    const float w0 = p.convw[(l * 3 + 0) * 512 + c], w1 = p.convw[(l * 3 + 1) * 512 + c], w2 = p.convw[(l * 3 + 2) * 512 + c];
    const u16* r2 = Uc + (size_t)t * 1536;
    const float v2 = bf2f(r2[512 + c]) * bf2f(r2[1024 + c]);
    float v1 = 0.f, v0 = 0.f;
    if (s >= 1) { const u16* r1 = r2 - 1536; v1 = bf2f(r1[512 + c]) * bf2f(r1[1024 + c]); }
    if (s >= 2) { const u16* r0 = r2 - 3072; v0 = bf2f(r0[512 + c]) * bf2f(r0[1024 + c]); }
    Y[(size_t)t * 1536 + c] = f2bf(bf2f(r2[c]) * (w0 * v0 + w1 * v1 + w2 * v2));
  }
  for (size_t e = gt; e < (size_t)2 * 4 * 2048; e += nth) {
    const int m = (int)(e >> 13), rem = (int)(e & 8191);
    CA[((size_t)m * 2048 + 2044) * 2048 + rem] = 0;
  }
  const float* pek = p.pe + (size_t)(l * 2 + 0) * 2048;
  const float* pev = p.pe + (size_t)(l * 2 + 1) * 2048;
  for (int it = BIDX; it < 1024; it += gridDim.x) {
    const int b = it >> 9, ch = it & 511;
    const int s0 = ch * 16, t0 = b * SEQL + s0;
    for (int idx = tid; idx < 4096; idx += 256) {
      const int i = idx >> 8, pr = idx & 255;
      const int head = pr >> 5, d = pr & 31;
      const int t = t0 + i;
      const float2 c_s = cs[(size_t)t * 32 + d];
      const float x1 = bf2f(Un[(size_t)t * 1408 + head * 64 + d]);
      const float x2 = bf2f(Un[(size_t)t * 1408 + head * 64 + 32 + d]);
      qr[(size_t)t * 512 + head * 64 + d] = f2bf(x1 * c_s.x - x2 * c_s.y);
      qr[(size_t)t * 512 + head * 64 + 32 + d] = f2bf(x2 * c_s.x + x1 * c_s.y);
    }
    for (int idx = tid; idx < 3072; idx += 256) {
      const int i = idx / 192, rem = idx % 192;
      const int m = rem >> 6, hp = rem & 63;
      const int kh = hp >> 5, d = hp & 31;
      const int t = t0 + i;
      const float2 c_s = cs[(size_t)t * 32 + d];
      const int col = 512 + m * 256 + kh * 64;
      const float x1 = bf2f(Un[(size_t)t * 1408 + col + d]);
      const float x2 = bf2f(Un[(size_t)t * 1408 + col + 32 + d]);
      const float o1 = x1 * c_s.x - x2 * c_s.y, o2 = x2 * c_s.x + x1 * c_s.y;
      u16* kd = KR + (size_t)m * 2097152 + ((size_t)(b * 2 + kh) * 128 + (s0 >> 6)) * 4096;
      kd[kfrag_off((s0 & 63) + i, d)] = f2bf(o1); kd[kfrag_off((s0 & 63) + i, 32 + d)] = f2bf(o2);
      if (m == 0) {
        if (ch <= 510) {
          u16* a = CA + ((size_t)((b * 511 + ch) * 2 + kh)) * 2048 + i * 64;
          a[d] = f2bf(o1 + pek[i * 64 + d]); a[32 + d] = f2bf(o2 + pek[i * 64 + 32 + d]);
        }
        if (ch >= 1) {
          u16* a = CA + ((size_t)((b * 511 + ch - 1) * 2 + kh)) * 2048 + (16 + i) * 64;
          a[d] = f2bf(o1 + pek[(16 + i) * 64 + d]); a[32 + d] = f2bf(o2 + pek[(16 + i) * 64 + 32 + d]);
        }
      }
    }
    for (int idx = tid; idx < 2048; idx += 256) {
      const int i = idx >> 7, cc = idx & 127;
      const int kh = cc >> 6, d = cc & 63;
      const int t = t0 + i;
      const float v = bf2f(Un[(size_t)t * 1408 + 640 + cc]);
      u16* CAv = CA + (size_t)2048 * 2048;
      if (ch <= 510) CAv[((size_t)((b * 511 + ch) * 2 + kh)) * 2048 + i * 64 + d] = f2bf(v + pev[i * 64 + d]);
      if (ch >= 1) CAv[((size_t)((b * 511 + ch - 1) * 2 + kh)) * 2048 + (16 + i) * 64 + d] = f2bf(v + pev[(16 + i) * 64 + d]);
    }
    for (int idx = tid; idx < 4096; idx += 256) {
      const int i = idx & 15, cc = idx >> 4;
      const int m = cc >> 7, c2 = cc & 127;
      const int kh = c2 >> 6, d = c2 & 63;
      VT[(size_t)m * 2097152 + ((size_t)(b * 2 + kh) * 128 + (s0 >> 6)) * 4096 + vfrag_off(d, (s0 & 63) + i)] =
          Un[(size_t)(t0 + i) * 1408 + 896 + m * 256 + c2];
    }
    for (int idx = tid; idx < 384; idx += 256) {
      const int i = idx / 24, gI = idx % 24;
      gates[(size_t)(t0 + i) * 24 + gI] = sigmoidf_(bf2f(Un[(size_t)(t0 + i) * 1408 + 1280 + gI]));
    }
  }
}

typedef unsigned long long u64;

__device__ __forceinline__ int kfrag_off(int key, int d) {
  return (((key >> 4) * 2 + (d >> 5)) * 64 + ((d >> 3) & 3) * 16 + (key & 15)) * 8 + (d & 7);
}
__device__ __forceinline__ int vfrag_off(int d, int key) {
  return (((d >> 4) * 2 + (key >> 5)) * 64 + ((key >> 2) & 3) * 16 + (d & 15)) * 8 + ((key >> 4) & 1) * 4 + (key & 3);
}
__device__ __forceinline__ void k_load64(bf16x8 (&kq)[8], const u16* __restrict__ Kp, int lane) {
  const u16* kr = Kp + lane * 8;
#pragma unroll
  for (int i = 0; i < 8; ++i) kq[i] = *(const bf16x8*)(kr + i * 512);
}
__device__ __forceinline__ void v_load64(bf16x8 (&vq)[8], const u16* __restrict__ Vp, int lane) {
  const u16* vr = Vp + lane * 8;
#pragma unroll
  for (int i = 0; i < 8; ++i) vq[i] = *(const bf16x8*)(vr + i * 512);
}
template <class MaskF>
__device__ __forceinline__ void qk64(const bf16x8 (&kq)[8], const bf16x8 (&qf)[2], float scale, MaskF maskf, int lane,
                                     f32x4 (&st)[4]) {
  const int q = lane >> 4;
#pragma unroll
  for (int kt = 0; kt < 4; ++kt) {
    f32x4 z = {0.f, 0.f, 0.f, 0.f};
    z = mfma16(kq[2 * kt], qf[0], z);
    z = mfma16(kq[2 * kt + 1], qf[1], z);
#pragma unroll
    for (int r = 0; r < 4; ++r) st[kt][r] = maskf(kt * 16 + q * 4 + r) ? z[r] * scale : -1e30f;
  }
}
__device__ __forceinline__ void pv64(const bf16x8 (&vq)[8], const f32x4 (&pr)[4], f32x4 (&o)[4]) {
#pragma unroll
  for (int hf = 0; hf < 2; ++hf) {
    bf16x8 pb;
#pragma unroll
    for (int j = 0; j < 4; ++j) { pb[j] = (short)f2bf(pr[2 * hf][j]); pb[4 + j] = (short)f2bf(pr[2 * hf + 1][j]); }
#pragma unroll
    for (int dt = 0; dt < 4; ++dt) o[dt] = mfma16(vq[dt * 2 + hf], pb, o[dt]);
  }
}
__device__ __forceinline__ void softmax_update(f32x4 (&st)[4], float& m, float& lsum, f32x4 (&o)[4]) {
  float mx = -1e30f;
#pragma unroll
  for (int kt = 0; kt < 4; ++kt)
#pragma unroll
    for (int r = 0; r < 4; ++r) mx = fmaxf(mx, st[kt][r]);
  mx = fmaxf(mx, __shfl_xor(mx, 16));
  mx = fmaxf(mx, __shfl_xor(mx, 32));
  const float mnew = fmaxf(m, mx);
  const float alpha = __expf(m - mnew);
  float ps = 0.f;
#pragma unroll
  for (int kt = 0; kt < 4; ++kt)
#pragma unroll
    for (int r = 0; r < 4; ++r) {
      const float pv = (st[kt][r] > -1e29f) ? __expf(st[kt][r] - mnew) : 0.f;
      st[kt][r] = pv;
      ps += pv;
    }
  lsum = lsum * alpha + ps;
  m = mnew;
#pragma unroll
  for (int dt = 0; dt < 4; ++dt) o[dt] *= alpha;
}

#define SB0 __builtin_amdgcn_sched_barrier(0)

__device__ __forceinline__ void phase_nsa_attn(const Params& p, char* smem) {
  const u16* qr = (const u16*)(p.ws + OFF_QR);
  const u16* kcmp = (const u16*)(p.ws + OFF_KCMP);
  const u16* vcmpT = (const u16*)(p.ws + OFF_VCMP);
  const u16* KS = (const u16*)(p.ws + OFF_KR) + (size_t)1 * 2097152;
  const u16* KW = (const u16*)(p.ws + OFF_KR) + (size_t)2 * 2097152;
  const u16* VS = (const u16*)(p.ws + OFF_VT);
  const u16* VW = (const u16*)(p.ws + OFF_VT) + (size_t)2097152;
  const float* gates = (const float*)(p.ws + OFF_GATES);
  u16* Y = (u16*)(p.ws + OFF_Y);
  const int tid = TIDX;
  const int lane = tid & 63, wave = tid >> 6;
  const int c16 = lane & 15, q = lane >> 4;
  const int tq = c16 >> 2, g = c16 & 3;
  const float scale = 0.125f;
  float* impl = (float*)smem + wave * 512;
  const int bid_ = BIDX;
  const int xcd_ = bid_ & 7;
  for (int li = bid_ >> 3; li < 256; li += (gridDim.x >> 3)) {
    const int b = xcd_ >> 2, kh = (xcd_ >> 1) & 1, grp = li * 2 + (xcd_ & 1);
    const int s0 = (grp * 4 + wave) * 4;
    const int s = s0 + tq;
    const int t = b * SEQL + s;
    const int head = kh * 4 + g;
    bf16x8 qf[2];
    qf[0] = *(const bf16x8*)(qr + (size_t)t * 512 + head * 64 + q * 8);
    qf[1] = *(const bf16x8*)(qr + (size_t)t * 512 + head * 64 + 32 + q * 8);
    const float gt0 = gates[(size_t)t * 24 + kh * 12 + g * 3 + 0];
    const float gt1 = gates[(size_t)t * 24 + kh * 12 + g * 3 + 1];
    const float gt2 = gates[(size_t)t * 24 + kh * 12 + g * 3 + 2];
    const size_t kvb = (size_t)(b * 2 + kh);
    f32x4 y[4];
#pragma unroll
    for (int dt = 0; dt < 4; ++dt) y[dt] = (f32x4){0.f, 0.f, 0.f, 0.f};
    bf16x8 kA[8];
    bf16x8 vA[8];

    {
      const int nvalid = (s >= 31) ? (((s - 31) >> 4) + 1) : 0;
      const int slast = s0 + 3;
      const int nvmax = (slast >= 31) ? (((slast - 31) >> 4) + 1) : 0;
      const int ntile = (nvmax + 63) >> 6;
      const u16* Kb = kcmp + kvb * 512 * 64;
      const u16* Vb = vcmpT + kvb * 64 * 512;
      if (ntile > 0) {
        float m = -1e30f, lsum = 0.f;
        k_load64(kA, Kb, lane);
        for (int i = 0; i < ntile; ++i) {
          const int n0 = i * 64;
          const int nn = (i + 1 < ntile ? i + 1 : i) * 64;
          f32x4 st[4];
          qk64(kA, qf, scale, [&](int ko) { return (n0 + ko) < nvalid; }, lane, st);
          SB0;
          k_load64(kA, Kb + (size_t)nn * 64, lane);
          SB0;
          float mx = -1e30f;
#pragma unroll
          for (int kt = 0; kt < 4; ++kt)
#pragma unroll
            for (int r = 0; r < 4; ++r) mx = fmaxf(mx, st[kt][r]);
          mx = fmaxf(mx, __shfl_xor(mx, 16));
          mx = fmaxf(mx, __shfl_xor(mx, 32));
          const float mnew = fmaxf(m, mx);
          float ps = 0.f;
#pragma unroll
          for (int kt = 0; kt < 4; ++kt)
#pragma unroll
            for (int r = 0; r < 4; ++r) ps += (st[kt][r] > -1e29f) ? __expf(st[kt][r] - mnew) : 0.f;
          lsum = lsum * __expf(m - mnew) + ps;
          m = mnew;
        }
        lsum += __shfl_xor(lsum, 16);
        lsum += __shfl_xor(lsum, 32);
        const float invl = (lsum > 0.f) ? 1.0f / lsum : 0.f;
        f32x4 o[4];
#pragma unroll
        for (int dt = 0; dt < 4; ++dt) o[dt] = (f32x4){0.f, 0.f, 0.f, 0.f};
        float carry = 0.f;
      SB0;
        k_load64(kA, Kb, lane);
      SB0;
        v_load64(vA, Vb, lane);
      SB0;
        for (int i = 0; i < ntile; ++i) {
          const int n0 = i * 64;
          const int nn = (i + 1 < ntile ? i + 1 : i) * 64;
          f32x4 st[4];
          qk64(kA, qf, scale, [&](int ko) { return (n0 + ko) < nvalid; }, lane, st);
          SB0;
          k_load64(kA, Kb + (size_t)nn * 64, lane);
          SB0;
#pragma unroll
          for (int kt = 0; kt < 4; ++kt)
#pragma unroll
            for (int r = 0; r < 4; ++r) st[kt][r] = (st[kt][r] > -1e29f) ? __expf(st[kt][r] - m) * invl : 0.f;
          pv64(vA, st, o);
          SB0;
          v_load64(vA, Vb + (size_t)nn * 64, lane);
          SB0;
          float mainv[4], ev[4], eup[4];
#pragma unroll
          for (int kt = 0; kt < 4; ++kt) {
            float acc = 0.f, last = 0.f;
#pragma unroll
            for (int r = 0; r < 4; ++r) {
              float a = st[kt][r];
              a += __shfl_xor(a, 1);
              a += __shfl_xor(a, 2);
              acc += a;
              last = a;
            }
            mainv[kt] = acc; ev[kt] = last;
          }
#pragma unroll
          for (int kt = 0; kt < 4; ++kt) eup[kt] = __shfl(ev[kt], (lane + 48) & 63);
#pragma unroll
          for (int kt = 0; kt < 4; ++kt) {
            const float pe = (q > 0) ? eup[kt] : (kt > 0 ? eup[kt > 0 ? kt - 1 : 0] : carry);
            if (g == 0) impl[tq * 128 + (n0 >> 2) + kt * 4 + q] = mainv[kt] + pe;
          }
          carry = eup[3];
        }
#pragma unroll
        for (int dt = 0; dt < 4; ++dt) y[dt] += o[dt] * gt0;
      }
    }

    {
      const u16* Kw = KW + kvb * SEQL * 64;
      const u16* Vw = VW + kvb * 64 * SEQL;
      float m = -1e30f, lsum = 0.f;
      f32x4 o[4];
#pragma unroll
      for (int dt = 0; dt < 4; ++dt) o[dt] = (f32x4){0.f, 0.f, 0.f, 0.f};
      int lo = s0 - 511; if (lo < 0) lo = 0;
      lo &= ~63;
      const int ntile = ((s0 + 3 - lo) >> 6) + 1;
      SB0;
      k_load64(kA, Kw + (size_t)lo * 64, lane);
      SB0;
      v_load64(vA, Vw + (size_t)lo * 64, lane);
      SB0;
      for (int i = 0; i < ntile; ++i) {
        const int k0 = lo + i * 64;
        const int kx = lo + (i + 1 < ntile ? i + 1 : i) * 64;
        f32x4 st[4];
        qk64(kA, qf, scale, [&](int ko) { const int ks = k0 + ko; return (ks <= s) && (ks + 512 > s); }, lane, st);
        SB0;
        k_load64(kA, Kw + (size_t)kx * 64, lane);
        SB0;
        softmax_update(st, m, lsum, o);
        pv64(vA, st, o);
        SB0;
        v_load64(vA, Vw + (size_t)kx * 64, lane);
        SB0;
      }
      lsum += __shfl_xor(lsum, 16);
      lsum += __shfl_xor(lsum, 32);
      const float sc = (lsum > 0.f) ? gt2 / lsum : 0.f;
#pragma unroll
      for (int dt = 0; dt < 4; ++dt) y[dt] += o[dt] * sc;
    }

    {
      const u16* Ks = KS + kvb * SEQL * 64;
      const u16* Vs = VS + kvb * 64 * SEQL;
      const int cur = s0 >> 6;
      const int ncand = cur - 2;
      u64 mk0[5], mk1[5];
#pragma unroll
      for (int i = 0; i < 5; ++i) { mk0[i] = 0; mk1[i] = 0; }
      if (ncand <= 13) {
        mk0[0] = (cur >= 63) ? ~0ull : ((1ull << (cur + 1)) - 1ull);
      } else {
        mk0[0] = 1ull;
        if (cur - 1 < 64) mk0[0] |= 1ull << (cur - 1); else mk1[0] |= 1ull << (cur - 1 - 64);
        if (cur < 64) mk0[0] |= 1ull << cur; else mk1[0] |= 1ull << (cur - 64);
        u32 b0[4], b1[4], T[4];
#pragma unroll
        for (int tk = 0; tk < 4; ++tk) {
          const float* ir = impl + tk * 128;
          b0[tk] = (lane >= 1 && lane <= ncand) ? (__float_as_uint(ir[lane]) + 1u) : 0u;
          b1[tk] = (lane + 64 <= ncand) ? (__float_as_uint(ir[lane + 64]) + 1u) : 0u;
          T[tk] = 0u;
        }
        for (int bit = 30; bit >= 0; --bit) {
#pragma unroll
          for (int tk = 0; tk < 4; ++tk) {
            const u32 cand = T[tk] | (1u << bit);
            const int c = __builtin_popcountll(__builtin_amdgcn_ballot_w64(b0[tk] >= cand)) +
                          __builtin_popcountll(__builtin_amdgcn_ballot_w64(b1[tk] >= cand));
            if (c >= 13) T[tk] = cand;
          }
        }
#pragma unroll
        for (int tk = 0; tk < 4; ++tk) {
          u64 g0 = __builtin_amdgcn_ballot_w64(b0[tk] > T[tk]);
          u64 g1 = __builtin_amdgcn_ballot_w64(b1[tk] > T[tk]);
          u64 e0 = __builtin_amdgcn_ballot_w64(b0[tk] == T[tk]);
          u64 e1 = __builtin_amdgcn_ballot_w64(b1[tk] == T[tk]);
          int need = 13 - __builtin_popcountll(g0) - __builtin_popcountll(g1);
          while (need > 0 && (e0 | e1)) {
            if (e0) { const u64 low = e0 & (~e0 + 1ull); g0 |= low; e0 ^= low; }
            else { const u64 low = e1 & (~e1 + 1ull); g1 |= low; e1 ^= low; }
            --need;
          }
          mk0[tk + 1] = g0; mk1[tk + 1] = g1;
        }
      }
      int ntot = 0;
#pragma unroll
      for (int i = 0; i < 5; ++i) ntot += __builtin_popcountll(mk0[i]) + __builtin_popcountll(mk1[i]);
      int gi = 0;
      u64 c0 = mk0[0], c1 = mk1[0];
      int jn = 0, gn = 0;
      auto advance = [&]() {
        while ((c0 | c1) == 0ull && gi < 4) {
          ++gi;
          c0 = (gi == 1) ? mk0[1] : (gi == 2) ? mk0[2] : (gi == 3) ? mk0[3] : mk0[4];
          c1 = (gi == 1) ? mk1[1] : (gi == 2) ? mk1[2] : (gi == 3) ? mk1[3] : mk1[4];
        }
        if (c0) { jn = __builtin_ctzll(c0); c0 &= c0 - 1ull; }
        else if (c1) { jn = 64 + __builtin_ctzll(c1); c1 &= c1 - 1ull; }
        gn = gi;
      };
      float m = -1e30f, lsum = 0.f;
      f32x4 o[4];
#pragma unroll
      for (int dt = 0; dt < 4; ++dt) o[dt] = (f32x4){0.f, 0.f, 0.f, 0.f};
      advance();
      SB0;
      k_load64(kA, Ks + (size_t)jn * 4096, lane);
      SB0;
      v_load64(vA, Vs + (size_t)jn * 4096, lane);
      SB0;
      for (int i = 0; i < ntot; ++i) {
        const int j = jn, gc = gn;
        if (i + 1 < ntot) advance();
        const bool mine = (gc == 0) || (tq == gc - 1);
        const int k0 = j * 64;
        f32x4 st[4];
        qk64(kA, qf, scale, [&](int ko) { return mine && ((k0 + ko) <= s); }, lane, st);
        SB0;
        k_load64(kA, Ks + (size_t)jn * 4096, lane);
        SB0;
        softmax_update(st, m, lsum, o);
        pv64(vA, st, o);
        SB0;
        v_load64(vA, Vs + (size_t)jn * 4096, lane);
        SB0;
      }
      lsum += __shfl_xor(lsum, 16);
      lsum += __shfl_xor(lsum, 32);
      const float sc = (lsum > 0.f) ? gt1 / lsum : 0.f;
#pragma unroll
      for (int dt = 0; dt < 4; ++dt) y[dt] += o[dt] * sc;
    }

#pragma unroll
    for (int dt = 0; dt < 4; ++dt) {
      uint2 w;
      w.x = (u32)f2bf(y[dt][0]) | ((u32)f2bf(y[dt][1]) << 16);
      w.y = (u32)f2bf(y[dt][2]) | ((u32)f2bf(y[dt][3]) << 16);
      *(uint2*)(Y + (size_t)t * 1536 + 1024 + head * 64 + dt * 16 + q * 4) = w;
    }
  }
}

#define BCS 132
__device__ __forceinline__ float hg_lb(const Params& p, int l, int ch) {
  if (l == 0) return 0.f;
  const float a0 = p.lb_logits[ch], a1 = p.lb_logits[512 + ch], a2 = p.lb_logits[1024 + ch], a3 = p.lb_logits[1536 + ch];
  const float mx = fmaxf(fmaxf(a0, a1), fmaxf(a2, a3));
  const float e0 = __expf(a0 - mx), e1 = __expf(a1 - mx), e2 = __expf(a2 - mx), e3 = __expf(a3 - mx);
  const float inv = 1.0f / (e0 + e1 + e2 + e3);
  float sacc = e1;
  if (l >= 2) sacc += e2;
  if (l >= 3) sacc += e3;
  return sacc * inv;
}

__device__ __forceinline__ void hg_bcum(const Params& p, int l, const u16* Uhg, int t0, int h, float* bc, float* lbs) {
  const int tid = TIDX;
  const int d = tid & 127;
  const float lbv = hg_lb(p, l, h * 128 + d);
  if (tid < 128) lbs[d] = lbv;
  for (int idx = tid; idx < 64 * 128; idx += 256) {
    const int s = idx >> 7;
    const float z = bf2f(Uhg[(size_t)(t0 + s) * 2048 + 512 + h * 128 + d]);
    const float f = lbv + (1.0f - lbv) * sigmoidf_(z);
    bc[s * BCS + d] = __logf(fmaxf(f, 1e-30f));
  }
  __syncthreads();
  if (tid < 128) {
    float run = 0.f;
    for (int s = 0; s < 64; ++s) { run += bc[s * BCS + d]; bc[s * BCS + d] = run; }
  }
  __syncthreads();
}

__device__ __forceinline__ void phase_hg_local(const Params& p, int l, char* smem) {
  const u16* Uhg = (const u16*)(p.ws + OFF_UHG);
  float* states = (float*)(p.ws + OFF_STATES);
  float* gdec = (float*)(p.ws + OFF_GDEC);
  float* bc = (float*)smem;
  float* lbs = (float*)(smem + 33792);
  u16* KT = (u16*)(smem + 33792 + 512);
  u16* VTs = (u16*)(smem + 33792 + 512 + 18432);
  const int tid = TIDX, lane = tid & 63, wave = tid >> 6;
  const int c16 = lane & 15, q = lane >> 4;
  for (int it = BIDX; it < 1024; it += gridDim.x) {
    const int b = it >> 9, h = (it >> 7) & 3, c = it & 127;
    const int t0 = b * SEQL + c * 64;
    hg_bcum(p, l, Uhg, t0, h, bc, lbs);
    {
      const int d = tid & 127;
      const float lbv = lbs[d];
      const float bl = bc[63 * BCS + d];
      for (int idx = tid; idx < 64 * 128; idx += 256) {
        const int s = idx >> 7;
        const float z = bf2f(Uhg[(size_t)(t0 + s) * 2048 + 512 + h * 128 + d]);
        const float kk = (1.0f - lbv) * sigmoidf_(-z);
        KT[d * 72 + s] = f2bf(kk * __expf(bl - bc[s * BCS + d]));
        VTs[d * 72 + s] = Uhg[(size_t)(t0 + s) * 2048 + 1024 + h * 128 + d];
      }
      if (tid < 128) gdec[(size_t)it * 128 + d] = __expf(bl);
    }
    __syncthreads();
    f32x4 acc[2][8];
#pragma unroll
    for (int i = 0; i < 2; ++i)
#pragma unroll
      for (int j = 0; j < 8; ++j) acc[i][j] = (f32x4){0.f, 0.f, 0.f, 0.f};
#pragma unroll
    for (int ks = 0; ks < 2; ++ks) {
      bf16x8 af[2];
#pragma unroll
      for (int i = 0; i < 2; ++i) af[i] = *(const bf16x8*)(VTs + (wave * 32 + i * 16 + c16) * 72 + ks * 32 + q * 8);
#pragma unroll
      for (int j = 0; j < 8; ++j) {
        const bf16x8 bfr = *(const bf16x8*)(KT + (j * 16 + c16) * 72 + ks * 32 + q * 8);
#pragma unroll
        for (int i = 0; i < 2; ++i) acc[i][j] = mfma16(af[i], bfr, acc[i][j]);
      }
    }
    float* st = states + (size_t)it * 16384;
#pragma unroll
    for (int i = 0; i < 2; ++i)
#pragma unroll
      for (int j = 0; j < 8; ++j)
#pragma unroll
        for (int r = 0; r < 4; ++r) st[(wave * 32 + i * 16 + q * 4 + r) * 128 + j * 16 + c16] = acc[i][j][r];
    __syncthreads();
  }
}

__device__ __forceinline__ void phase_hg_scan(const Params& p) {
  float* __restrict__ states = (float*)(p.ws + OFF_STATES);
  const float* __restrict__ gdec = (const float*)(p.ws + OFF_GDEC);
  const size_t nth = (size_t)gridDim.x * blockDim.x;
  for (size_t e = (size_t)BIDX * blockDim.x + TIDX; e < (size_t)8 * 16384; e += nth) {
    const int bh = (int)(e >> 14), vd = (int)(e & 16383), d = vd & 127;
    float S = 0.f;
    for (int c0 = 0; c0 < 128; c0 += 16) {
      float Lv[16], gv[16];
#pragma unroll
      for (int i = 0; i < 16; ++i) {
        const size_t item = (size_t)bh * 128 + c0 + i;
        Lv[i] = states[item * 16384 + vd];
        gv[i] = gdec[item * 128 + d];
      }
#pragma unroll
      for (int i = 0; i < 16; ++i) {
        const size_t item = (size_t)bh * 128 + c0 + i;
        S = gv[i] * S + Lv[i];
        states[item * 16384 + vd] = S;
      }
    }
  }
}

__device__ __forceinline__ void phase_hg_out(const Params& p, int l, char* smem) {
  const u16* Uhg = (const u16*)(p.ws + OFF_UHG);
  const float* states = (const float*)(p.ws + OFF_STATES);
  u16* Y = (u16*)(p.ws + OFF_Y);
  float* bc = (float*)smem;
  float* lbs = (float*)(smem + 33792);
  u16* VTs = (u16*)(smem + 33792 + 512);
  const int tid = TIDX, lane = tid & 63, wave = tid >> 6;
  const int c16 = lane & 15, q = lane >> 4;
  for (int it = BIDX; it < 1024; it += gridDim.x) {
    const int b = it >> 9, h = (it >> 7) & 3, c = it & 127;
    const int t0 = b * SEQL + c * 64;
    hg_bcum(p, l, Uhg, t0, h, bc, lbs);
    {
      const int d = tid & 127;
      for (int idx = tid; idx < 64 * 128; idx += 256) {
        const int s = idx >> 7;
        VTs[d * 72 + s] = Uhg[(size_t)(t0 + s) * 2048 + 1024 + h * 128 + d];
      }
    }
    __syncthreads();
    const int tt = wave * 16 + c16;
    const bool hi = (wave >= 2);
    bf16x8 Qt[4], Qh[4];
#pragma unroll
    for (int ks = 0; ks < 4; ++ks) {
      const int d0 = ks * 32 + q * 8;
      const bf16x8 qraw = *(const bf16x8*)(Uhg + (size_t)(t0 + tt) * 2048 + h * 128 + d0);
#pragma unroll
      for (int j = 0; j < 8; ++j) {
        const float qv = siluf_(bf2f((u16)qraw[j]));
        const float bt = bc[tt * BCS + d0 + j];
        const float rr = hi ? bc[31 * BCS + d0 + j] : 0.f;
        Qt[ks][j] = (short)f2bf(qv * __expf(bt - rr));
        Qh[ks][j] = (short)f2bf(qv * __expf(bt));
      }
    }
    f32x4 at[4];
#pragma unroll
    for (int st = 0; st < 4; ++st) {
      at[st] = (f32x4){0.f, 0.f, 0.f, 0.f};
      if (st <= wave) {
        f32x4 a = {0.f, 0.f, 0.f, 0.f};
        const int srow = st * 16 + c16;
#pragma unroll
        for (int ks = 0; ks < 4; ++ks) {
          const int d0 = ks * 32 + q * 8;
          const bf16x8 zraw = *(const bf16x8*)(Uhg + (size_t)(t0 + srow) * 2048 + 512 + h * 128 + d0);
          bf16x8 kf;
#pragma unroll
          for (int j = 0; j < 8; ++j) {
            const float z = bf2f((u16)zraw[j]);
            const float kk = (1.0f - lbs[d0 + j]) * sigmoidf_(-z);
            const float rr = hi ? bc[31 * BCS + d0 + j] : 0.f;
            const float ex = fminf(rr - bc[srow * BCS + d0 + j], 80.f);
            kf[j] = (short)f2bf(kk * __expf(ex));
          }
          a = mfma16(kf, Qt[ks], a);
        }
#pragma unroll
        for (int r = 0; r < 4; ++r) at[st][r] = ((st * 16 + q * 4 + r) <= tt) ? a[r] : 0.f;
      }
    }
    bf16x8 pb[2];
#pragma unroll
    for (int sp = 0; sp < 2; ++sp)
#pragma unroll
      for (int j = 0; j < 4; ++j) {
        pb[sp][j] = (short)f2bf(at[2 * sp][j]);
        pb[sp][4 + j] = (short)f2bf(at[2 * sp + 1][j]);
      }
    f32x4 o[8];
    float ss = 0.f;
    const float* Sp = states + (size_t)(it - 1) * 16384;
#pragma unroll
    for (int vt = 0; vt < 8; ++vt) {
      f32x4 acc = {0.f, 0.f, 0.f, 0.f};
#pragma unroll
      for (int sp = 0; sp < 2; ++sp) {
        if (2 * sp <= wave) {
          const u16* vr = VTs + (vt * 16 + c16) * 72 + sp * 32 + q * 4;
          const bf16x4 va = *(const bf16x4*)(vr);
          const bf16x4 vb = *(const bf16x4*)(vr + 16);
          bf16x8 vf;
          vf[0] = va[0]; vf[1] = va[1]; vf[2] = va[2]; vf[3] = va[3];
          vf[4] = vb[0]; vf[5] = vb[1]; vf[6] = vb[2]; vf[7] = vb[3];
          acc = mfma16(vf, pb[sp], acc);
        }
      }
      if (c > 0) {
#pragma unroll
        for (int ks = 0; ks < 4; ++ks) {
          const float* sr = Sp + (size_t)(vt * 16 + c16) * 128 + ks * 32 + q * 8;
          const float4 s0v = *(const float4*)(sr);
          const float4 s1v = *(const float4*)(sr + 4);
          bf16x8 sf;
          sf[0] = (short)f2bf(s0v.x); sf[1] = (short)f2bf(s0v.y); sf[2] = (short)f2bf(s0v.z); sf[3] = (short)f2bf(s0v.w);
          sf[4] = (short)f2bf(s1v.x); sf[5] = (short)f2bf(s1v.y); sf[6] = (short)f2bf(s1v.z); sf[7] = (short)f2bf(s1v.w);
          acc = mfma16(sf, Qh[ks], acc);
        }
      }
      o[vt] = acc;
#pragma unroll
      for (int r = 0; r < 4; ++r) ss += acc[r] * acc[r];
    }
    ss += __shfl_xor(ss, 16);
    ss += __shfl_xor(ss, 32);
    const float rinv = rsqrtf(ss * (1.0f / 128.0f) + EPSN);
    const size_t trow = (size_t)(t0 + tt);
#pragma unroll
    for (int vt = 0; vt < 8; ++vt) {
      const int v0 = vt * 16 + q * 4;
      const uint2 graw = *(const uint2*)(Uhg + trow * 2048 + 1536 + h * 128 + v0);
      const float4 gn = *(const float4*)(p.gnorm + l * 128 + v0);
      const float y0 = o[vt][0] * rinv * gn.x * siluf_(bf2f((u16)(graw.x & 0xffff)));
      const float y1 = o[vt][1] * rinv * gn.y * siluf_(bf2f((u16)(graw.x >> 16)));
      const float y2 = o[vt][2] * rinv * gn.z * siluf_(bf2f((u16)(graw.y & 0xffff)));
      const float y3 = o[vt][3] * rinv * gn.w * siluf_(bf2f((u16)(graw.y >> 16)));
      uint2 w;
      w.x = (u32)f2bf(y0) | ((u32)f2bf(y1) << 16);
      w.y = (u32)f2bf(y2) | ((u32)f2bf(y3) << 16);
      *(uint2*)(Y + trow * 1536 + 512 + h * 128 + v0) = w;
    }
    __syncthreads();
  }
}


#define XB_TMO      128
#define XB_XCNT(j)  (256  + 64 * (j))
#define XB_XSUB(j)  (1280 + 64 * (j))
#define XB_XGEN(j)  (2304 + 64 * (j))
#define XB_TOP      3328
#define XB_TOPGEN   3392
#define XCD_BAR_WORDS 3456
#define XB_SPIN_CAP (1u << 18)
#define LAS __attribute__((address_space(3)))

__device__ __forceinline__ unsigned xb_ld(unsigned* p)              { return __hip_atomic_load(p, __ATOMIC_RELAXED, __HIP_MEMORY_SCOPE_AGENT); }
__device__ __forceinline__ unsigned xb_add(unsigned* p, unsigned v) { return __hip_atomic_fetch_add(p, v, __ATOMIC_RELAXED, __HIP_MEMORY_SCOPE_AGENT); }
__device__ __forceinline__ unsigned xb_xcc_id() { return (unsigned)__builtin_amdgcn_s_getreg((3 << 11) | 20) & 0xFu; }
#define XB_SPIN(cond, bar) do { unsigned _sp = 0; while (cond) { __builtin_amdgcn_s_sleep(1); \
    if ((++_sp & 255u) == 0u) { if (xb_ld(&(bar)[XB_TMO])) break; if (_sp > XB_SPIN_CAP) { atomicAdd(&(bar)[XB_TMO], 1u); break; } } } } while (0)

struct XcdBarrier { unsigned* bar; unsigned x; volatile LAS unsigned* st; };

__device__ __forceinline__ XcdBarrier xcd_barrier_post(unsigned* bar, volatile LAS unsigned* st) {
    XcdBarrier b; b.bar = bar; b.x = xb_xcc_id(); b.st = st;
    if (threadIdx.x == 0) (void)xb_add(&bar[XB_XCNT(b.x)], 1u);
    return b;
}
__device__ __forceinline__ void xcd_barrier_complete(unsigned* bar, unsigned x, unsigned& nloc, unsigned& nx) {
    const unsigned G = gridDim.x * gridDim.y * gridDim.z;
    unsigned sum, cnt, mine, sp = 0u;
    for (;;) {
        sum = 0u; cnt = 0u; mine = 0u;
#pragma unroll
        for (unsigned j = 0; j < 16; ++j) { const unsigned c = xb_ld(&bar[XB_XCNT(j)]); sum += c; cnt += (c > 0u) ? 1u : 0u; mine = (j == x) ? c : mine; }
        if (sum == G) break;
        __builtin_amdgcn_s_sleep(1);
        if ((++sp & 255u) == 0u) { if (xb_ld(&bar[XB_TMO])) break; if (sp > XB_SPIN_CAP) { atomicAdd(&bar[XB_TMO], 1u); break; } }
    }
    nloc = mine > 0u ? mine : 1u; nx = cnt > 0u ? cnt : 1u;
}
__device__ __forceinline__ void xcd_barrier(const XcdBarrier& b) {
    asm volatile("s_waitcnt vmcnt(0)" ::: "memory");
    __syncthreads();
    if (threadIdx.x == 0) {
        unsigned* bar = b.bar;
        __builtin_amdgcn_s_waitcnt(0);
        unsigned nloc = b.st[0], nx = b.st[1];
        if (nloc == 0u) { xcd_barrier_complete(bar, b.x, nloc, nx); b.st[0] = nloc; b.st[1] = nx; }
        const unsigned old = xb_add(&bar[XB_XSUB(b.x)], 1u);
        const unsigned gen = old / nloc;
        if (old + 1u == (gen + 1u) * nloc) {
            __builtin_amdgcn_fence(__ATOMIC_RELEASE, "agent");
            asm volatile("s_waitcnt vmcnt(0)" ::: "memory");
            const unsigned og = xb_add(&bar[XB_TOP], 1u);
            const unsigned tg = og / nx;
            if (og + 1u == (tg + 1u) * nx) xb_add(&bar[XB_TOPGEN], 1u);
            else XB_SPIN(xb_ld(&bar[XB_TOPGEN]) == tg, bar);
            __builtin_amdgcn_fence(__ATOMIC_ACQUIRE, "agent");
            xb_add(&bar[XB_XGEN(b.x)], 1u);
            asm volatile("s_waitcnt vmcnt(0)" ::: "memory");
        } else {
            XB_SPIN(xb_ld(&bar[XB_XGEN(b.x)]) == gen, bar);
            __builtin_amdgcn_fence(__ATOMIC_ACQUIRE, "agent");
            asm volatile("s_waitcnt vmcnt(0)" ::: "memory");
        }
    }
    __syncthreads();
}

#define SMEM_BYTES 73728
#ifndef XREP
#define XREP 0
#endif
#ifndef REPMASK
#define REPMASK 0
#endif
#define NREP(st) (((st) >= 0 && (st) != 2 && (st) != 7 && (st) != 11 && (st) != 14 && ((REPMASK >> (st)) & 1)) ? 2 : 1)
__global__ void __launch_bounds__(256, 2) mega(Params p) {
  cg::grid_group grid = cg::this_grid();
  __shared__ __attribute__((aligned(16))) char smem[SMEM_BYTES];
  __shared__ uint4 xb_words;
  u16* sm16 = (u16*)smem;
  char* ws = p.ws;
  if (threadIdx.x == 0) xb_words = make_uint4(0u, 0u, 0u, 0u);
  __syncthreads();
  XcdBarrier xb = xcd_barrier_post((unsigned*)(ws + OFF_BAR), (volatile LAS unsigned*)&xb_words);
  for (int gs = -1; gs < 60; ++gs) {
    const int l = (gs < 0) ? 0 : gs / 15;
    const int st = (gs < 0) ? -1 : gs % 15;
    const float* g = p.gains + (size_t)l * 6 * 1024;
    for (int rep_ = 0; rep_ < NREP(st); ++rep_) {
    if (st == 0 || st == 12) {
      phase_ffn_up(p, (const u16*)(ws + (st == 0 ? W_GU0 : W_GU1)), sm16);
    } else if (st == 1 || st == 10 || st == 13) {
      const u16* A = (const u16*)(ws + (st == 10 ? OFF_H : OFF_ACT));
      const u16* Bt = (const u16*)(ws + (st == 10 ? W_OUT : (st == 1 ? W_D0 : W_D1)));
      const int K = (st == 10) ? 1024 : DFF;
      float* outp = (float*)(ws + (st == 10 ? OFF_D2 : OFF_D));
      phase_gemm_f32(A, K, Bt, K, K, 128, 8, outp, 1024, sm16);
    } else if (st == -1 || st == 2 || st == 11 || st == 14) {
      if (st == -1) phase_rope_table(p);
      const int mode = (st == -1) ? 0 : 1;
      const float* D = (const float*)(ws + (st == 11 ? OFF_D2 : OFF_D));
      const float* gD = g + (st == 2 ? 1 : (st == 11 ? 3 : 5)) * 1024;
      const float scale = (st == 11) ? 1.0f : 0.5f;
      const float* gH = (st == -1) ? g : g + (st == 2 ? 2 : (st == 11 ? 4 : 6)) * 1024;
      const bool writeH = !(st == 14 && l == 3);
      phase_norm(p, mode, D, gD, scale, gH, writeH);
      if (st == -1 || (st == 14 && l < 3)) phase_convert(p, (st == -1) ? 0 : l + 1, (float*)smem);
    } else if (st == 3 || st == 5) {
      if (st == 5) phase_cmp1(p, sm16);
      phase_win(p, st == 5 ? 1 : 0, sm16);
    } else if (st == 4) {
      phase_prep(p, l);
    } else if (st == 6) {
      phase_cmp2(p, l);
      phase_hg_local(p, l, smem);
    } else if (st == 7) {
      for (int r2_ = 0; r2_ < (XREP == 1 ? 2 : 1); ++r2_) phase_nsa_attn(p, smem);
      phase_hg_scan(p);
    } else if (st == 8) {
      phase_hg_out(p, l, smem);
    } else if (st == 9) {
      phase_merge(p, sm16);
    }
    }
    if (gs < 0) grid.sync();
    else if (gs < 59) xcd_barrier(xb);
    if (XREP == 2 && gs < 59) xcd_barrier(xb);
  }
}

extern "C" void kernel_launch(void* const* d_in, const int* in_sizes, int n_in,
                              void* d_out, int out_size, void* d_ws, size_t ws_size,
                              hipStream_t stream) {
  static int grid_blocks = 0;
  if (!grid_blocks) {
    int dev = 0, cus = 0, per_cu = 0;
    hipGetDevice(&dev);
    hipDeviceGetAttribute(&cus, hipDeviceAttributeMultiprocessorCount, dev);
    hipOccupancyMaxActiveBlocksPerMultiprocessor(&per_cu, mega, 256, 0);
    if (per_cu > 2) per_cu = 2;
    if (per_cu < 1) per_cu = 1;
    grid_blocks = cus * per_cu;
  }
  if (ws_size < (size_t)WS_NEEDED) {
    fprintf(stderr, "workspace too small: %zu < %zu\n", ws_size, (size_t)WS_NEEDED);
    return;
  }
  Params p{};
  p.x_in = (const float*)d_in[0];
  p.pos = (const int*)d_in[1];
  p.lb_logits = (const float*)d_in[2];
  p.gains = (const float*)d_in[3];
  p.wg = (const float*)d_in[4];
  p.wu = (const float*)d_in[5];
  p.wd = (const float*)d_in[6];
  p.win = (const float*)d_in[7];
  p.convw = (const float*)d_in[8];
  p.gnorm = (const float*)d_in[9];
  p.pe = (const float*)d_in[10];
  p.cw1 = (const float*)d_in[11];
  p.cw2 = (const float*)d_in[12];
  p.wbr = (const float*)d_in[13];
  p.wout = (const float*)d_in[14];
  p.x = (float*)d_out;
  p.ws = (char*)d_ws;
  hipMemsetAsync((char*)d_ws + OFF_BAR, 0, 16384, stream);
  void* args[] = {&p};
  hipError_t e = hipLaunchCooperativeKernel((void*)mega, dim3(grid_blocks), dim3(256), args, 0, stream);
  if (e != hipSuccess) fprintf(stderr, "coop launch failed: %s (grid %d)\n", hipGetErrorString(e), grid_blocks);
}
```

```cpp
#include <hip/hip_runtime.h>
#include <hip/hip_cooperative_groups.h>
#include <cstdio>
namespace cg = cooperative_groups;

#define LAS __attribute__((address_space(3)))
typedef unsigned short u16;
typedef unsigned int u32;
typedef __attribute__((ext_vector_type(8))) short bf16x8;
typedef __attribute__((ext_vector_type(4))) short bf16x4;
typedef __attribute__((ext_vector_type(4))) float f32x4;

#define T_TOK 16384
#define SEQL 8192
#define DM 1024
#define DFF 2816
#define EPSN 1e-6f

#define W_GU0 0ul
#define W_D0 11534336ul
#define W_GU1 17301504ul
#define W_D1 28835840ul
#define W_IN 34603008ul
#define W_BR (W_IN + 16777216ul)
#define W_OUT (W_BR + 3145728ul)
#define W_C1 (W_OUT + 2097152ul)
#define W_C2 (W_C1 + 2097152ul)
#define OFF_H (W_C2 + 65536ul)
#define OFF_ACT (OFF_H + 33554432ul)
#define OFF_STATES OFF_ACT
#define OFF_KR (OFF_ACT + 67108864ul)
#define OFF_VT (OFF_KR + 12582912ul)
#define OFF_D (OFF_ACT + 92274688ul)
#define OFF_Y OFF_D
#define OFF_IMP (OFF_D + 50331648ul)
#define OFF_U1 (OFF_D + 67108864ul)
#define OFF_UCONV OFF_U1
#define OFF_UNSA (OFF_U1 + 50331648ul)
#define OFF_UHG OFF_U1
#define OFF_D2 OFF_U1
#define OFF_UMG (OFF_U1 + 100663296ul)
#define OFF_QR (OFF_UMG + 100663296ul)
#define OFF_CMPA (OFF_QR + 16777216ul)
#define OFF_OCMP (OFF_CMPA + 16777216ul)
#define OFF_ROPE (OFF_QR + 50331648ul)
#define OFF_HC (OFF_ROPE + 4194304ul)
#define OFF_GATES (OFF_HC + 2097152ul)
#define OFF_GDEC (OFF_GATES + 1572864ul)
#define OFF_KCMP (OFF_GDEC + 524288ul)
#define OFF_VCMP (OFF_KCMP + 262144ul)
#define OFF_BAR (OFF_VCMP + 262144ul)
#define WS_NEEDED (OFF_BAR + 16384ul)

struct Params {
  const float* x_in; const int* pos; const float* lb_logits; const float* gains;
  const float* wg; const float* wu; const float* wd; const float* win; const float* convw;
  const float* gnorm; const float* pe; const float* cw1; const float* cw2; const float* wbr; const float* wout;
  float* x; char* ws;
};

__device__ __forceinline__ int opaque_tid() { int t = threadIdx.x; asm volatile("" : "+v"(t)); return t; }
__device__ __forceinline__ int opaque_bid() { int t = blockIdx.x; asm volatile("" : "+s"(t)); return t; }
#define RTID opaque_tid()
#define TIDX (opaque_tid() & 255)
#define HALF_ (__builtin_amdgcn_readfirstlane(opaque_tid() >> 8))
#define BIDX (opaque_bid() * 2 + HALF_)
#define VGRID ((int)gridDim.x * 2)

typedef __attribute__((ext_vector_type(2))) __bf16 bf16v2_t;
typedef __attribute__((ext_vector_type(2))) float f32v2_t;
__device__ __forceinline__ u16 f2bf(float f) { const __bf16 b = (__bf16)f; return __builtin_bit_cast(u16, b); }
__device__ __forceinline__ u32 pack2bf(float lo, float hi) {
  const f32v2_t v = {lo, hi};
  const bf16v2_t w = __builtin_convertvector(v, bf16v2_t);
  return __builtin_bit_cast(u32, w);
}
__device__ __forceinline__ float bf2f(u16 h) { return __uint_as_float(((u32)h) << 16); }
__device__ __forceinline__ float sigmoidf_(float x) { return 1.0f / (1.0f + __expf(-x)); }
__device__ __forceinline__ float siluf_(float x) { return x / (1.0f + __expf(-x)); }
__device__ __forceinline__ float wave_sum(float v) {
#pragma unroll
  for (int o = 32; o; o >>= 1) v += __shfl_xor(v, o);
  return v;
}
__device__ __forceinline__ int kfrag_off(int key, int d);
__device__ __forceinline__ int vfrag_off(int d, int key);
__device__ __forceinline__ f32x4 mfma16(bf16x8 a, bf16x8 b, f32x4 c) {
  return __builtin_amdgcn_mfma_f32_16x16x32_bf16(a, b, c, 0, 0, 0);
}

#define LSTR 64
template <int NJ>
__device__ __forceinline__ void gemm_acc(f32x4 (&acc)[4][NJ], const u16* __restrict__ A, int lda,
                                         const u16* __restrict__ Bt, int ldb, int kbeg, int kend,
                                         int row0, int col0, u16* smem) {
  const int tid = TIDX;
  const int lane = tid & 63, wave = tid >> 6;
  const int wm = wave >> 1, wn = wave & 1;
  u16* sA = smem;
  u16* sB = smem + 2 * 128 * LSTR;
  const int lrow = tid >> 3, lkc = tid & 7;
  const u16* Ag = A + (size_t)(row0 + lrow) * lda + kbeg + lkc * 8;
  const u16* Bg = Bt + (size_t)(col0 + lrow) * ldb + kbeg + lkc * 8;
  const size_t a32 = (size_t)32 * lda, b32 = (size_t)32 * ldb;
  uint4 ra0, ra1, ra2, ra3, rb0, rb1, rb2, rb3;
  const int nk = (kend - kbeg) >> 6;
  ra0 = *(const uint4*)(Ag); ra1 = *(const uint4*)(Ag + a32); ra2 = *(const uint4*)(Ag + 2 * a32); ra3 = *(const uint4*)(Ag + 3 * a32);
  rb0 = *(const uint4*)(Bg); rb1 = *(const uint4*)(Bg + b32);
  if (NJ == 4) { rb2 = *(const uint4*)(Bg + 2 * b32); rb3 = *(const uint4*)(Bg + 3 * b32); }
  {
    u16* wa = sA + lrow * LSTR + ((lkc ^ (lrow & 7)) * 8);
    u16* wb = sB + lrow * LSTR + ((lkc ^ (lrow & 7)) * 8);
    *(uint4*)(wa) = ra0; *(uint4*)(wa + 32 * LSTR) = ra1; *(uint4*)(wa + 64 * LSTR) = ra2; *(uint4*)(wa + 96 * LSTR) = ra3;
    *(uint4*)(wb) = rb0; *(uint4*)(wb + 32 * LSTR) = rb1;
    if (NJ == 4) { *(uint4*)(wb + 64 * LSTR) = rb2; *(uint4*)(wb + 96 * LSTR) = rb3; }
  }
  __syncthreads();
  for (int kt = 0; kt < nk; ++kt) {
    const int buf = kt & 1;
    const bool more = (kt + 1 < nk);
    if (more) {
      const u16* Ak = Ag + (kt + 1) * 64;
      const u16* Bk = Bg + (kt + 1) * 64;
      ra0 = *(const uint4*)(Ak); ra1 = *(const uint4*)(Ak + a32); ra2 = *(const uint4*)(Ak + 2 * a32); ra3 = *(const uint4*)(Ak + 3 * a32);
      rb0 = *(const uint4*)(Bk); rb1 = *(const uint4*)(Bk + b32);
      if (NJ == 4) { rb2 = *(const uint4*)(Bk + 2 * b32); rb3 = *(const uint4*)(Bk + 3 * b32); }
    }
    __builtin_amdgcn_sched_barrier(0);
    const int swz = (((lane >> 4) ^ (lane & 7)) * 8);
    const u16* a = sA + buf * 128 * LSTR + (wm * 64 + (lane & 15)) * LSTR;
    const u16* b = sB + buf * 128 * LSTR + (wn * (NJ * 16) + (lane & 15)) * LSTR;
#pragma unroll
    for (int ks = 0; ks < 2; ++ks) {
      bf16x8 af[4], bfr[NJ];
      const int so = swz ^ (ks * 32);
#pragma unroll
      for (int i = 0; i < 4; ++i) af[i] = *(const bf16x8*)(a + i * 16 * LSTR + so);
#pragma unroll
      for (int j = 0; j < NJ; ++j) bfr[j] = *(const bf16x8*)(b + j * 16 * LSTR + so);
#pragma unroll
      for (int i = 0; i < 4; ++i)
#pragma unroll
        for (int j = 0; j < NJ; ++j) acc[i][j] = mfma16(af[i], bfr[j], acc[i][j]);
    }
    __builtin_amdgcn_sched_barrier(0);
    if (more) {
      const int nb = buf ^ 1;
      u16* wa = sA + nb * 128 * LSTR + lrow * LSTR + ((lkc ^ (lrow & 7)) * 8);
      u16* wb = sB + nb * 128 * LSTR + lrow * LSTR + ((lkc ^ (lrow & 7)) * 8);
      *(uint4*)(wa) = ra0; *(uint4*)(wa + 32 * LSTR) = ra1; *(uint4*)(wa + 64 * LSTR) = ra2; *(uint4*)(wa + 96 * LSTR) = ra3;
      *(uint4*)(wb) = rb0; *(uint4*)(wb + 32 * LSTR) = rb1;
      if (NJ == 4) { *(uint4*)(wb + 64 * LSTR) = rb2; *(uint4*)(wb + 96 * LSTR) = rb3; }
    }
    __syncthreads();
  }
}

#define ZERO_ACC(acc)                                  \
  _Pragma("unroll") for (int i_ = 0; i_ < 4; ++i_)     \
  _Pragma("unroll") for (int j_ = 0; j_ < 4; ++j_) { acc[i_][j_] = (f32x4){0.f, 0.f, 0.f, 0.f}; }

#define CONV_ITEMS 7176
__device__ __forceinline__ void convert_tile(const Params& p, int l, int item, float* tile) {
  const int tid = TIDX;
  int id, loc;
  if (item < 1408) { id = 0; loc = item; }
  else if (item < 2112) { id = 1; loc = item - 1408; }
  else if (item < 3520) { id = 2; loc = item - 2112; }
  else if (item < 4224) { id = 3; loc = item - 3520; }
  else if (item < 6272) { id = 4; loc = item - 4224; }
  else if (item < 6656) { id = 5; loc = item - 6272; }
  else if (item < 6912) { id = 6; loc = item - 6656; }
  else if (item < 7168) { id = 7; loc = item - 6912; }
  else { id = 8; loc = item - 7168; }
  int KT = 16;
  if (id == 1 || id == 3) KT = 44; else if (id == 5) KT = 24; else if (id == 7) KT = 32; else if (id == 8) KT = 4;
  const int nt = loc / KT, kt = loc % KT;
  const int n0 = nt * 64, k0 = kt * 64;
  const int tn = tid & 63, tk = tid >> 6;
  const int n = n0 + tn;
  const float* src = nullptr; size_t ldsrc = 0; bool zero = false;
  u16* dst = nullptr; int lddst = 0;
  char* ws = p.ws;
  if (id == 0 || id == 2) {
    const int f = id >> 1;
    const int pp = n >> 5, s = (n >> 4) & 1, i = n & 15;
    src = (s ? p.wu : p.wg) + (size_t)(l * 2 + f) * 1024 * DFF + (pp * 16 + i);
    ldsrc = DFF; dst = (u16*)(ws + (f ? W_GU1 : W_GU0)); lddst = 1024;
  } else if (id == 1 || id == 3) {
    const int f = id >> 1;
    src = p.wd + (size_t)(l * 2 + f) * DFF * 1024 + n;
    ldsrc = 1024; dst = (u16*)(ws + (f ? W_D1 : W_D0)); lddst = DFF;
  } else if (id == 4) {
    int col = n;
    if (n >= 4888 && n < 5120) { zero = true; col = 0; }
    else if (n >= 5120) col = n - 232;
    src = p.win + (size_t)l * 1024 * 7960 + col;
    ldsrc = 7960; dst = (u16*)(ws + W_IN); lddst = 1024;
  } else if (id == 5) {
    src = p.wbr + (size_t)l * 1536 * 1024 + n;
    ldsrc = 1024; dst = (u16*)(ws + W_BR); lddst = 1536;
  } else if (id == 6) {
    src = p.wout + (size_t)l * 1024 * 1024 + n;
    ldsrc = 1024; dst = (u16*)(ws + W_OUT); lddst = 1024;
  } else if (id == 7) {
    const int m = n >> 8, nn = n & 255;
    src = p.cw1 + (size_t)(l * 2 + m) * 2048 * 256 + nn;
    ldsrc = 256; dst = (u16*)(ws + W_C1); lddst = 2048;
  } else {
    src = p.cw2 + (size_t)(l * 2 + (n >> 6)) * 256 * 64 + (n & 63);
    ldsrc = 64; dst = (u16*)(ws + W_C2); lddst = 256;
  }
  (void)tn; (void)tk; (void)n;
  {
    const int kr = tid >> 4, nq = tid & 15;
    const int n4 = n0 + nq * 4;
    const float* s4 = nullptr; bool z4 = false;
    if (id == 0 || id == 2) {
      const int f = id >> 1;
      const int pp = n4 >> 5, s = (n4 >> 4) & 1, i = n4 & 15;
      s4 = (s ? p.wu : p.wg) + (size_t)(l * 2 + f) * 1024 * DFF + (pp * 16 + i);
    } else if (id == 1 || id == 3) {
      s4 = p.wd + (size_t)(l * 2 + (id >> 1)) * DFF * 1024 + n4;
    } else if (id == 4) {
      int col = n4;
      if (n4 >= 4888 && n4 < 5120) { z4 = true; col = 0; }
      else if (n4 >= 5120) col = n4 - 232;
      s4 = p.win + (size_t)l * 1024 * 7960 + col;
    } else if (id == 5) {
      s4 = p.wbr + (size_t)l * 1536 * 1024 + n4;
    } else if (id == 6) {
      s4 = p.wout + (size_t)l * 1024 * 1024 + n4;
    } else if (id == 7) {
      s4 = p.cw1 + (size_t)(l * 2 + (n4 >> 8)) * 2048 * 256 + (n4 & 255);
    } else {
      s4 = p.cw2 + (size_t)(l * 2 + (n4 >> 6)) * 256 * 64 + (n4 & 63);
    }
    float4 v[4];
#pragma unroll
    for (int it = 0; it < 4; ++it)
      v[it] = z4 ? make_float4(0.f, 0.f, 0.f, 0.f) : *(const float4*)(s4 + (size_t)(k0 + kr + 16 * it) * ldsrc);
#pragma unroll
    for (int it = 0; it < 4; ++it) {
      float* tr = tile + (kr + 16 * it) * 65 + nq * 4;
      tr[0] = v[it].x; tr[1] = v[it].y; tr[2] = v[it].z; tr[3] = v[it].w;
    }
  }
  __syncthreads();
  {
    const int kp = tid & 31, nr = tid >> 5;
#pragma unroll
    for (int it = 0; it < 8; ++it) {
      const int nn = nr + 8 * it;
      const u32 w = pack2bf(tile[(2 * kp) * 65 + nn], tile[(2 * kp + 1) * 65 + nn]);
      *(u32*)(dst + (size_t)(n0 + nn) * lddst + k0 + 2 * kp) = w;
    }
  }
  __syncthreads();
}

__device__ __forceinline__ void phase_convert(const Params& p, int l, float* tile) {
  const int vb0_ = BIDX;
  for (int k = 0; k < (CONV_ITEMS + VGRID - 1) / VGRID; ++k) {
    int it = vb0_ + k * VGRID;
    if (it > CONV_ITEMS - 1) it = CONV_ITEMS - 1;
    convert_tile(p, l, it, tile);
  }
}

__device__ __forceinline__ void phase_norm(const Params& p, int mode, const u16* D, const float* gD, float scale,
                           const float* gH, bool writeH) {
  const int lane = TIDX & 63, wave = TIDX >> 6;
  u16* H = (u16*)(p.ws + OFF_H);
  const float* xsrc = (mode == 0 ? p.x_in : p.x);
  for (int it = BIDX; it < T_TOK / 8; it += VGRID) {
    const int row0 = it * 8 + wave * 2;
    float4 xv[2][4], dv[2][4], g1[4], g2[4];
#pragma unroll
    for (int r = 0; r < 2; ++r)
#pragma unroll
      for (int i = 0; i < 4; ++i) {
        xv[r][i] = *(const float4*)(xsrc + (size_t)(row0 + r) * DM + i * 256 + lane * 4);
        if (mode == 1) {
          const uint2 w = *(const uint2*)(D + (size_t)(row0 + r) * DM + i * 256 + lane * 4);
          dv[r][i] = make_float4(__uint_as_float(w.x << 16), __uint_as_float(w.x & 0xffff0000u),
                                 __uint_as_float(w.y << 16), __uint_as_float(w.y & 0xffff0000u));
        } else {
          dv[r][i] = make_float4(0.f, 0.f, 0.f, 0.f);
        }
      }
#pragma unroll
    for (int i = 0; i < 4; ++i) {
      g1[i] = (mode == 1) ? *(const float4*)(gD + i * 256 + lane * 4) : make_float4(0.f, 0.f, 0.f, 0.f);
      g2[i] = writeH ? *(const float4*)(gH + i * 256 + lane * 4) : make_float4(0.f, 0.f, 0.f, 0.f);
    }
    __builtin_amdgcn_sched_barrier(0);
    if (mode == 1) {
      float ss0 = 0.f, ss1 = 0.f;
#pragma unroll
      for (int i = 0; i < 4; ++i) {
        ss0 += dv[0][i].x * dv[0][i].x + dv[0][i].y * dv[0][i].y + dv[0][i].z * dv[0][i].z + dv[0][i].w * dv[0][i].w;
        ss1 += dv[1][i].x * dv[1][i].x + dv[1][i].y * dv[1][i].y + dv[1][i].z * dv[1][i].z + dv[1][i].w * dv[1][i].w;
      }
#pragma unroll
      for (int o = 32; o; o >>= 1) { ss0 += __shfl_xor(ss0, o); ss1 += __shfl_xor(ss1, o); }
      const float r0 = rsqrtf(ss0 * (1.0f / DM) + EPSN) * scale;
      const float r1 = rsqrtf(ss1 * (1.0f / DM) + EPSN) * scale;
#pragma unroll
      for (int i = 0; i < 4; ++i) {
        xv[0][i].x += dv[0][i].x * r0 * g1[i].x; xv[0][i].y += dv[0][i].y * r0 * g1[i].y;
        xv[0][i].z += dv[0][i].z * r0 * g1[i].z; xv[0][i].w += dv[0][i].w * r0 * g1[i].w;
        xv[1][i].x += dv[1][i].x * r1 * g1[i].x; xv[1][i].y += dv[1][i].y * r1 * g1[i].y;
        xv[1][i].z += dv[1][i].z * r1 * g1[i].z; xv[1][i].w += dv[1][i].w * r1 * g1[i].w;
      }
    }
#pragma unroll
    for (int r = 0; r < 2; ++r)
#pragma unroll
      for (int i = 0; i < 4; ++i) *(float4*)(p.x + (size_t)(row0 + r) * DM + i * 256 + lane * 4) = xv[r][i];
    if (writeH) {
      float ss0 = 0.f, ss1 = 0.f;
#pragma unroll
      for (int i = 0; i < 4; ++i) {
        ss0 += xv[0][i].x * xv[0][i].x + xv[0][i].y * xv[0][i].y + xv[0][i].z * xv[0][i].z + xv[0][i].w * xv[0][i].w;
        ss1 += xv[1][i].x * xv[1][i].x + xv[1][i].y * xv[1][i].y + xv[1][i].z * xv[1][i].z + xv[1][i].w * xv[1][i].w;
      }
#pragma unroll
      for (int o = 32; o; o >>= 1) { ss0 += __shfl_xor(ss0, o); ss1 += __shfl_xor(ss1, o); }
      const float rr[2] = {rsqrtf(ss0 * (1.0f / DM) + EPSN), rsqrtf(ss1 * (1.0f / DM) + EPSN)};
#pragma unroll
      for (int r = 0; r < 2; ++r)
#pragma unroll
        for (int i = 0; i < 4; ++i) {
          uint2 o;
          o.x = pack2bf(xv[r][i].x * rr[r] * g2[i].x, xv[r][i].y * rr[r] * g2[i].y);
          o.y = pack2bf(xv[r][i].z * rr[r] * g2[i].z, xv[r][i].w * rr[r] * g2[i].w);
          *(uint2*)(H + (size_t)(row0 + r) * DM + i * 256 + lane * 4) = o;
        }
    }
  }
}

__device__ __forceinline__ void phase_rope_table(const Params& p) {
  float2* cs = (float2*)(p.ws + OFF_ROPE);
  const size_t nth = (size_t)VGRID * 256;
  for (size_t e = (size_t)BIDX * 256 + TIDX; e < (size_t)T_TOK * 32; e += nth) {
    const int t = (int)(e >> 5), i = (int)(e & 31);
    const float inv = powf(10000.0f, -(float)i * (2.0f / 64.0f));
    const float ang = (float)p.pos[t] * inv;
    double rev = (double)ang * 0.15915494309189535;
    rev -= floor(rev);
    const float fr = (float)rev;
    cs[e] = make_float2(__builtin_amdgcn_cosf(fr), __builtin_amdgcn_sinf(fr));
  }
}

#define G8REGS_DECL uint4 R_a0, R_a1, R_a2, R_a3, R_b0, R_b1, R_b2, R_b3
#define G8REGS_PARAMS uint4& ra0, uint4& ra1, uint4& ra2, uint4& ra3, uint4& rb0, uint4& rb1, uint4& rb2, uint4& rb3
#define G8REGS_ARGS R_a0, R_a1, R_a2, R_a3, R_b0, R_b1, R_b2, R_b3
template <int MI, int NJ>
__device__ __forceinline__ void gemm8(f32x4 (&acc)[MI][NJ], G8REGS_PARAMS, bool pre, const u16* __restrict__ A, int lda,
                                      const u16* __restrict__ Bt, int ldb, int kbeg, int kend,
                                      int row0, int col0, int nrow0, int ncol0, int nkbeg, u16* smem, int tid) {
  const int lane = tid & 63, wave = tid >> 6;
  const int wm = wave >> 2, wn = wave & 3;
  constexpr int AROWS = 32 * MI;
  constexpr int BROWS = 64 * NJ;
  u16* sA = smem;
  u16* sB = smem + 2 * AROWS * 64;
  const int lrow = tid >> 3, lkc = tid & 7;
  const u16* Ag = A + (size_t)(row0 + lrow) * lda + kbeg + lkc * 8;
  const u16* Bg = Bt + (size_t)(col0 + lrow) * ldb + kbeg + lkc * 8;
  const size_t a64 = (size_t)64 * lda, b64 = (size_t)64 * ldb;
  const int nk = (kend - kbeg) >> 6;
  const long long nAoff = (long long)(nrow0 - row0) * lda + (nkbeg - kbeg);
  const long long nBoff = (long long)(ncol0 - col0) * ldb + (nkbeg - kbeg);
  u16* wa = sA + lrow * 64 + ((lkc ^ (lrow & 7)) * 8);
  u16* wb = sB + lrow * 64 + ((lkc ^ (lrow & 7)) * 8);
#define G8LOADP(ga_, gb_) do { \
    ra0 = *(const uint4*)(ga_); ra1 = *(const uint4*)((ga_) + a64); \
    if (MI == 8) { ra2 = *(const uint4*)((ga_) + 2 * a64); ra3 = *(const uint4*)((ga_) + 3 * a64); } \
    rb0 = *(const uint4*)(gb_); if (NJ >= 2) rb1 = *(const uint4*)((gb_) + b64); \
    if (NJ == 4) { rb2 = *(const uint4*)((gb_) + 2 * b64); rb3 = *(const uint4*)((gb_) + 3 * b64); } } while (0)
#define G8STORE(buf_) do { u16* wa_ = wa + (buf_) * AROWS * 64; u16* wb_ = wb + (buf_) * BROWS * 64; \
    *(uint4*)(wa_) = ra0; *(uint4*)(wa_ + 64 * 64) = ra1; \
    if (MI == 8) { *(uint4*)(wa_ + 128 * 64) = ra2; *(uint4*)(wa_ + 192 * 64) = ra3; } \
    *(uint4*)(wb_) = rb0; if (NJ >= 2) *(uint4*)(wb_ + 64 * 64) = rb1; \
    if (NJ == 4) { *(uint4*)(wb_ + 128 * 64) = rb2; *(uint4*)(wb_ + 192 * 64) = rb3; } } while (0)
  if (!pre) G8LOADP(Ag, Bg);
  G8STORE(0);
  {
    const u16* ga_ = (1 < nk) ? Ag + 64 : Ag + nAoff;
    const u16* gb_ = (1 < nk) ? Bg + 64 : Bg + nBoff;
    G8LOADP(ga_, gb_);
  }
  __syncthreads();
  const int sw0 = ((lane >> 4) ^ (lane & 7)) * 8;
  const int dsw = (sw0 ^ 32) - sw0;
  const u16* ra_ = sA + (wm * (16 * MI) + (lane & 15)) * 64 + sw0;
  const u16* rb_ = sB + (wn * (16 * NJ) + (lane & 15)) * 64 + sw0;
  for (int kt = 0; kt < nk; ++kt) {
    const int buf = kt & 1;
    {
      G8STORE(buf ^ 1);
      const u16* ga_ = (kt + 2 < nk) ? Ag + (kt + 2) * 64 : Ag + nAoff;
      const u16* gb_ = (kt + 2 < nk) ? Bg + (kt + 2) * 64 : Bg + nBoff;
      G8LOADP(ga_, gb_);
    }
    __builtin_amdgcn_sched_barrier(0);
    __builtin_amdgcn_s_setprio(1);
    const u16* a = ra_ + buf * AROWS * 64;
    const u16* b = rb_ + buf * BROWS * 64;
#pragma unroll
    for (int ks = 0; ks < 2; ++ks) {
      const u16* a_ = ks ? a + dsw : a;
      const u16* b_ = ks ? b + dsw : b;
      bf16x8 bfr[NJ];
#pragma unroll
      for (int j = 0; j < NJ; ++j) bfr[j] = *(const bf16x8*)(b_ + j * 16 * 64);
#pragma unroll
      for (int ih = 0; ih < MI / 2; ++ih) {
        bf16x8 af[2];
#pragma unroll
        for (int i = 0; i < 2; ++i) af[i] = *(const bf16x8*)(a_ + (ih * 2 + i) * 16 * 64);
#pragma unroll
        for (int i = 0; i < 2; ++i)
#pragma unroll
          for (int j = 0; j < NJ; ++j) acc[ih * 2 + i][j] = mfma16(af[i], bfr[j], acc[ih * 2 + i][j]);
      }
    }
    __builtin_amdgcn_s_setprio(0);
    __builtin_amdgcn_sched_barrier(0);
    __syncthreads();
  }
#undef G8LOADP
#undef G8STORE
}

#define ZERO_ACC8(acc, NJ_)                             \
  _Pragma("unroll") for (int i_ = 0; i_ < 8; ++i_)      \
  _Pragma("unroll") for (int j_ = 0; j_ < (NJ_); ++j_) { acc[i_][j_] = (f32x4){0.f, 0.f, 0.f, 0.f}; }

__device__ __forceinline__ int real_vb(volatile LAS unsigned* vb_) {
  int b = __builtin_amdgcn_readfirstlane((int)vb_[2]);
  asm volatile("" : "+s"(b));
  return b;
}

__device__ __forceinline__ void phase_ffn_up(const Params& p, const u16* Wgu, u16* smem, volatile LAS unsigned* vb_) {
  const u16* H = (const u16*)(p.ws + OFF_H);
  u16* act = (u16*)(p.ws + OFF_ACT);
  const int tid = RTID;
  const int lane = tid & 63, wave = tid >> 6;
  const int wm = wave >> 2, wn = wave & 3;
  const int vb = real_vb(vb_);
  const int step = gridDim.x >> 3;
  G8REGS_DECL;
  bool pre = false;
  for (int lt = vb >> 3; lt < 8 * 20; lt += step) {
    const int nt = lt >> 3, mt = (vb & 7) * 8 + (lt & 7);
    const int ltn = (lt + step < 8 * 20) ? lt + step : lt;
    f32x4 acc[8][4];
    ZERO_ACC8(acc, 4);
    gemm8<8, 4>(acc, G8REGS_ARGS, pre, H, 1024, Wgu, 1024, 0, 1024, mt * 256, nt * 256,
                ((vb & 7) * 8 + (ltn & 7)) * 256, (ltn >> 3) * 256, 0, smem, tid);
    pre = true;
#pragma unroll
    for (int i = 0; i < 8; ++i)
#pragma unroll
      for (int jp = 0; jp < 2; ++jp) {
#pragma unroll
        for (int r = 0; r < 4; ++r) {
          const float g = acc[i][2 * jp][r], u = acc[i][2 * jp + 1][r];
          smem[(wm * 128 + i * 16 + (lane >> 4) * 4 + r) * 136 + (wn * 2 + jp) * 16 + (lane & 15)] = f2bf(siluf_(g) * u);
        }
        __builtin_amdgcn_sched_barrier(0);
      }
    __syncthreads();
#pragma unroll
    for (int k = 0; k < 8; ++k) {
      const int c = tid + 512 * k;
      const int row = c >> 4, ch = c & 15;
      const uint4 v = *(const uint4*)(smem + row * 136 + ch * 8);
      *(uint4*)(act + (size_t)(mt * 256 + row) * DFF + nt * 128 + ch * 8) = v;
    }
    __syncthreads();
  }
  for (int lt = vb >> 3; lt < 8 * 4; lt += step) {
    const int hn = lt >> 3, mt = (vb & 7) * 8 + (lt & 7);
    f32x4 acc[8][2];
    ZERO_ACC8(acc, 2);
    G8REGS_DECL;
    R_b2 = R_b3 = make_uint4(0u, 0u, 0u, 0u);
    gemm8<8, 2>(acc, G8REGS_ARGS, false, H, 1024, Wgu, 1024, 0, 1024, mt * 256, 5120 + hn * 128, mt * 256, 5120 + hn * 128, 0, smem, tid);
    const int col = (160 + hn * 4 + wn) * 16 + (lane & 15);
#pragma unroll
    for (int i = 0; i < 8; ++i)
#pragma unroll
      for (int r = 0; r < 4; ++r) {
        const int row = mt * 256 + wm * 128 + i * 16 + (lane >> 4) * 4 + r;
        const float g = acc[i][0][r], u = acc[i][1][r];
        act[(size_t)row * DFF + col] = f2bf(siluf_(g) * u);
      }
  }
}

__device__ __forceinline__ void phase_gemm_f32(const u16* A, const u16* Bt, int K, u16* out, u16* smem,
                                               volatile LAS unsigned* vb_) {
  const int tid = RTID;
  const int lane = tid & 63, wave = tid >> 6;
  const int wm = wave >> 2, wn = wave & 3;
  const int vb = real_vb(vb_);
  G8REGS_DECL;
  R_b1 = R_b2 = R_b3 = make_uint4(0u, 0u, 0u, 0u);
  const int step = gridDim.x >> 3;
  bool pre = false;
  for (int lt = vb >> 3; lt < 8 * 4; lt += step) {
    const int nt = lt >> 3, mt = (vb & 7) * 8 + (lt & 7);
    const int ltn = (lt + step < 8 * 4) ? lt + step : lt;
    f32x4 acc[8][4];
    ZERO_ACC8(acc, 4);
    gemm8<8, 4>(acc, G8REGS_ARGS, pre, A, K, Bt, K, 0, K, mt * 256, nt * 256, ((vb & 7) * 8 + (ltn & 7)) * 256, (ltn >> 3) * 256, 0, smem, tid);
    pre = true;
#pragma unroll
    for (int i = 0; i < 8; ++i)
#pragma unroll
      for (int j = 0; j < 4; ++j)
#pragma unroll
        for (int r = 0; r < 4; ++r)
          smem[(wm * 128 + i * 16 + (lane >> 4) * 4 + r) * 264 + wn * 64 + j * 16 + (lane & 15)] = f2bf(acc[i][j][r]);
    __syncthreads();
    const int tid2 = RTID;
#pragma unroll
    for (int k = 0; k < 16; ++k) {
      const int c = tid2 + 512 * k;
      const int row = c >> 5, ch = c & 31;
      const uint4 v = *(const uint4*)(smem + row * 264 + ch * 8);
      *(uint4*)(out + (size_t)(mt * 256 + row) * 1024 + nt * 256 + ch * 8) = v;
    }
    __syncthreads();
  }
}

__device__ __forceinline__ void phase_win(const Params& p, int part, u16* smem, volatile LAS unsigned* vb_) {
  const u16* H = (const u16*)(p.ws + OFF_H);
  const u16* W = (const u16*)(p.ws + W_IN);
  const int tid = RTID;
  const int lane = tid & 63, wave = tid >> 6;
  const int wm = wave >> 2, wn = wave & 3;
  const int NT = part ? 20 : 12;
  const int vb = real_vb(vb_);
  G8REGS_DECL;
  R_b1 = R_b2 = R_b3 = make_uint4(0u, 0u, 0u, 0u);
  const int step = gridDim.x >> 3;
  bool pre = false;
  auto ntile = [&](int nl_) { return (part == 0) ? ((nl_ < 6) ? nl_ : (14 + nl_ - 6)) : ((nl_ < 8) ? (6 + nl_) : (20 + nl_ - 8)); };
  for (int lt = vb >> 3; lt < 8 * NT; lt += step) {
    const int nl = lt >> 3, mt = (vb & 7) * 8 + (lt & 7);
    const int nt = ntile(nl);
    const int ltn = (lt + step < 8 * NT) ? lt + step : lt;
    const int nmt = (vb & 7) * 8 + (ltn & 7), nnt = ntile(ltn >> 3);
    u16* dstA; u16* dstB; int ldA, ldB;
    {
      const int ct = nt * 2;
      if (ct < 12) { dstA = (u16*)(p.ws + OFF_UCONV) + ct * 128; ldA = 1536; }
      else if (ct < 28) { dstA = (u16*)(p.ws + OFF_UHG) + (ct - 12) * 128; ldA = 2048; }
      else if (ct < 40) { dstA = (u16*)(p.ws + OFF_UNSA) + (ct - 28) * 128; ldA = 1536; }
      else { dstA = (u16*)(p.ws + OFF_UMG) + (ct - 40) * 128; ldA = 3072; }
      dstB = dstA + 128; ldB = ldA;
    }
    f32x4 acc[8][4];
    ZERO_ACC8(acc, 4);
    gemm8<8, 4>(acc, G8REGS_ARGS, pre, H, 1024, W, 1024, 0, 1024, mt * 256, nt * 256, nmt * 256, nnt * 256, 0, smem, tid);
    pre = true;
#pragma unroll
    for (int i = 0; i < 8; ++i)
#pragma unroll
      for (int j = 0; j < 4; ++j)
#pragma unroll
        for (int r = 0; r < 4; ++r)
          smem[(wm * 128 + i * 16 + (lane >> 4) * 4 + r) * 264 + wn * 64 + j * 16 + (lane & 15)] = f2bf(acc[i][j][r]);
    __syncthreads();
    const int tid2 = RTID;
#pragma unroll
    for (int k = 0; k < 16; ++k) {
      const int c = tid2 + 512 * k;
      const int row = c >> 5, ch = c & 31;
      const uint4 v = *(const uint4*)(smem + row * 264 + ch * 8);
      u16* d_ = (ch < 16) ? dstA : dstB;
      const int l_ = (ch < 16) ? ldA : ldB;
      *(uint4*)(d_ + (size_t)(mt * 256 + row) * l_ + (ch & 15) * 8) = v;
    }
    __syncthreads();
  }
}

__device__ __forceinline__ void phase_cmp1(const Params& p, u16* smem, volatile LAS unsigned* vb_) {
  const int tid = RTID;
  const int lane = tid & 63, wave = tid >> 6;
  const int wm = wave >> 2, wn = wave & 3;
  const int vb = real_vb(vb_);
  for (int it = vb; it < 64; it += gridDim.x) {
    const int m = it >> 5, mt = (it >> 1) & 15, nt = it & 1;
    const u16* A = (const u16*)(p.ws + OFF_CMPA) + (size_t)m * 2048 * 2048;
    const u16* Bt = (const u16*)(p.ws + W_C1) + (size_t)m * 256 * 2048;
    u16* Hc = (u16*)(p.ws + OFF_HC) + (size_t)m * 2048 * 256;
    f32x4 acc[4][2];
#pragma unroll
    for (int i = 0; i < 4; ++i)
#pragma unroll
      for (int j = 0; j < 2; ++j) acc[i][j] = (f32x4){0.f, 0.f, 0.f, 0.f};
    {
      G8REGS_DECL;
      R_a2 = R_a3 = R_b2 = R_b3 = make_uint4(0u, 0u, 0u, 0u);
      gemm8<4, 2>(acc, G8REGS_ARGS, false, A, 2048, Bt, 2048, 0, 2048, mt * 128, nt * 128, mt * 128, nt * 128, 0, smem, tid);
    }
#pragma unroll
    for (int i = 0; i < 4; ++i)
#pragma unroll
      for (int j = 0; j < 2; ++j) {
        const int col = nt * 128 + wn * 32 + j * 16 + (lane & 15);
#pragma unroll
        for (int r = 0; r < 4; ++r) {
          const int row = mt * 128 + wm * 64 + i * 16 + (lane >> 4) * 4 + r;
          const float x = acc[i][j][r];
          const float u = 0.7978845608028654f * (x + 0.044715f * x * x * x);
          Hc[(size_t)row * 256 + col] = f2bf(x * sigmoidf_(2.0f * u));
        }
      }
  }
}

__device__ __forceinline__ void phase_cmp2(const Params& p, int l, u16* smem) {
  (void)l;
  u16* kcmp = (u16*)(p.ws + OFF_KCMP);
  u16* vcmpT = (u16*)(p.ws + OFF_VCMP);
  const int tid = TIDX;
  const int lane = tid & 63, wave = tid >> 6;
  const int wm = wave >> 1, wn = wave & 1;
  for (int it = BIDX; it < 32; it += VGRID) {
    const int m = it >> 4, mt = it & 15;
    const u16* A = (const u16*)(p.ws + OFF_HC) + (size_t)m * 2048 * 256;
    const u16* Bt = (const u16*)(p.ws + W_C2) + (size_t)m * 64 * 256;
    f32x4 acc[4][2];
#pragma unroll
    for (int i = 0; i < 4; ++i)
#pragma unroll
      for (int j = 0; j < 2; ++j) acc[i][j] = (f32x4){0.f, 0.f, 0.f, 0.f};
    gemm_acc<2>(acc, A, 256, Bt, 256, 0, 256, mt * 128, 0, smem);
#pragma unroll
    for (int i = 0; i < 4; ++i)
#pragma unroll
      for (int j = 0; j < 2; ++j) {
        const int d = wn * 32 + j * 16 + (lane & 15);
#pragma unroll
        for (int r = 0; r < 4; ++r) {
          const int row = mt * 128 + wm * 64 + i * 16 + (lane >> 4) * 4 + r;
          if (row < 2044) {
            const int b = row / 1022, r2 = row % 1022;
            const int n = r2 >> 1, kh = r2 & 1;
            if (m == 0) kcmp[((size_t)(b * 2 + kh) * 8 + (n >> 6)) * 4096 + kfrag_off(n & 63, d)] = f2bf(acc[i][j][r]);
            else vcmpT[((size_t)(b * 2 + kh) * 8 + (n >> 6)) * 4096 + vfrag_off(d, n & 63)] = f2bf(acc[i][j][r]);
          } else {
            const int bk = row - 2044;
            if (m == 0) kcmp[((size_t)bk * 8 + 7) * 4096 + kfrag_off(63, d)] = 0;
            else vcmpT[((size_t)bk * 8 + 7) * 4096 + vfrag_off(d, 63)] = 0;
          }
        }
      }
  }
}

__device__ __forceinline__ void phase_merge(const Params& p, u16* smem, volatile LAS unsigned* vb_) {
  const u16* Y = (const u16*)(p.ws + OFF_Y);
  const u16* W = (const u16*)(p.ws + W_BR);
  const u16* MG = (const u16*)(p.ws + OFF_UMG);
  u16* outp = (u16*)(p.ws + OFF_H);
  const int tid = RTID;
  const int lane = tid & 63, wave = tid >> 6;
  const int wm = wave >> 2, wn = wave & 3;
  const int vb = real_vb(vb_);
  const int step = gridDim.x >> 3;
  for (int lt = vb >> 3; lt < 16 * 4; lt += step) {
    const int nt = lt >> 4, mt = (vb & 7) * 16 + (lt & 15);
    f32x4 tot[4][4];
    ZERO_ACC(tot);
    for (int n = 0; n < 3; ++n) {
      f32x4 acc[4][4];
      ZERO_ACC(acc);
      {
        G8REGS_DECL;
        R_a2 = R_a3 = make_uint4(0u, 0u, 0u, 0u);
        gemm8<4, 4>(acc, G8REGS_ARGS, false, Y, 1536, W, 1536, n * 512, n * 512 + 512, mt * 128, nt * 256,
                    mt * 128, nt * 256, n * 512, smem, tid);
      }
      const int tid2 = RTID;
#pragma unroll
      for (int k = 0; k < 8; ++k) {
        const int c = tid2 + 512 * k;
        const int row = c >> 5, ch = c & 31;
        *(uint4*)(smem + row * 264 + ch * 8) = *(const uint4*)(MG + (size_t)(mt * 128 + row) * 3072 + n * 1024 + nt * 256 + ch * 8);
      }
      __syncthreads();
#pragma unroll
      for (int i = 0; i < 4; ++i)
#pragma unroll
        for (int j = 0; j < 4; ++j)
#pragma unroll
          for (int r = 0; r < 4; ++r) {
            const float g = sigmoidf_(bf2f(smem[(wm * 64 + i * 16 + (lane >> 4) * 4 + r) * 264 + wn * 64 + j * 16 + (lane & 15)]));
            tot[i][j][r] += g * acc[i][j][r];
            if (r == 3) __builtin_amdgcn_sched_barrier(0);
          }
      __syncthreads();
    }
#pragma unroll
    for (int i = 0; i < 4; ++i)
#pragma unroll
      for (int j = 0; j < 4; ++j)
#pragma unroll
        for (int r = 0; r < 4; ++r)
          smem[(wm * 64 + i * 16 + (lane >> 4) * 4 + r) * 264 + wn * 64 + j * 16 + (lane & 15)] = f2bf(tot[i][j][r]);
    __syncthreads();
    const int tid3 = RTID;
#pragma unroll
    for (int k = 0; k < 8; ++k) {
      const int c = tid3 + 512 * k;
      const int row = c >> 5, ch = c & 31;
      *(uint4*)(outp + (size_t)(mt * 128 + row) * 1024 + nt * 256 + ch * 8) = *(const uint4*)(smem + row * 264 + ch * 8);
    }
    __syncthreads();
  }
}

__device__ __forceinline__ void unpack8(const uint4& v, float (&f)[8]) {
  f[0] = __uint_as_float(v.x << 16); f[1] = __uint_as_float(v.x & 0xffff0000u);
  f[2] = __uint_as_float(v.y << 16); f[3] = __uint_as_float(v.y & 0xffff0000u);
  f[4] = __uint_as_float(v.z << 16); f[5] = __uint_as_float(v.z & 0xffff0000u);
  f[6] = __uint_as_float(v.w << 16); f[7] = __uint_as_float(v.w & 0xffff0000u);
}
__device__ __forceinline__ uint4 pack8(const float (&f)[8]) {
  return make_uint4(pack2bf(f[0], f[1]), pack2bf(f[2], f[3]), pack2bf(f[4], f[5]), pack2bf(f[6], f[7]));
}
__device__ __forceinline__ void load8f(const float* p, float (&f)[8]) {
  const float4 a = *(const float4*)(p), b = *(const float4*)(p + 4);
  f[0] = a.x; f[1] = a.y; f[2] = a.z; f[3] = a.w; f[4] = b.x; f[5] = b.y; f[6] = b.z; f[7] = b.w;
}

__device__ __forceinline__ void phase_prep(const Params& p, int l) {
  const u16* Uc = (const u16*)(p.ws + OFF_UCONV);
  const u16* Un = (const u16*)(p.ws + OFF_UNSA);
  u16* Y = (u16*)(p.ws + OFF_Y);
  u16* qr = (u16*)(p.ws + OFF_QR);
  u16* KR = (u16*)(p.ws + OFF_KR);
  u16* VT = (u16*)(p.ws + OFF_VT);
  u16* CA = (u16*)(p.ws + OFF_CMPA);
  float* gates = (float*)(p.ws + OFF_GATES);
  const float* cs = (const float*)(p.ws + OFF_ROPE);
  const int tid = TIDX;
  const size_t nth = (size_t)VGRID * 256;
  const size_t gt = (size_t)BIDX * 256 + tid;
  for (size_t e = gt; e < (size_t)T_TOK * 64; e += nth) {
    const int t = (int)(e >> 6), c0 = (int)(e & 63) * 8;
    const int s = t & (SEQL - 1);
    float w0[8], w1[8], w2[8], bb[8], cv[8], xv[8], acc[8];
    load8f(p.convw + (l * 3 + 0) * 512 + c0, w0);
    load8f(p.convw + (l * 3 + 1) * 512 + c0, w1);
    load8f(p.convw + (l * 3 + 2) * 512 + c0, w2);
    const u16* r2 = Uc + (size_t)t * 1536 + c0;
    unpack8(*(const uint4*)(r2), bb);
    unpack8(*(const uint4*)(r2 + 512), cv);
    unpack8(*(const uint4*)(r2 + 1024), xv);
#pragma unroll
    for (int j = 0; j < 8; ++j) acc[j] = w2[j] * (cv[j] * xv[j]);
    if (s >= 1) {
      unpack8(*(const uint4*)(r2 - 1536 + 512), cv);
      unpack8(*(const uint4*)(r2 - 1536 + 1024), xv);
#pragma unroll
      for (int j = 0; j < 8; ++j) acc[j] += w1[j] * (cv[j] * xv[j]);
    }
    if (s >= 2) {
      unpack8(*(const uint4*)(r2 - 3072 + 512), cv);
      unpack8(*(const uint4*)(r2 - 3072 + 1024), xv);
#pragma unroll
      for (int j = 0; j < 8; ++j) acc[j] += w0[j] * (cv[j] * xv[j]);
    }
#pragma unroll
    for (int j = 0; j < 8; ++j) acc[j] *= bb[j];
    *(uint4*)(Y + (size_t)t * 1536 + c0) = pack8(acc);
  }
  for (size_t e = gt; e < (size_t)2 * 4 * 2048; e += nth) {
    const int m = (int)(e >> 13), rem = (int)(e & 8191);
    CA[((size_t)m * 2048 + 2044) * 2048 + rem] = 0;
  }
  const float* pek = p.pe + (size_t)(l * 2 + 0) * 2048;
  const float* pev = p.pe + (size_t)(l * 2 + 1) * 2048;
  for (int it = BIDX; it < 1024; it += VGRID) {
    const int b = it >> 9, ch = it & 511;
    const int s0 = ch * 16, t0 = b * SEQL + s0;
    for (int idx = tid; idx < 512 + 384; idx += 256) {
      int i, col, d0, m = -1, kh = 0;
      if (idx < 512) { i = idx >> 5; const int rem = idx & 31; col = (rem >> 2) * 64; d0 = (rem & 3) * 8; }
      else { const int k2 = idx - 512; i = k2 / 24; const int rem = k2 % 24; m = rem >> 3; kh = (rem >> 2) & 1; d0 = (rem & 3) * 8; col = 512 + m * 256 + kh * 64; }
      const int t = t0 + i;
      float x1[8], x2[8], c0[8], c1[8], o1[8], o2[8];
      unpack8(*(const uint4*)(Un + (size_t)t * 1536 + col + d0), x1);
      unpack8(*(const uint4*)(Un + (size_t)t * 1536 + col + 32 + d0), x2);
      load8f(cs + ((size_t)t * 32 + d0) * 2, c0);
      load8f(cs + ((size_t)t * 32 + d0) * 2 + 8, c1);
#pragma unroll
      for (int j = 0; j < 8; ++j) {
        const float cc = (j < 4) ? c0[2 * j] : c1[2 * (j - 4)];
        const float sn = (j < 4) ? c0[2 * j + 1] : c1[2 * (j - 4) + 1];
        o1[j] = x1[j] * cc - x2[j] * sn;
        o2[j] = x2[j] * cc + x1[j] * sn;
      }
      if (m < 0) {
        *(uint4*)(qr + (size_t)t * 512 + col + d0) = pack8(o1);
        *(uint4*)(qr + (size_t)t * 512 + col + 32 + d0) = pack8(o2);
      } else {
        u16* kd = KR + (size_t)m * 2097152 + ((size_t)(b * 2 + kh) * 128 + (s0 >> 6)) * 4096;
        *(uint4*)(kd + kfrag_off((s0 & 63) + i, d0)) = pack8(o1);
        *(uint4*)(kd + kfrag_off((s0 & 63) + i, 32 + d0)) = pack8(o2);
        if (m == 0) {
          float pe1[8], pe2[8], a1[8], a2[8];
          if (ch <= 510) {
            load8f(pek + i * 64 + d0, pe1); load8f(pek + i * 64 + 32 + d0, pe2);
#pragma unroll
            for (int j = 0; j < 8; ++j) { a1[j] = o1[j] + pe1[j]; a2[j] = o2[j] + pe2[j]; }
            u16* a = CA + ((size_t)((b * 511 + ch) * 2 + kh)) * 2048 + i * 64;
            *(uint4*)(a + d0) = pack8(a1); *(uint4*)(a + 32 + d0) = pack8(a2);
          }
          if (ch >= 1) {
            load8f(pek + (16 + i) * 64 + d0, pe1); load8f(pek + (16 + i) * 64 + 32 + d0, pe2);
#pragma unroll
            for (int j = 0; j < 8; ++j) { a1[j] = o1[j] + pe1[j]; a2[j] = o2[j] + pe2[j]; }
            u16* a = CA + ((size_t)((b * 511 + ch - 1) * 2 + kh)) * 2048 + (16 + i) * 64;
            *(uint4*)(a + d0) = pack8(a1); *(uint4*)(a + 32 + d0) = pack8(a2);
          }
        }
      }
    }
    {
      const int i = tid >> 4, cc0 = (tid & 15) * 8;
      const int kh = cc0 >> 6, d0 = cc0 & 63;
      float v[8], pe1[8], a1[8];
      unpack8(*(const uint4*)(Un + (size_t)(t0 + i) * 1536 + 640 + cc0), v);
      u16* CAv = CA + (size_t)2048 * 2048;
      if (ch <= 510) {
        load8f(pev + i * 64 + d0, pe1);
#pragma unroll
        for (int j = 0; j < 8; ++j) a1[j] = v[j] + pe1[j];
        *(uint4*)(CAv + ((size_t)((b * 511 + ch) * 2 + kh)) * 2048 + i * 64 + d0) = pack8(a1);
      }
      if (ch >= 1) {
        load8f(pev + (16 + i) * 64 + d0, pe1);
#pragma unroll
        for (int j = 0; j < 8; ++j) a1[j] = v[j] + pe1[j];
        *(uint4*)(CAv + ((size_t)((b * 511 + ch - 1) * 2 + kh)) * 2048 + (16 + i) * 64 + d0) = pack8(a1);
      }
    }
    if (tid < 128) {
      const int m = tid >> 6, c8 = (tid >> 2) & 15, tq4 = tid & 3;
      const int c2 = c8 * 8, kh = c2 >> 6, d0 = c2 & 63;
      uint4 w[4];
#pragma unroll
      for (int j = 0; j < 4; ++j) w[j] = *(const uint4*)(Un + (size_t)(t0 + tq4 * 4 + j) * 1536 + 896 + m * 256 + c2);
      u16* vd = VT + (size_t)m * 2097152 + ((size_t)(b * 2 + kh) * 128 + (s0 >> 6)) * 4096;
      const int key0 = (s0 & 63) + tq4 * 4;
#pragma unroll
      for (int e = 0; e < 8; ++e) {
        u32 h[4];
#pragma unroll
        for (int j = 0; j < 4; ++j) {
          const u32 word = (e < 2) ? w[j].x : (e < 4) ? w[j].y : (e < 6) ? w[j].z : w[j].w;
          h[j] = (e & 1) ? (word >> 16) : (word & 0xffffu);
        }
        uint2 o;
        o.x = h[0] | (h[1] << 16);
        o.y = h[2] | (h[3] << 16);
        *(uint2*)(vd + vfrag_off(d0 + e, key0)) = o;
      }
    }
    for (int idx = tid; idx < 384; idx += 256) {
      const int i = idx / 24, gI = idx % 24;
      gates[(size_t)(t0 + i) * 24 + gI] = sigmoidf_(bf2f(Un[(size_t)(t0 + i) * 1536 + 1280 + gI]));
    }
  }
}

typedef unsigned long long u64;

__device__ __forceinline__ int kfrag_off(int key, int d) {
  return (((key >> 4) * 2 + (d >> 5)) * 64 + ((d >> 3) & 3) * 16 + (key & 15)) * 8 + (d & 7);
}
__device__ __forceinline__ int vfrag_off(int d, int key) {
  return (((d >> 4) * 2 + (key >> 5)) * 64 + ((key >> 2) & 3) * 16 + (d & 15)) * 8 + ((key >> 4) & 1) * 4 + (key & 3);
}
__device__ __forceinline__ void k_load64(bf16x8 (&kq)[8], const u16* __restrict__ Kp, int lane) {
  const u16* kr = Kp + lane * 8;
#pragma unroll
  for (int i = 0; i < 8; ++i) kq[i] = *(const bf16x8*)(kr + i * 512);
}
__device__ __forceinline__ void v_load64(bf16x8 (&vq)[8], const u16* __restrict__ Vp, int lane) {
  const u16* vr = Vp + lane * 8;
#pragma unroll
  for (int i = 0; i < 8; ++i) vq[i] = *(const bf16x8*)(vr + i * 512);
}
template <class MaskF>
__device__ __forceinline__ void qk64(const bf16x8 (&kq)[8], const bf16x8 (&qf)[2], float scale, MaskF maskf, int lane,
                                     f32x4 (&st)[4]) {
  const int q = lane >> 4;
#pragma unroll
  for (int kt = 0; kt < 4; ++kt) {
    f32x4 z = {0.f, 0.f, 0.f, 0.f};
    z = mfma16(kq[2 * kt], qf[0], z);
    z = mfma16(kq[2 * kt + 1], qf[1], z);
#pragma unroll
    for (int r = 0; r < 4; ++r) st[kt][r] = maskf(kt * 16 + q * 4 + r) ? z[r] * scale : -INFINITY;
  }
}
__device__ __forceinline__ void qk64_lim(const bf16x8 (&kq)[8], const bf16x8 (&qf)[2], float scale, int lim2,
                                         f32x4 (&st)[4]) {
#pragma unroll
  for (int kt = 0; kt < 4; ++kt) {
    f32x4 z = {0.f, 0.f, 0.f, 0.f};
    z = mfma16(kq[2 * kt], qf[0], z);
    z = mfma16(kq[2 * kt + 1], qf[1], z);
#pragma unroll
    for (int r = 0; r < 4; ++r) st[kt][r] = ((kt * 16 + r) <= lim2) ? z[r] * scale : -INFINITY;
  }
}
__device__ __forceinline__ void pv64(const bf16x8 (&vq)[8], const f32x4 (&pr)[4], f32x4 (&o)[4]) {
#pragma unroll
  for (int hf = 0; hf < 2; ++hf) {
    uint4 pw;
    pw.x = pack2bf(pr[2 * hf][0], pr[2 * hf][1]); pw.y = pack2bf(pr[2 * hf][2], pr[2 * hf][3]);
    pw.z = pack2bf(pr[2 * hf + 1][0], pr[2 * hf + 1][1]); pw.w = pack2bf(pr[2 * hf + 1][2], pr[2 * hf + 1][3]);
    const bf16x8 pb = __builtin_bit_cast(bf16x8, pw);
#pragma unroll
    for (int dt = 0; dt < 4; ++dt) o[dt] = mfma16(vq[dt * 2 + hf], pb, o[dt]);
  }
}
#define EXP2F(x) __builtin_amdgcn_exp2f(x)
__device__ __forceinline__ void softmax_update(f32x4 (&st)[4], float& m, float& lsum, f32x4 (&o)[4]) {
  float mx = -1e30f;
#pragma unroll
  for (int kt = 0; kt < 4; ++kt)
#pragma unroll
    for (int r = 0; r < 4; ++r) mx = fmaxf(mx, st[kt][r]);
  mx = fmaxf(mx, __shfl_xor(mx, 16));
  mx = fmaxf(mx, __shfl_xor(mx, 32));
  const float mnew = fmaxf(m, mx);
  const float alpha = EXP2F(m - mnew);
  float ps = 0.f;
#pragma unroll
  for (int kt = 0; kt < 4; ++kt)
#pragma unroll
    for (int r = 0; r < 4; ++r) {
      const float pv = EXP2F(st[kt][r] - mnew);
      st[kt][r] = pv;
      ps += pv;
    }
  lsum = lsum * alpha + ps;
  m = mnew;
  if (__builtin_amdgcn_ballot_w64(alpha != 1.0f)) {
#pragma unroll
    for (int dt = 0; dt < 4; ++dt) o[dt] *= alpha;
  }
}

#define SB0 __builtin_amdgcn_sched_barrier(0)

__device__ __forceinline__ void phase_nsa_attn(const Params& p, char* smem, volatile LAS unsigned* vb_) {
  const u16* qr = (const u16*)(p.ws + OFF_QR);
  const u16* kcmp = (const u16*)(p.ws + OFF_KCMP);
  const u16* vcmpT = (const u16*)(p.ws + OFF_VCMP);
  const u16* KS = (const u16*)(p.ws + OFF_KR) + (size_t)1 * 2097152;
  const u16* KW = (const u16*)(p.ws + OFF_KR) + (size_t)2 * 2097152;
  const u16* VS = (const u16*)(p.ws + OFF_VT);
  const u16* VW = (const u16*)(p.ws + OFF_VT) + (size_t)2097152;
  const float* gates = (const float*)(p.ws + OFF_GATES);
  u16* Y = (u16*)(p.ws + OFF_Y);
  const int tid = TIDX;
  const int lane = tid & 63, wave = tid >> 6;
  const int c16 = lane & 15, q = lane >> 4;
  const int tq = c16 >> 2, g = c16 & 3;
  const float scale = 0.125f * 1.4426950408889634f;
  float* impl = (float*)smem + wave * 512;
  const int rvb_ = real_vb(vb_);
  int bid_ = (((rvb_ >> 3) * 2 + HALF_) << 3) | (rvb_ & 7);
  asm volatile("" : "+s"(bid_));
  const int xcd_ = bid_ & 7;
  for (int li = bid_ >> 3; li < 256; li += (VGRID >> 3)) {
    const int b = xcd_ >> 2, kh = (xcd_ >> 1) & 1, grp = li * 2 + (xcd_ & 1);
    const int s0 = (grp * 4 + wave) * 4;
    const int s = s0 + tq;
    const int t = b * SEQL + s;
    const int head = kh * 4 + g;
    bf16x8 qf[2];
    qf[0] = *(const bf16x8*)(qr + (size_t)t * 512 + head * 64 + q * 8);
    qf[1] = *(const bf16x8*)(qr + (size_t)t * 512 + head * 64 + 32 + q * 8);
    const float gt0 = gates[(size_t)t * 24 + kh * 12 + g * 3 + 0];
    const float gt1 = gates[(size_t)t * 24 + kh * 12 + g * 3 + 1];
    const float gt2 = gates[(size_t)t * 24 + kh * 12 + g * 3 + 2];
    const size_t kvb = (size_t)(b * 2 + kh);
    float* yl = (float*)smem + 2048 + wave * 1024 + lane;
    bf16x8 kA[8];
    bf16x8 vA[8];

    {
      const int nvalid = (s >= 31) ? (((s - 31) >> 4) + 1) : 0;
      const int slast = s0 + 3;
      const int nvmax = (slast >= 31) ? (((slast - 31) >> 4) + 1) : 0;
      const int ntile = (nvmax + 63) >> 6;
      const u16* Kb = kcmp + kvb * 512 * 64;
      const u16* Vb = vcmpT + kvb * 64 * 512;
      if (ntile > 0) {
        float m = -1e30f, lsum = 0.f;
        k_load64(kA, Kb, lane);
        for (int i = 0; i < ntile; ++i) {
          const int n0 = i * 64;
          const int nn = (i + 1 < ntile ? i + 1 : i) * 64;
          f32x4 st[4];
          qk64_lim(kA, qf, scale, nvalid - 1 - n0 - q * 4, st);
          SB0;
          k_load64(kA, Kb + (size_t)nn * 64, lane);
          SB0;
          float mx = -1e30f;
#pragma unroll
          for (int kt = 0; kt < 4; ++kt)
#pragma unroll
            for (int r = 0; r < 4; ++r) mx = fmaxf(mx, st[kt][r]);
          mx = fmaxf(mx, __shfl_xor(mx, 16));
          mx = fmaxf(mx, __shfl_xor(mx, 32));
          const float mnew = fmaxf(m, mx);
          float ps = 0.f;
#pragma unroll
          for (int kt = 0; kt < 4; ++kt)
#pragma unroll
            for (int r = 0; r < 4; ++r) ps += EXP2F(st[kt][r] - mnew);
          lsum = lsum * EXP2F(m - mnew) + ps;
          m = mnew;
        }
        lsum += __shfl_xor(lsum, 16);
        lsum += __shfl_xor(lsum, 32);
        const float invl = (lsum > 0.f) ? 1.0f / lsum : 0.f;
        f32x4 o[4];
#pragma unroll
        for (int dt = 0; dt < 4; ++dt) o[dt] = (f32x4){0.f, 0.f, 0.f, 0.f};
        float carry = 0.f;
      SB0;
        k_load64(kA, Kb, lane);
      SB0;
        v_load64(vA, Vb, lane);
      SB0;
        for (int i = 0; i < ntile; ++i) {
          const int n0 = i * 64;
          const int nn = (i + 1 < ntile ? i + 1 : i) * 64;
          f32x4 st[4];
          qk64_lim(kA, qf, scale, nvalid - 1 - n0 - q * 4, st);
          SB0;
          k_load64(kA, Kb + (size_t)nn * 64, lane);
          SB0;
#pragma unroll
          for (int kt = 0; kt < 4; ++kt)
#pragma unroll
            for (int r = 0; r < 4; ++r) st[kt][r] = EXP2F(st[kt][r] - m) * invl;
          pv64(vA, st, o);
          SB0;
          v_load64(vA, Vb + (size_t)nn * 64, lane);
          SB0;
          float mainv[4], ev[4], eup[4];
#pragma unroll
          for (int kt = 0; kt < 4; ++kt) {
            float acc = 0.f, last = 0.f;
#pragma unroll
            for (int r = 0; r < 4; ++r) {
              float a = st[kt][r];
              a += __shfl_xor(a, 1);
              a += __shfl_xor(a, 2);
              acc += a;
              last = a;
            }
            mainv[kt] = acc; ev[kt] = last;
          }
#pragma unroll
          for (int kt = 0; kt < 4; ++kt) eup[kt] = __shfl(ev[kt], (lane + 48) & 63);
#pragma unroll
          for (int kt = 0; kt < 4; ++kt) {
            const float pe = (q > 0) ? eup[kt] : (kt > 0 ? eup[kt > 0 ? kt - 1 : 0] : carry);
            if (g == 0) impl[tq * 128 + (n0 >> 2) + kt * 4 + q] = mainv[kt] + pe;
          }
          carry = eup[3];
        }
#pragma unroll
        for (int dt = 0; dt < 4; ++dt)
#pragma unroll
          for (int r = 0; r < 4; ++r) yl[(dt * 4 + r) * 64] = o[dt][r] * gt0;
      } else {
#pragma unroll
        for (int i = 0; i < 16; ++i) yl[i * 64] = 0.f;
      }
    }

    {
      const u16* Kw = KW + kvb * SEQL * 64;
      const u16* Vw = VW + kvb * 64 * SEQL;
      float m = -1e30f, lsum = 0.f;
      f32x4 o[4];
#pragma unroll
      for (int dt = 0; dt < 4; ++dt) o[dt] = (f32x4){0.f, 0.f, 0.f, 0.f};
      int lo = s0 - 511; if (lo < 0) lo = 0;
      lo &= ~63;
      const int ntile = ((s0 + 3 - lo) >> 6) + 1;
      SB0;
      k_load64(kA, Kw + (size_t)lo * 64, lane);
      SB0;
      v_load64(vA, Vw + (size_t)lo * 64, lane);
      SB0;
      for (int i = 0; i < ntile; ++i) {
        const int k0 = lo + i * 64;
        const int kx = lo + (i + 1 < ntile ? i + 1 : i) * 64;
        f32x4 st[4];
        qk64(kA, qf, scale, [&](int ko) { const int ks = k0 + ko; return (ks <= s) && (ks + 512 > s); }, lane, st);
        SB0;
        k_load64(kA, Kw + (size_t)kx * 64, lane);
        SB0;
        softmax_update(st, m, lsum, o);
        pv64(vA, st, o);
        SB0;
        v_load64(vA, Vw + (size_t)kx * 64, lane);
        SB0;
      }
      lsum += __shfl_xor(lsum, 16);
      lsum += __shfl_xor(lsum, 32);
      const float sc = (lsum > 0.f) ? gt2 / lsum : 0.f;
#pragma unroll
      for (int dt = 0; dt < 4; ++dt)
#pragma unroll
        for (int r = 0; r < 4; ++r) yl[(dt * 4 + r) * 64] += o[dt][r] * sc;
    }

    {
      const u16* Ks = KS + kvb * SEQL * 64;
      const u16* Vs = VS + kvb * 64 * SEQL;
      const int cur = s0 >> 6;
      const int ncand = cur - 2;
      u64 mk0[5], mk1[5];
#pragma unroll
      for (int i = 0; i < 5; ++i) { mk0[i] = 0; mk1[i] = 0; }
      if (ncand <= 13) {
        mk0[0] = (cur >= 63) ? ~0ull : ((1ull << (cur + 1)) - 1ull);
      } else {
        mk0[0] = 1ull;
        if (cur - 1 < 64) mk0[0] |= 1ull << (cur - 1); else mk1[0] |= 1ull << (cur - 1 - 64);
        if (cur < 64) mk0[0] |= 1ull << cur; else mk1[0] |= 1ull << (cur - 64);
#pragma unroll
        for (int tk = 0; tk < 4; ++tk) {
          const float* ir = impl + tk * 128;
          const u32 b0 = (lane >= 1 && lane <= ncand) ? (__float_as_uint(ir[lane]) + 1u) : 0u;
          const u32 b1 = (lane + 64 <= ncand) ? (__float_as_uint(ir[lane + 64]) + 1u) : 0u;
          u32 T = 0u;
          for (int bit = 30; bit >= 0; --bit) {
            const u32 cand = T | (1u << bit);
            const int c = __builtin_popcountll(__builtin_amdgcn_ballot_w64(b0 >= cand)) +
                          __builtin_popcountll(__builtin_amdgcn_ballot_w64(b1 >= cand));
            if (c >= 13) T = cand;
          }
          u64 g0 = __builtin_amdgcn_ballot_w64(b0 > T);
          u64 g1 = __builtin_amdgcn_ballot_w64(b1 > T);
          u64 e0 = __builtin_amdgcn_ballot_w64(b0 == T);
          u64 e1 = __builtin_amdgcn_ballot_w64(b1 == T);
          int need = 13 - __builtin_popcountll(g0) - __builtin_popcountll(g1);
          while (need > 0 && (e0 | e1)) {
            if (e0) { const u64 low = e0 & (~e0 + 1ull); g0 |= low; e0 ^= low; }
            else { const u64 low = e1 & (~e1 + 1ull); g1 |= low; e1 ^= low; }
            --need;
          }
          mk0[tk + 1] = g0; mk1[tk + 1] = g1;
        }
      }
      u64 c0 = mk0[0] | mk0[1] | mk0[2] | mk0[3] | mk0[4];
      u64 c1 = mk1[0] | mk1[1] | mk1[2] | mk1[3] | mk1[4];
      const int ntot = __builtin_popcountll(c0) + __builtin_popcountll(c1);
      const u64 my0 = mk0[0] | ((tq == 0) ? mk0[1] : (tq == 1) ? mk0[2] : (tq == 2) ? mk0[3] : mk0[4]);
      const u64 my1 = mk1[0] | ((tq == 0) ? mk1[1] : (tq == 1) ? mk1[2] : (tq == 2) ? mk1[3] : mk1[4]);
      int jn = 0;
      auto advance = [&]() {
        if (c0) { jn = __builtin_ctzll(c0); c0 &= c0 - 1ull; }
        else if (c1) { jn = 64 + __builtin_ctzll(c1); c1 &= c1 - 1ull; }
      };
      float m = -1e30f, lsum = 0.f;
      f32x4 o[4];
#pragma unroll
      for (int dt = 0; dt < 4; ++dt) o[dt] = (f32x4){0.f, 0.f, 0.f, 0.f};
      advance();
      SB0;
      k_load64(kA, Ks + (size_t)jn * 4096, lane);
      SB0;
      v_load64(vA, Vs + (size_t)jn * 4096, lane);
      SB0;
      for (int i = 0; i < ntot; ++i) {
        const int j = jn;
        if (i + 1 < ntot) advance();
        const bool mine = (((j < 64) ? (my0 >> j) : (my1 >> (j - 64))) & 1ull) != 0ull;
        const int lim2 = (mine ? ((j == cur) ? (s - j * 64) : 63) : -1) - q * 4;
        f32x4 st[4];
        qk64_lim(kA, qf, scale, lim2, st);
        SB0;
        k_load64(kA, Ks + (size_t)jn * 4096, lane);
        SB0;
        softmax_update(st, m, lsum, o);
        pv64(vA, st, o);
        SB0;
        v_load64(vA, Vs + (size_t)jn * 4096, lane);
        SB0;
      }
      lsum += __shfl_xor(lsum, 16);
      lsum += __shfl_xor(lsum, 32);
      const float sc = (lsum > 0.f) ? gt1 / lsum : 0.f;
#pragma unroll
      for (int dt = 0; dt < 4; ++dt) {
        const float y0 = yl[(dt * 4 + 0) * 64] + o[dt][0] * sc, y1 = yl[(dt * 4 + 1) * 64] + o[dt][1] * sc;
        const float y2 = yl[(dt * 4 + 2) * 64] + o[dt][2] * sc, y3 = yl[(dt * 4 + 3) * 64] + o[dt][3] * sc;
        uint2 w;
        w.x = pack2bf(y0, y1);
        w.y = pack2bf(y2, y3);
        *(uint2*)(Y + (size_t)t * 1536 + 1024 + head * 64 + dt * 16 + q * 4) = w;
      }
    }

  }
}

#define BCS 132
__device__ __forceinline__ float hg_lb(const Params& p, int l, int ch) {
  if (l == 0) return 0.f;
  const float a0 = p.lb_logits[ch], a1 = p.lb_logits[512 + ch], a2 = p.lb_logits[1024 + ch], a3 = p.lb_logits[1536 + ch];
  const float mx = fmaxf(fmaxf(a0, a1), fmaxf(a2, a3));
  const float e0 = __expf(a0 - mx), e1 = __expf(a1 - mx), e2 = __expf(a2 - mx), e3 = __expf(a3 - mx);
  const float inv = 1.0f / (e0 + e1 + e2 + e3);
  float sacc = e1;
  if (l >= 2) sacc += e2;
  if (l >= 3) sacc += e3;
  return sacc * inv;
}

__device__ __forceinline__ void hg_bcum(const Params& p, int l, const u16* Uhg, int t0, int h, float* bc, float* lbs,
                                        float* tots) {
  const int tid = TIDX;
  if (tid < 128) lbs[tid] = hg_lb(p, l, h * 128 + tid);
  __syncthreads();
#pragma unroll
  for (int k = 0; k < 4; ++k) {
    const int s = (tid >> 4) + 16 * k, d0 = (tid & 15) * 8;
    float z[8];
    unpack8(*(const uint4*)(Uhg + (size_t)(t0 + s) * 2048 + 512 + h * 128 + d0), z);
    float lf[8];
#pragma unroll
    for (int j = 0; j < 8; ++j) {
      const float lbv = lbs[d0 + j];
      const float f = lbv + (1.0f - lbv) * sigmoidf_(z[j]);
      lf[j] = __logf(fmaxf(f, 1e-30f));
    }
    *(float4*)(bc + s * BCS + d0) = make_float4(lf[0], lf[1], lf[2], lf[3]);
    *(float4*)(bc + s * BCS + d0 + 4) = make_float4(lf[4], lf[5], lf[6], lf[7]);
  }
  __syncthreads();
  {
    const int d = tid & 127, hf = tid >> 7;
    float r[32];
    float run = 0.f;
#pragma unroll
    for (int s = 0; s < 32; ++s) { run += bc[(hf * 32 + s) * BCS + d]; r[s] = run; }
    if (hf == 0) tots[d] = run;
    __syncthreads();
    const float add = hf ? tots[d] : 0.f;
#pragma unroll
    for (int s = 0; s < 32; ++s) bc[(hf * 32 + s) * BCS + d] = r[s] + add;
  }
  __syncthreads();
}

__device__ __forceinline__ void phase_hg_local(const Params& p, int l, char* smem) {
  const u16* Uhg = (const u16*)(p.ws + OFF_UHG);
  u16* states = (u16*)(p.ws + OFF_STATES);
  float* gdec = (float*)(p.ws + OFF_GDEC);
  float* bc = (float*)smem;
  float* lbs = (float*)(smem + 33792);
  u16* KT = (u16*)(smem + 33792 + 512);
  u16* VTs = (u16*)(smem + 33792 + 512 + 18432);
  const int tid = TIDX, lane = tid & 63, wave = tid >> 6;
  const int c16 = lane & 15, q = lane >> 4;
  const int vb0_ = BIDX;
  for (int k_ = 0; k_ < (1024 + VGRID - 1) / VGRID; ++k_) {
    int it = vb0_ + k_ * VGRID;
    if (it > 1023) it = 1023;
    const int b = it >> 9, h = (it >> 7) & 3, c = it & 127;
    const int t0 = b * SEQL + c * 64;
    hg_bcum(p, l, Uhg, t0, h, bc, lbs, (float*)(smem + 71168));
    {
      const int d = tid & 127;
      const float bl = bc[63 * BCS + d];
      for (int idx = tid; idx < 64 * 128; idx += 256) {
        const int s = idx >> 7;
        const float bs = bc[s * BCS + d];
        const float bp = s ? bc[(s - 1) * BCS + d] : 0.f;
        const float kk = 1.0f - __expf(bs - bp);
        KT[d * 72 + s] = f2bf(kk * __expf(bl - bs));
        VTs[d * 72 + s] = Uhg[(size_t)(t0 + s) * 2048 + 1024 + h * 128 + d];
      }
      if (tid < 128) gdec[(size_t)it * 128 + d] = __expf(bl);
    }
    __syncthreads();
    f32x4 acc[2][8];
#pragma unroll
    for (int i = 0; i < 2; ++i)
#pragma unroll
      for (int j = 0; j < 8; ++j) acc[i][j] = (f32x4){0.f, 0.f, 0.f, 0.f};
#pragma unroll
    for (int ks = 0; ks < 2; ++ks) {
      bf16x8 af[2];
#pragma unroll
      for (int i = 0; i < 2; ++i) af[i] = *(const bf16x8*)(VTs + (wave * 32 + i * 16 + c16) * 72 + ks * 32 + q * 8);
#pragma unroll
      for (int j = 0; j < 8; ++j) {
        const bf16x8 bfr = *(const bf16x8*)(KT + (j * 16 + c16) * 72 + ks * 32 + q * 8);
#pragma unroll
        for (int i = 0; i < 2; ++i) acc[i][j] = mfma16(af[i], bfr, acc[i][j]);
      }
    }
    __syncthreads();
    {
      u16* stg = (u16*)smem;
#pragma unroll
      for (int i = 0; i < 2; ++i)
#pragma unroll
        for (int j = 0; j < 8; ++j)
#pragma unroll
          for (int r = 0; r < 4; ++r) stg[(wave * 32 + i * 16 + q * 4 + r) * 136 + j * 16 + c16] = f2bf(acc[i][j][r]);
      __syncthreads();
      u16* st = states + (size_t)it * 16384;
#pragma unroll
      for (int k = 0; k < 8; ++k) {
        const int cc = tid + 256 * k;
        const int row = cc >> 4, ch = cc & 15;
        *(uint4*)(st + row * 128 + ch * 8) = *(const uint4*)(stg + row * 136 + ch * 8);
      }
    }
    __syncthreads();
  }
}

__device__ __forceinline__ void phase_hg_scan(const Params& p) {
  u16* __restrict__ states = (u16*)(p.ws + OFF_STATES);
  const float* __restrict__ gdec = (const float*)(p.ws + OFF_GDEC);
  const size_t nth = (size_t)VGRID * 256;
  for (size_t e = (size_t)BIDX * 256 + TIDX; e < (size_t)8 * 16384; e += nth) {
    const int bh = (int)(e >> 14), vd = (int)(e & 16383), d = vd & 127;
    float S = 0.f;
    for (int c0 = 0; c0 < 128; c0 += 16) {
      float Lv[16], gv[16];
#pragma unroll
      for (int i = 0; i < 16; ++i) {
        const size_t item = (size_t)bh * 128 + c0 + i;
        Lv[i] = bf2f(states[item * 16384 + vd]);
        gv[i] = gdec[item * 128 + d];
      }
#pragma unroll
      for (int i = 0; i < 16; ++i) {
        const size_t item = (size_t)bh * 128 + c0 + i;
        S = gv[i] * S + Lv[i];
        states[item * 16384 + vd] = f2bf(S);
      }
    }
  }
}

__device__ __forceinline__ void phase_hg_out(const Params& p, int l, char* smem) {
  const u16* Uhg = (const u16*)(p.ws + OFF_UHG);
  const u16* states = (const u16*)(p.ws + OFF_STATES);
  u16* Y = (u16*)(p.ws + OFF_Y);
  float* bc = (float*)smem;
  float* lbs = (float*)(smem + 33792);
  u16* VTs = (u16*)(smem + 33792 + 512);
  const int tid = TIDX, lane = tid & 63, wave = tid >> 6;
  const int c16 = lane & 15, q = lane >> 4;
  const int vb0_ = BIDX;
  for (int k_ = 0; k_ < (1024 + VGRID - 1) / VGRID; ++k_) {
    int it = vb0_ + k_ * VGRID;
    if (it > 1023) it = 1023;
    const int b = it >> 9, h = (it >> 7) & 3, c = it & 127;
    const int t0 = b * SEQL + c * 64;
    hg_bcum(p, l, Uhg, t0, h, bc, lbs, (float*)(smem + 71168));
    {
      const int d = tid & 127;
      for (int idx = tid; idx < 64 * 128; idx += 256) {
        const int s = idx >> 7;
        VTs[d * 72 + s] = Uhg[(size_t)(t0 + s) * 2048 + 1024 + h * 128 + d];
      }
    }
    __syncthreads();
    const int tt = wave * 16 + c16;
    const bool hi = (wave >= 2);
    bf16x8 Qt[4], Qh[4];
    float rr8[4][8];
#pragma unroll
    for (int ks = 0; ks < 4; ++ks) {
      const int d0 = ks * 32 + q * 8;
      if (hi) load8f(bc + 31 * BCS + d0, rr8[ks]);
      else {
#pragma unroll
        for (int j = 0; j < 8; ++j) rr8[ks][j] = 0.f;
      }
    }
#pragma unroll
    for (int ks = 0; ks < 4; ++ks) {
      const int d0 = ks * 32 + q * 8;
      const bf16x8 qraw = *(const bf16x8*)(Uhg + (size_t)(t0 + tt) * 2048 + h * 128 + d0);
      float bt8[8];
      load8f(bc + tt * BCS + d0, bt8);
      uint4 wt, wh;
      float a_[8], b_[8];
#pragma unroll
      for (int j = 0; j < 8; ++j) {
        const float qv = siluf_(bf2f((u16)qraw[j]));
        a_[j] = qv * __expf(bt8[j] - rr8[ks][j]);
        b_[j] = qv * __expf(bt8[j]);
      }
      wt = pack8(a_); wh = pack8(b_);
      Qt[ks] = __builtin_bit_cast(bf16x8, wt);
      Qh[ks] = __builtin_bit_cast(bf16x8, wh);
    }
    f32x4 at[4];
#pragma unroll
    for (int st = 0; st < 4; ++st) {
      at[st] = (f32x4){0.f, 0.f, 0.f, 0.f};
      if (st <= wave) {
        f32x4 a = {0.f, 0.f, 0.f, 0.f};
        const int srow = st * 16 + c16;
#pragma unroll
        for (int ks = 0; ks < 4; ++ks) {
          const int d0 = ks * 32 + q * 8;
          float bs8[8], bp8[8], kv[8];
          load8f(bc + srow * BCS + d0, bs8);
          if (srow > 0) load8f(bc + (srow - 1) * BCS + d0, bp8);
          else {
#pragma unroll
            for (int j = 0; j < 8; ++j) bp8[j] = 0.f;
          }
#pragma unroll
          for (int j = 0; j < 8; ++j) {
            const float kk = 1.0f - __expf(bs8[j] - bp8[j]);
            const float ex = fminf(rr8[ks][j] - bs8[j], 80.f);
            kv[j] = kk * __expf(ex);
          }
          const uint4 wk = pack8(kv);
          a = mfma16(__builtin_bit_cast(bf16x8, wk), Qt[ks], a);
        }
        int tt2 = tt;
        asm volatile("" : "+v"(tt2));
#pragma unroll
        for (int r = 0; r < 4; ++r) at[st][r] = ((st * 16 + q * 4 + r) <= tt2) ? a[r] : 0.f;
      }
    }
    bf16x8 pb[2];
#pragma unroll
    for (int sp = 0; sp < 2; ++sp)
#pragma unroll
      for (int j = 0; j < 4; ++j) {
        pb[sp][j] = (short)f2bf(at[2 * sp][j]);
        pb[sp][4 + j] = (short)f2bf(at[2 * sp + 1][j]);
      }
    f32x4 o[8];
    float ss = 0.f;
    const u16* Sp = states + (size_t)(it - 1) * 16384;
#pragma unroll
    for (int vt = 0; vt < 8; ++vt) {
      f32x4 acc = {0.f, 0.f, 0.f, 0.f};
#pragma unroll
      for (int sp = 0; sp < 2; ++sp) {
        if (2 * sp <= wave) {
          const u16* vr = VTs + (vt * 16 + c16) * 72 + sp * 32 + q * 4;
          const bf16x4 va = *(const bf16x4*)(vr);
          const bf16x4 vb = *(const bf16x4*)(vr + 16);
          const bf16x8 vf = __builtin_shufflevector(va, vb, 0, 1, 2, 3, 4, 5, 6, 7);
          acc = mfma16(vf, pb[sp], acc);
        }
      }
      o[vt] = acc;
    }
    if (c > 0) {
#pragma unroll
      for (int ks = 0; ks < 4; ++ks) {
        bf16x8 sf[8];
#pragma unroll
        for (int vt = 0; vt < 8; ++vt) sf[vt] = *(const bf16x8*)(Sp + (size_t)(vt * 16 + c16) * 128 + ks * 32 + q * 8);
#pragma unroll
        for (int vt = 0; vt < 8; ++vt) o[vt] = mfma16(sf[vt], Qh[ks], o[vt]);
      }
    }
#pragma unroll
    for (int vt = 0; vt < 8; ++vt)
#pragma unroll
      for (int r = 0; r < 4; ++r) ss += o[vt][r] * o[vt][r];
    ss += __shfl_xor(ss, 16);
    ss += __shfl_xor(ss, 32);
    const float rinv = rsqrtf(ss * (1.0f / 128.0f) + EPSN);
    const size_t trow = (size_t)(t0 + tt);
#pragma unroll
    for (int vt = 0; vt < 8; ++vt) {
      const int v0 = vt * 16 + q * 4;
      const uint2 graw = *(const uint2*)(Uhg + trow * 2048 + 1536 + h * 128 + v0);
      const float4 gn = *(const float4*)(p.gnorm + l * 128 + v0);
      const float y0 = o[vt][0] * rinv * gn.x * siluf_(bf2f((u16)(graw.x & 0xffff)));
      const float y1 = o[vt][1] * rinv * gn.y * siluf_(bf2f((u16)(graw.x >> 16)));
      const float y2 = o[vt][2] * rinv * gn.z * siluf_(bf2f((u16)(graw.y & 0xffff)));
      const float y3 = o[vt][3] * rinv * gn.w * siluf_(bf2f((u16)(graw.y >> 16)));
      uint2 w;
      w.x = pack2bf(y0, y1);
      w.y = pack2bf(y2, y3);
      *(uint2*)(Y + trow * 1536 + 512 + h * 128 + v0) = w;
    }
    __syncthreads();
  }
}


#define XB_TMO      128
#define XB_XCNT(j)  (256  + 64 * (j))
#define XB_XSUB(j)  (1280 + 64 * (j))
#define XB_XGEN(j)  (2304 + 64 * (j))
#define XB_TOP      3328
#define XB_TOPGEN   3392
#define XCD_BAR_WORDS 3456
#define XB_SPIN_CAP (1u << 18)

__device__ __forceinline__ unsigned xb_ld(unsigned* p)              { return __hip_atomic_load(p, __ATOMIC_RELAXED, __HIP_MEMORY_SCOPE_AGENT); }
__device__ __forceinline__ unsigned xb_add(unsigned* p, unsigned v) { return __hip_atomic_fetch_add(p, v, __ATOMIC_RELAXED, __HIP_MEMORY_SCOPE_AGENT); }
__device__ __forceinline__ unsigned xb_xcc_id() { return (unsigned)__builtin_amdgcn_s_getreg((3 << 11) | 20) & 0xFu; }
#define XB_SPIN(cond, bar) do { unsigned _sp = 0; while (cond) { __builtin_amdgcn_s_sleep(1); \
    if ((++_sp & 255u) == 0u) { if (xb_ld(&(bar)[XB_TMO])) break; if (_sp > XB_SPIN_CAP) { atomicAdd(&(bar)[XB_TMO], 1u); break; } } } } while (0)

struct XcdBarrier { unsigned* bar; unsigned x; volatile LAS unsigned* st; };

__device__ __forceinline__ XcdBarrier xcd_barrier_post(unsigned* bar, volatile LAS unsigned* st) {
    XcdBarrier b; b.bar = bar; b.x = xb_xcc_id(); b.st = st;
    if (threadIdx.x == 0) st[3] = xb_add(&bar[XB_XCNT(b.x)], 1u);
    return b;
}
__device__ __forceinline__ void xcd_barrier_complete(unsigned* bar, unsigned x, unsigned& nloc, unsigned& nx) {
    const unsigned G = gridDim.x * gridDim.y * gridDim.z;
    unsigned sum, cnt, mine, sp = 0u;
    for (;;) {
        sum = 0u; cnt = 0u; mine = 0u;
#pragma unroll
        for (unsigned j = 0; j < 16; ++j) { const unsigned c = xb_ld(&bar[XB_XCNT(j)]); sum += c; cnt += (c > 0u) ? 1u : 0u; mine = (j == x) ? c : mine; }
        if (sum == G) break;
        __builtin_amdgcn_s_sleep(1);
        if ((++sp & 255u) == 0u) { if (xb_ld(&bar[XB_TMO])) break; if (sp > XB_SPIN_CAP) { atomicAdd(&bar[XB_TMO], 1u); break; } }
    }
    nloc = mine > 0u ? mine : 1u; nx = cnt > 0u ? cnt : 1u;
}
__device__ __forceinline__ void xcd_barrier(const XcdBarrier& b) {
    asm volatile("s_waitcnt vmcnt(0)" ::: "memory");
    __syncthreads();
    if (threadIdx.x == 0) {
        unsigned* bar = b.bar;
        __builtin_amdgcn_s_waitcnt(0);
        unsigned nloc = b.st[0], nx = b.st[1];
        if (nloc == 0u) { xcd_barrier_complete(bar, b.x, nloc, nx); b.st[0] = nloc; b.st[1] = nx; }
        const unsigned old = xb_add(&bar[XB_XSUB(b.x)], 1u);
        const unsigned gen = old / nloc;
        if (old + 1u == (gen + 1u) * nloc) {
            __builtin_amdgcn_fence(__ATOMIC_RELEASE, "agent");
            asm volatile("s_waitcnt vmcnt(0)" ::: "memory");
            const unsigned og = xb_add(&bar[XB_TOP], 1u);
            const unsigned tg = og / nx;
            if (og + 1u == (tg + 1u) * nx) xb_add(&bar[XB_TOPGEN], 1u);
            else XB_SPIN(xb_ld(&bar[XB_TOPGEN]) == tg, bar);
            __builtin_amdgcn_fence(__ATOMIC_ACQUIRE, "agent");
            xb_add(&bar[XB_XGEN(b.x)], 1u);
            asm volatile("s_waitcnt vmcnt(0)" ::: "memory");
        } else {
            XB_SPIN(xb_ld(&bar[XB_XGEN(b.x)]) == gen, bar);
            __builtin_amdgcn_fence(__ATOMIC_ACQUIRE, "agent");
            asm volatile("s_waitcnt vmcnt(0)" ::: "memory");
        }
    }
    __syncthreads();
}

#define SMEM_HALF 71680
#define SMEM_BYTES 143360
#ifndef XREP
#define XREP 0
#endif
#ifndef REPMASK
#define REPMASK 0
#endif
#define NREP(st) (((st) >= 0 && (st) != 2 && (st) != 7 && (st) != 11 && (st) != 14 && ((REPMASK >> (st)) & 1)) ? 2 : 1)
__global__ void __launch_bounds__(512, 2) mega(Params p) {
  cg::grid_group grid = cg::this_grid();
  __shared__ __attribute__((aligned(16))) char smem[SMEM_BYTES];
  __shared__ uint4 xb_words;
  u16* sm16 = (u16*)smem;
  char* smh = smem + (int)HALF_ * SMEM_HALF;
  char* ws = p.ws;
  if (threadIdx.x == 0) xb_words = make_uint4(0u, 0u, 0u, 0u);
  __syncthreads();
  XcdBarrier xb = xcd_barrier_post((unsigned*)(ws + OFF_BAR), (volatile LAS unsigned*)&xb_words);
  if (threadIdx.x == 0) ((volatile LAS unsigned*)&xb_words)[2] = blockIdx.x;
  for (int gs = -1; gs < 60; ++gs) {
    const int l = (gs < 0) ? 0 : gs / 15;
    const int st = (gs < 0) ? -1 : gs % 15;
    const float* g = p.gains + (size_t)l * 6 * 1024;
    for (int rep_ = 0; rep_ < NREP(st); ++rep_) {
    if (st == 0 || st == 12) {
      phase_ffn_up(p, (const u16*)(ws + (st == 0 ? W_GU0 : W_GU1)), sm16, xb.st);
    } else if (st == 1 || st == 10 || st == 13) {
      const u16* A = (const u16*)(ws + (st == 10 ? OFF_H : OFF_ACT));
      const u16* Bt = (const u16*)(ws + (st == 10 ? W_OUT : (st == 1 ? W_D0 : W_D1)));
      const int K = (st == 10) ? 1024 : DFF;
      u16* outp = (u16*)(ws + (st == 10 ? OFF_D2 : OFF_D));
      phase_gemm_f32(A, Bt, K, outp, sm16, xb.st);
    } else if (st == -1 || st == 2 || st == 11 || st == 14) {
      if (st == -1) phase_rope_table(p);
      const int mode = (st == -1) ? 0 : 1;
      const u16* D = (const u16*)(ws + (st == 11 ? OFF_D2 : OFF_D));
      const float* gD = g + (st == 2 ? 1 : (st == 11 ? 3 : 5)) * 1024;
      const float scale = (st == 11) ? 1.0f : 0.5f;
      const float* gH = (st == -1) ? g : g + (st == 2 ? 2 : (st == 11 ? 4 : 6)) * 1024;
      const bool writeH = !(st == 14 && l == 3);
      phase_norm(p, mode, D, gD, scale, gH, writeH);
      if (XREP == 3) phase_norm(p, 2, D, gD, scale, gH, writeH);
      if (XREP == 4 && (st == -1 || (st == 14 && l < 3))) phase_convert(p, (st == -1) ? 0 : l + 1, (float*)smh);
      if (st == -1 || (st == 14 && l < 3)) phase_convert(p, (st == -1) ? 0 : l + 1, (float*)smh);
    } else if (st == 3 || st == 5) {
      phase_win(p, st == 5 ? 1 : 0, sm16, xb.st);
      if (st == 5) phase_cmp1(p, sm16, xb.st);
    } else if (st == 4) {
      phase_prep(p, l);
    } else if (st == 6) {
      phase_cmp2(p, l, (u16*)smh);
      phase_hg_local(p, l, smh);
    } else if (st == 7) {
      for (int r2_ = 0; r2_ < (XREP == 1 ? 2 : 1); ++r2_) phase_nsa_attn(p, smh, xb.st);
      phase_hg_scan(p);
    } else if (st == 8) {
      phase_hg_out(p, l, smh);
    } else if (st == 9) {
      phase_merge(p, sm16, xb.st);
    }
    }
    if (gs < 0) {
      grid.sync();
      if (threadIdx.x == 0) {
        unsigned* bar = (unsigned*)(ws + OFF_BAR);
        unsigned npop = 0, lower = 0, mine = 0; bool uni = true; unsigned first = 0;
        unsigned myx = xb.x;
        asm volatile("" : "+s"(myx));
#pragma unroll 1
        for (unsigned j = 0; j < 16; ++j) {
          const unsigned c = xb_ld(&bar[XB_XCNT(j)]);
          if (c > 0u) { if (npop == 0u) first = c; else if (c != first) uni = false; ++npop; if (j < myx) ++lower; }
          if (j == myx) mine = c;
        }
        const unsigned rank = ((volatile LAS unsigned*)&xb_words)[3];
        unsigned v = blockIdx.x;
        if (uni && npop == 8u && mine * 8u == gridDim.x && rank < mine) v = rank * 8u + lower;
        ((volatile LAS unsigned*)&xb_words)[2] = v;
      }
      __syncthreads();
    }
    else if (gs < 59) xcd_barrier(xb);
    if (XREP == 2 && gs < 59) xcd_barrier(xb);
  }
}

extern "C" void kernel_launch(void* const* d_in, const int* in_sizes, int n_in,
                              void* d_out, int out_size, void* d_ws, size_t ws_size,
                              hipStream_t stream) {
  static int grid_blocks = 0;
  if (!grid_blocks) {
    int dev = 0, cus = 0, per_cu = 0;
    hipGetDevice(&dev);
    hipDeviceGetAttribute(&cus, hipDeviceAttributeMultiprocessorCount, dev);
    hipOccupancyMaxActiveBlocksPerMultiprocessor(&per_cu, mega, 512, 0);
    if (per_cu > 1) per_cu = 1;
    if (per_cu < 1) per_cu = 1;
    grid_blocks = cus * per_cu;
  }
  if (ws_size < (size_t)WS_NEEDED) {
    fprintf(stderr, "workspace too small: %zu < %zu\n", ws_size, (size_t)WS_NEEDED);
    return;
  }
  Params p{};
  p.x_in = (const float*)d_in[0];
  p.pos = (const int*)d_in[1];
  p.lb_logits = (const float*)d_in[2];
  p.gains = (const float*)d_in[3];
  p.wg = (const float*)d_in[4];
  p.wu = (const float*)d_in[5];
  p.wd = (const float*)d_in[6];
  p.win = (const float*)d_in[7];
  p.convw = (const float*)d_in[8];
  p.gnorm = (const float*)d_in[9];
  p.pe = (const float*)d_in[10];
  p.cw1 = (const float*)d_in[11];
  p.cw2 = (const float*)d_in[12];
  p.wbr = (const float*)d_in[13];
  p.wout = (const float*)d_in[14];
  p.x = (float*)d_out;
  p.ws = (char*)d_ws;
  hipMemsetAsync((char*)d_ws + OFF_BAR, 0, 16384, stream);
  void* args[] = {&p};
  hipError_t e = hipLaunchCooperativeKernel((void*)mega, dim3(grid_blocks), dim3(512), args, 0, stream);
  if (e != hipSuccess) fprintf(stderr, "coop launch failed: %s (grid %d)\n", hipGetErrorString(e), grid_blocks);
}
```

```cpp
#include <hip/hip_runtime.h>
#include <hip/hip_cooperative_groups.h>
#include <cstdio>
namespace cg = cooperative_groups;

#define LAS __attribute__((address_space(3)))
typedef unsigned short u16;
typedef unsigned int u32;
typedef __attribute__((ext_vector_type(8))) short bf16x8;
typedef __attribute__((ext_vector_type(4))) short bf16x4;
typedef __attribute__((ext_vector_type(4))) float f32x4;

#define T_TOK 16384
#define SEQL 8192
#define DM 1024
#define DFF 2816
#define EPSN 1e-6f

#define W_GU0 0ul
#define W_D0 11534336ul
#define W_GU1 17301504ul
#define W_D1 28835840ul
#define W_IN 34603008ul
#define W_BR (W_IN + 16777216ul)
#define W_OUT (W_BR + 3145728ul)
#define W_C1 (W_OUT + 2097152ul)
#define W_C2 (W_C1 + 2097152ul)
#define OFF_H (W_C2 + 65536ul)
#define OFF_ACT (OFF_H + 33554432ul)
#define OFF_STATES OFF_ACT
#define OFF_KR (OFF_ACT + 67108864ul)
#define OFF_VT (OFF_KR + 12582912ul)
#define OFF_D (OFF_ACT + 92274688ul)
#define OFF_Y OFF_D
#define OFF_IMP (OFF_D + 50331648ul)
#define OFF_U1 (OFF_D + 67108864ul)
#define OFF_UCONV OFF_U1
#define OFF_UNSA (OFF_U1 + 50331648ul)
#define OFF_UHG OFF_U1
#define OFF_D2 OFF_U1
#define OFF_UMG (OFF_U1 + 100663296ul)
#define OFF_QR (OFF_UMG + 100663296ul)
#define OFF_CMPA (OFF_QR + 16777216ul)
#define OFF_OCMP (OFF_CMPA + 16777216ul)
#define OFF_ROPE (OFF_QR + 50331648ul)
#define OFF_HC (OFF_ROPE + 4194304ul)
#define OFF_GATES (OFF_HC + 2097152ul)
#define OFF_GDEC (OFF_GATES + 1572864ul)
#define OFF_KCMP (OFF_GDEC + 524288ul)
#define OFF_VCMP (OFF_KCMP + 262144ul)
#define OFF_BAR (OFF_VCMP + 262144ul)
#define WS_NEEDED (OFF_BAR + 16384ul)

struct Params {
  const float* x_in; const int* pos; const float* lb_logits; const float* gains;
  const float* wg; const float* wu; const float* wd; const float* win; const float* convw;
  const float* gnorm; const float* pe; const float* cw1; const float* cw2; const float* wbr; const float* wout;
  float* x; char* ws;
};

__device__ __forceinline__ int opaque_tid() { int t = threadIdx.x; asm volatile("" : "+v"(t)); return t; }
__device__ __forceinline__ int opaque_bid() { int t = blockIdx.x; asm volatile("" : "+s"(t)); return t; }
#define RTID opaque_tid()
#define TIDX (opaque_tid() & 255)
#define HALF_ (__builtin_amdgcn_readfirstlane(opaque_tid() >> 8))
#define BIDX (opaque_bid() * 2 + HALF_)
#define VGRID ((int)gridDim.x * 2)

typedef __attribute__((ext_vector_type(2))) __bf16 bf16v2_t;
typedef __attribute__((ext_vector_type(2))) float f32v2_t;
__device__ __forceinline__ u16 f2bf(float f) { const __bf16 b = (__bf16)f; return __builtin_bit_cast(u16, b); }
__device__ __forceinline__ u32 pack2bf(float lo, float hi) {
  const f32v2_t v = {lo, hi};
  const bf16v2_t w = __builtin_convertvector(v, bf16v2_t);
  return __builtin_bit_cast(u32, w);
}
__device__ __forceinline__ float bf2f(u16 h) { return __uint_as_float(((u32)h) << 16); }
__device__ __forceinline__ float sigmoidf_(float x) { return 1.0f / (1.0f + __expf(-x)); }
__device__ __forceinline__ float siluf_(float x) { return x / (1.0f + __expf(-x)); }
__device__ __forceinline__ float wave_sum(float v) {
#pragma unroll
  for (int o = 32; o; o >>= 1) v += __shfl_xor(v, o);
  return v;
}
__device__ __forceinline__ int kfrag_off(int key, int d);
__device__ __forceinline__ int vfrag_off(int d, int key);
__device__ __forceinline__ f32x4 mfma16(bf16x8 a, bf16x8 b, f32x4 c) {
  return __builtin_amdgcn_mfma_f32_16x16x32_bf16(a, b, c, 0, 0, 0);
}

#define LSTR 64
template <int NJ>
__device__ __forceinline__ void gemm_acc(f32x4 (&acc)[4][NJ], const u16* __restrict__ A, int lda,
                                         const u16* __restrict__ Bt, int ldb, int kbeg, int kend,
                                         int row0, int col0, u16* smem) {
  const int tid = TIDX;
  const int lane = tid & 63, wave = tid >> 6;
  const int wm = wave >> 1, wn = wave & 1;
  u16* sA = smem;
  u16* sB = smem + 2 * 128 * LSTR;
  const int lrow = tid >> 3, lkc = tid & 7;
  const u16* Ag = A + (size_t)(row0 + lrow) * lda + kbeg + lkc * 8;
  const u16* Bg = Bt + (size_t)(col0 + lrow) * ldb + kbeg + lkc * 8;
  const size_t a32 = (size_t)32 * lda, b32 = (size_t)32 * ldb;
  uint4 ra0, ra1, ra2, ra3, rb0, rb1, rb2, rb3;
  const int nk = (kend - kbeg) >> 6;
  ra0 = *(const uint4*)(Ag); ra1 = *(const uint4*)(Ag + a32); ra2 = *(const uint4*)(Ag + 2 * a32); ra3 = *(const uint4*)(Ag + 3 * a32);
  rb0 = *(const uint4*)(Bg); rb1 = *(const uint4*)(Bg + b32);
  if (NJ == 4) { rb2 = *(const uint4*)(Bg + 2 * b32); rb3 = *(const uint4*)(Bg + 3 * b32); }
  {
    u16* wa = sA + lrow * LSTR + ((lkc ^ (lrow & 7)) * 8);
    u16* wb = sB + lrow * LSTR + ((lkc ^ (lrow & 7)) * 8);
    *(uint4*)(wa) = ra0; *(uint4*)(wa + 32 * LSTR) = ra1; *(uint4*)(wa + 64 * LSTR) = ra2; *(uint4*)(wa + 96 * LSTR) = ra3;
    *(uint4*)(wb) = rb0; *(uint4*)(wb + 32 * LSTR) = rb1;
    if (NJ == 4) { *(uint4*)(wb + 64 * LSTR) = rb2; *(uint4*)(wb + 96 * LSTR) = rb3; }
  }
  __syncthreads();
  for (int kt = 0; kt < nk; ++kt) {
    const int buf = kt & 1;
    const bool more = (kt + 1 < nk);
    if (more) {
      const u16* Ak = Ag + (kt + 1) * 64;
      const u16* Bk = Bg + (kt + 1) * 64;
      ra0 = *(const uint4*)(Ak); ra1 = *(const uint4*)(Ak + a32); ra2 = *(const uint4*)(Ak + 2 * a32); ra3 = *(const uint4*)(Ak + 3 * a32);
      rb0 = *(const uint4*)(Bk); rb1 = *(const uint4*)(Bk + b32);
      if (NJ == 4) { rb2 = *(const uint4*)(Bk + 2 * b32); rb3 = *(const uint4*)(Bk + 3 * b32); }
    }
    __builtin_amdgcn_sched_barrier(0);
    const int swz = (((lane >> 4) ^ (lane & 7)) * 8);
    const u16* a = sA + buf * 128 * LSTR + (wm * 64 + (lane & 15)) * LSTR;
    const u16* b = sB + buf * 128 * LSTR + (wn * (NJ * 16) + (lane & 15)) * LSTR;
#pragma unroll
    for (int ks = 0; ks < 2; ++ks) {
      bf16x8 af[4], bfr[NJ];
      const int so = swz ^ (ks * 32);
#pragma unroll
      for (int i = 0; i < 4; ++i) af[i] = *(const bf16x8*)(a + i * 16 * LSTR + so);
#pragma unroll
      for (int j = 0; j < NJ; ++j) bfr[j] = *(const bf16x8*)(b + j * 16 * LSTR + so);
#pragma unroll
      for (int i = 0; i < 4; ++i)
#pragma unroll
        for (int j = 0; j < NJ; ++j) acc[i][j] = mfma16(af[i], bfr[j], acc[i][j]);
    }
    __builtin_amdgcn_sched_barrier(0);
    if (more) {
      const int nb = buf ^ 1;
      u16* wa = sA + nb * 128 * LSTR + lrow * LSTR + ((lkc ^ (lrow & 7)) * 8);
      u16* wb = sB + nb * 128 * LSTR + lrow * LSTR + ((lkc ^ (lrow & 7)) * 8);
      *(uint4*)(wa) = ra0; *(uint4*)(wa + 32 * LSTR) = ra1; *(uint4*)(wa + 64 * LSTR) = ra2; *(uint4*)(wa + 96 * LSTR) = ra3;
      *(uint4*)(wb) = rb0; *(uint4*)(wb + 32 * LSTR) = rb1;
      if (NJ == 4) { *(uint4*)(wb + 64 * LSTR) = rb2; *(uint4*)(wb + 96 * LSTR) = rb3; }
    }
    __syncthreads();
  }
}

#define ZERO_ACC(acc)                                  \
  _Pragma("unroll") for (int i_ = 0; i_ < 4; ++i_)     \
  _Pragma("unroll") for (int j_ = 0; j_ < 4; ++j_) { acc[i_][j_] = (f32x4){0.f, 0.f, 0.f, 0.f}; }

#define CONV_ITEMS 7176
__device__ __forceinline__ void convert_tile(const Params& p, int l, int item, float* tile) {
  const int tid = TIDX;
  int id, loc;
  if (item < 1408) { id = 0; loc = item; }
  else if (item < 2112) { id = 1; loc = item - 1408; }
  else if (item < 3520) { id = 2; loc = item - 2112; }
  else if (item < 4224) { id = 3; loc = item - 3520; }
  else if (item < 6272) { id = 4; loc = item - 4224; }
  else if (item < 6656) { id = 5; loc = item - 6272; }
  else if (item < 6912) { id = 6; loc = item - 6656; }
  else if (item < 7168) { id = 7; loc = item - 6912; }
  else { id = 8; loc = item - 7168; }
  int KT = 16;
  if (id == 1 || id == 3) KT = 44; else if (id == 5) KT = 24; else if (id == 7) KT = 32; else if (id == 8) KT = 4;
  const int nt = loc / KT, kt = loc % KT;
  const int n0 = nt * 64, k0 = kt * 64;
  const int tn = tid & 63, tk = tid >> 6;
  const int n = n0 + tn;
  const float* src = nullptr; size_t ldsrc = 0; bool zero = false;
  u16* dst = nullptr; int lddst = 0;
  char* ws = p.ws;
  if (id == 0 || id == 2) {
    const int f = id >> 1;
    const int pp = n >> 5, s = (n >> 4) & 1, i = n & 15;
    src = (s ? p.wu : p.wg) + (size_t)(l * 2 + f) * 1024 * DFF + (pp * 16 + i);
    ldsrc = DFF; dst = (u16*)(ws + (f ? W_GU1 : W_GU0)); lddst = 1024;
  } else if (id == 1 || id == 3) {
    const int f = id >> 1;
    src = p.wd + (size_t)(l * 2 + f) * DFF * 1024 + n;
    ldsrc = 1024; dst = (u16*)(ws + (f ? W_D1 : W_D0)); lddst = DFF;
  } else if (id == 4) {
    int col = n;
    if (n >= 4888 && n < 5120) { zero = true; col = 0; }
    else if (n >= 5120) col = n - 232;
    src = p.win + (size_t)l * 1024 * 7960 + col;
    ldsrc = 7960; dst = (u16*)(ws + W_IN); lddst = 1024;
  } else if (id == 5) {
    src = p.wbr + (size_t)l * 1536 * 1024 + n;
    ldsrc = 1024; dst = (u16*)(ws + W_BR); lddst = 1536;
  } else if (id == 6) {
    src = p.wout + (size_t)l * 1024 * 1024 + n;
    ldsrc = 1024; dst = (u16*)(ws + W_OUT); lddst = 1024;
  } else if (id == 7) {
    const int m = n >> 8, nn = n & 255;
    src = p.cw1 + (size_t)(l * 2 + m) * 2048 * 256 + nn;
    ldsrc = 256; dst = (u16*)(ws + W_C1); lddst = 2048;
  } else {
    src = p.cw2 + (size_t)(l * 2 + (n >> 6)) * 256 * 64 + (n & 63);
    ldsrc = 64; dst = (u16*)(ws + W_C2); lddst = 256;
  }
  (void)tn; (void)tk; (void)n;
  {
    const int kr = tid >> 4, nq = tid & 15;
    const int n4 = n0 + nq * 4;
    const float* s4 = nullptr; bool z4 = false;
    if (id == 0 || id == 2) {
      const int f = id >> 1;
      const int pp = n4 >> 5, s = (n4 >> 4) & 1, i = n4 & 15;
      s4 = (s ? p.wu : p.wg) + (size_t)(l * 2 + f) * 1024 * DFF + (pp * 16 + i);
    } else if (id == 1 || id == 3) {
      s4 = p.wd + (size_t)(l * 2 + (id >> 1)) * DFF * 1024 + n4;
    } else if (id == 4) {
      int col = n4;
      if (n4 >= 4888 && n4 < 5120) { z4 = true; col = 0; }
      else if (n4 >= 5120) col = n4 - 232;
      s4 = p.win + (size_t)l * 1024 * 7960 + col;
    } else if (id == 5) {
      s4 = p.wbr + (size_t)l * 1536 * 1024 + n4;
    } else if (id == 6) {
      s4 = p.wout + (size_t)l * 1024 * 1024 + n4;
    } else if (id == 7) {
      s4 = p.cw1 + (size_t)(l * 2 + (n4 >> 8)) * 2048 * 256 + (n4 & 255);
    } else {
      s4 = p.cw2 + (size_t)(l * 2 + (n4 >> 6)) * 256 * 64 + (n4 & 63);
    }
    float4 v[4];
#pragma unroll
    for (int it = 0; it < 4; ++it)
      v[it] = z4 ? make_float4(0.f, 0.f, 0.f, 0.f) : *(const float4*)(s4 + (size_t)(k0 + kr + 16 * it) * ldsrc);
#pragma unroll
    for (int it = 0; it < 4; ++it) {
      float* tr = tile + (kr + 16 * it) * 65 + nq * 4;
      tr[0] = v[it].x; tr[1] = v[it].y; tr[2] = v[it].z; tr[3] = v[it].w;
    }
  }
  __syncthreads();
  {
    const int kp = tid & 31, nr = tid >> 5;
#pragma unroll
    for (int it = 0; it < 8; ++it) {
      const int nn = nr + 8 * it;
      const u32 w = pack2bf(tile[(2 * kp) * 65 + nn], tile[(2 * kp + 1) * 65 + nn]);
      *(u32*)(dst + (size_t)(n0 + nn) * lddst + k0 + 2 * kp) = w;
    }
  }
  __syncthreads();
}

__device__ __forceinline__ void phase_convert(const Params& p, int l, float* tile) {
  const int vb0_ = BIDX;
  for (int k = 0; k < (CONV_ITEMS + VGRID - 1) / VGRID; ++k) {
    int it = vb0_ + k * VGRID;
    if (it > CONV_ITEMS - 1) it = CONV_ITEMS - 1;
    convert_tile(p, l, it, tile);
  }
}

__device__ __forceinline__ void phase_norm(const Params& p, int mode, const u16* D, const float* gD, float scale,
                           const float* gH, bool writeH) {
  const int lane = TIDX & 63, wave = TIDX >> 6;
  u16* H = (u16*)(p.ws + OFF_H);
  const float* xsrc = (mode == 0 ? p.x_in : p.x);
  for (int it = BIDX; it < T_TOK / 8; it += VGRID) {
    const int row0 = it * 8 + wave * 2;
    float4 xv[2][4], dv[2][4], g1[4], g2[4];
#pragma unroll
    for (int r = 0; r < 2; ++r)
#pragma unroll
      for (int i = 0; i < 4; ++i) {
        xv[r][i] = *(const float4*)(xsrc + (size_t)(row0 + r) * DM + i * 256 + lane * 4);
        if (mode == 1) {
          const uint2 w = *(const uint2*)(D + (size_t)(row0 + r) * DM + i * 256 + lane * 4);
          dv[r][i] = make_float4(__uint_as_float(w.x << 16), __uint_as_float(w.x & 0xffff0000u),
                                 __uint_as_float(w.y << 16), __uint_as_float(w.y & 0xffff0000u));
        } else {
          dv[r][i] = make_float4(0.f, 0.f, 0.f, 0.f);
        }
      }
#pragma unroll
    for (int i = 0; i < 4; ++i) {
      g1[i] = (mode == 1) ? *(const float4*)(gD + i * 256 + lane * 4) : make_float4(0.f, 0.f, 0.f, 0.f);
      g2[i] = writeH ? *(const float4*)(gH + i * 256 + lane * 4) : make_float4(0.f, 0.f, 0.f, 0.f);
    }
    __builtin_amdgcn_sched_barrier(0);
    if (mode == 1) {
      float ss0 = 0.f, ss1 = 0.f;
#pragma unroll
      for (int i = 0; i < 4; ++i) {
        ss0 += dv[0][i].x * dv[0][i].x + dv[0][i].y * dv[0][i].y + dv[0][i].z * dv[0][i].z + dv[0][i].w * dv[0][i].w;
        ss1 += dv[1][i].x * dv[1][i].x + dv[1][i].y * dv[1][i].y + dv[1][i].z * dv[1][i].z + dv[1][i].w * dv[1][i].w;
      }
#pragma unroll
      for (int o = 32; o; o >>= 1) { ss0 += __shfl_xor(ss0, o); ss1 += __shfl_xor(ss1, o); }
      const float r0 = rsqrtf(ss0 * (1.0f / DM) + EPSN) * scale;
      const float r1 = rsqrtf(ss1 * (1.0f / DM) + EPSN) * scale;
#pragma unroll
      for (int i = 0; i < 4; ++i) {
        xv[0][i].x += dv[0][i].x * r0 * g1[i].x; xv[0][i].y += dv[0][i].y * r0 * g1[i].y;
        xv[0][i].z += dv[0][i].z * r0 * g1[i].z; xv[0][i].w += dv[0][i].w * r0 * g1[i].w;
        xv[1][i].x += dv[1][i].x * r1 * g1[i].x; xv[1][i].y += dv[1][i].y * r1 * g1[i].y;
        xv[1][i].z += dv[1][i].z * r1 * g1[i].z; xv[1][i].w += dv[1][i].w * r1 * g1[i].w;
      }
    }
#pragma unroll
    for (int r = 0; r < 2; ++r)
#pragma unroll
      for (int i = 0; i < 4; ++i) *(float4*)(p.x + (size_t)(row0 + r) * DM + i * 256 + lane * 4) = xv[r][i];
    if (writeH) {
      float ss0 = 0.f, ss1 = 0.f;
#pragma unroll
      for (int i = 0; i < 4; ++i) {
        ss0 += xv[0][i].x * xv[0][i].x + xv[0][i].y * xv[0][i].y + xv[0][i].z * xv[0][i].z + xv[0][i].w * xv[0][i].w;
        ss1 += xv[1][i].x * xv[1][i].x + xv[1][i].y * xv[1][i].y + xv[1][i].z * xv[1][i].z + xv[1][i].w * xv[1][i].w;
      }
#pragma unroll
      for (int o = 32; o; o >>= 1) { ss0 += __shfl_xor(ss0, o); ss1 += __shfl_xor(ss1, o); }
      const float rr[2] = {rsqrtf(ss0 * (1.0f / DM) + EPSN), rsqrtf(ss1 * (1.0f / DM) + EPSN)};
#pragma unroll
      for (int r = 0; r < 2; ++r)
#pragma unroll
        for (int i = 0; i < 4; ++i) {
          uint2 o;
          o.x = pack2bf(xv[r][i].x * rr[r] * g2[i].x, xv[r][i].y * rr[r] * g2[i].y);
          o.y = pack2bf(xv[r][i].z * rr[r] * g2[i].z, xv[r][i].w * rr[r] * g2[i].w);
          *(uint2*)(H + (size_t)(row0 + r) * DM + i * 256 + lane * 4) = o;
        }
    }
  }
}

__device__ __forceinline__ void phase_rope_table(const Params& p) {
  float2* cs = (float2*)(p.ws + OFF_ROPE);
  const size_t nth = (size_t)VGRID * 256;
  for (size_t e = (size_t)BIDX * 256 + TIDX; e < (size_t)T_TOK * 32; e += nth) {
    const int t = (int)(e >> 5), i = (int)(e & 31);
    const float inv = powf(10000.0f, -(float)i * (2.0f / 64.0f));
    const float ang = (float)p.pos[t] * inv;
    double rev = (double)ang * 0.15915494309189535;
    rev -= floor(rev);
    const float fr = (float)rev;
    cs[e] = make_float2(__builtin_amdgcn_cosf(fr), __builtin_amdgcn_sinf(fr));
  }
}

#define G8REGS_DECL uint4 R_a0, R_a1, R_a2, R_a3, R_b0, R_b1, R_b2, R_b3
#define G8REGS_PARAMS uint4& ra0, uint4& ra1, uint4& ra2, uint4& ra3, uint4& rb0, uint4& rb1, uint4& rb2, uint4& rb3
#define G8REGS_ARGS R_a0, R_a1, R_a2, R_a3, R_b0, R_b1, R_b2, R_b3
template <int MI, int NJ>
__device__ __forceinline__ void gemm8(f32x4 (&acc)[MI][NJ], G8REGS_PARAMS, bool pre, const u16* __restrict__ A, int lda,
                                      const u16* __restrict__ Bt, int ldb, int kbeg, int kend,
                                      int row0, int col0, int nrow0, int ncol0, int nkbeg, u16* smem, int tid) {
  const int lane = tid & 63, wave = tid >> 6;
  const int wm = wave >> 2, wn = wave & 3;
  constexpr int AROWS = 32 * MI;
  constexpr int BROWS = 64 * NJ;
  u16* sA = smem;
  u16* sB = smem + 2 * AROWS * 64;
  const int lrow = tid >> 3, lkc = tid & 7;
  const u16* Ag = A + (size_t)(row0 + lrow) * lda + kbeg + lkc * 8;
  const u16* Bg = Bt + (size_t)(col0 + lrow) * ldb + kbeg + lkc * 8;
  const size_t a64 = (size_t)64 * lda, b64 = (size_t)64 * ldb;
  const int nk = (kend - kbeg) >> 6;
  const long long nAoff = (long long)(nrow0 - row0) * lda + (nkbeg - kbeg);
  const long long nBoff = (long long)(ncol0 - col0) * ldb + (nkbeg - kbeg);
  u16* wa = sA + lrow * 64 + ((lkc ^ (lrow & 7)) * 8);
  u16* wb = sB + lrow * 64 + ((lkc ^ (lrow & 7)) * 8);
#define G8LOADP(ga_, gb_) do { \
    ra0 = *(const uint4*)(ga_); ra1 = *(const uint4*)((ga_) + a64); \
    if (MI == 8) { ra2 = *(const uint4*)((ga_) + 2 * a64); ra3 = *(const uint4*)((ga_) + 3 * a64); } \
    rb0 = *(const uint4*)(gb_); if (NJ >= 2) rb1 = *(const uint4*)((gb_) + b64); \
    if (NJ == 4) { rb2 = *(const uint4*)((gb_) + 2 * b64); rb3 = *(const uint4*)((gb_) + 3 * b64); } } while (0)
#define G8STORE(buf_) do { u16* wa_ = wa + (buf_) * AROWS * 64; u16* wb_ = wb + (buf_) * BROWS * 64; \
    *(uint4*)(wa_) = ra0; *(uint4*)(wa_ + 64 * 64) = ra1; \
    if (MI == 8) { *(uint4*)(wa_ + 128 * 64) = ra2; *(uint4*)(wa_ + 192 * 64) = ra3; } \
    *(uint4*)(wb_) = rb0; if (NJ >= 2) *(uint4*)(wb_ + 64 * 64) = rb1; \
    if (NJ == 4) { *(uint4*)(wb_ + 128 * 64) = rb2; *(uint4*)(wb_ + 192 * 64) = rb3; } } while (0)
  if (!pre) G8LOADP(Ag, Bg);
  G8STORE(0);
  {
    const u16* ga_ = (1 < nk) ? Ag + 64 : Ag + nAoff;
    const u16* gb_ = (1 < nk) ? Bg + 64 : Bg + nBoff;
    G8LOADP(ga_, gb_);
  }
  __syncthreads();
  const int sw0 = ((lane >> 4) ^ (lane & 7)) * 8;
  const int dsw = (sw0 ^ 32) - sw0;
  const u16* ra_ = sA + (wm * (16 * MI) + (lane & 15)) * 64 + sw0;
  const u16* rb_ = sB + (wn * (16 * NJ) + (lane & 15)) * 64 + sw0;
  for (int kt = 0; kt < nk; ++kt) {
    const int buf = kt & 1;
    {
      G8STORE(buf ^ 1);
      const u16* ga_ = (kt + 2 < nk) ? Ag + (kt + 2) * 64 : Ag + nAoff;
      const u16* gb_ = (kt + 2 < nk) ? Bg + (kt + 2) * 64 : Bg + nBoff;
      G8LOADP(ga_, gb_);
    }
    __builtin_amdgcn_sched_barrier(0);
    __builtin_amdgcn_s_setprio(1);
    const u16* a = ra_ + buf * AROWS * 64;
    const u16* b = rb_ + buf * BROWS * 64;
#pragma unroll
    for (int ks = 0; ks < 2; ++ks) {
      const u16* a_ = ks ? a + dsw : a;
      const u16* b_ = ks ? b + dsw : b;
      bf16x8 bfr[NJ];
#pragma unroll
      for (int j = 0; j < NJ; ++j) bfr[j] = *(const bf16x8*)(b_ + j * 16 * 64);
      {
        bf16x8 af[MI];
#pragma unroll
        for (int i = 0; i < MI; ++i) af[i] = *(const bf16x8*)(a_ + i * 16 * 64);
#pragma unroll
        for (int i = 0; i < MI; ++i)
#pragma unroll
          for (int j = 0; j < NJ; ++j) acc[i][j] = mfma16(af[i], bfr[j], acc[i][j]);
      }
    }
    __builtin_amdgcn_s_setprio(0);
    __builtin_amdgcn_sched_barrier(0);
    __syncthreads();
  }
#undef G8LOADP
#undef G8STORE
}

#define ZERO_ACC8(acc, NJ_)                             \
  _Pragma("unroll") for (int i_ = 0; i_ < 8; ++i_)      \
  _Pragma("unroll") for (int j_ = 0; j_ < (NJ_); ++j_) { acc[i_][j_] = (f32x4){0.f, 0.f, 0.f, 0.f}; }

__device__ __forceinline__ int real_vb(volatile LAS unsigned* vb_) {
  int b = __builtin_amdgcn_readfirstlane((int)vb_[2]);
  asm volatile("" : "+s"(b));
  return b;
}

__device__ __forceinline__ void phase_ffn_up(const Params& p, const u16* Wgu, u16* smem, volatile LAS unsigned* vb_) {
  const u16* H = (const u16*)(p.ws + OFF_H);
  u16* act = (u16*)(p.ws + OFF_ACT);
  const int tid = RTID;
  const int lane = tid & 63, wave = tid >> 6;
  const int wm = wave >> 2, wn = wave & 3;
  const int vb = real_vb(vb_);
  const int step = gridDim.x >> 3;
  G8REGS_DECL;
  bool pre = false;
  for (int lt = vb >> 3; lt < 8 * 20; lt += step) {
    const int nt = lt >> 3, mt = (vb & 7) * 8 + (lt & 7);
    const bool last_full = (lt + step >= 8 * 20);
    const int ltn = last_full ? (vb >> 3) : lt + step;
    const int nrow = ((vb & 7) * 8 + (ltn & 7)) * 256;
    const int ncol = last_full ? 5120 + (ltn >> 3) * 128 : (ltn >> 3) * 256;
    f32x4 acc[8][4];
    ZERO_ACC8(acc, 4);
    gemm8<8, 4>(acc, G8REGS_ARGS, pre, H, 1024, Wgu, 1024, 0, 1024, mt * 256, nt * 256, nrow, ncol, 0, smem, tid);
    pre = true;
#pragma unroll
    for (int i = 0; i < 8; ++i)
#pragma unroll
      for (int jp = 0; jp < 2; ++jp) {
#pragma unroll
        for (int r = 0; r < 4; ++r) {
          const float g = acc[i][2 * jp][r], u = acc[i][2 * jp + 1][r];
          smem[(wm * 128 + i * 16 + (lane >> 4) * 4 + r) * 136 + (wn * 2 + jp) * 16 + (lane & 15)] = f2bf(siluf_(g) * u);
        }
        __builtin_amdgcn_sched_barrier(0);
      }
    __syncthreads();
#pragma unroll
    for (int k = 0; k < 8; ++k) {
      const int c = tid + 512 * k;
      const int row = c >> 4, ch = c & 15;
      const uint4 v = *(const uint4*)(smem + row * 136 + ch * 8);
      *(uint4*)(act + (size_t)(mt * 256 + row) * DFF + nt * 128 + ch * 8) = v;
    }
    __syncthreads();
  }
  for (int lt = vb >> 3; lt < 8 * 4; lt += step) {
    const int hn = lt >> 3, mt = (vb & 7) * 8 + (lt & 7);
    f32x4 acc[8][2];
    ZERO_ACC8(acc, 2);
    gemm8<8, 2>(acc, G8REGS_ARGS, pre && (gridDim.x == 256), H, 1024, Wgu, 1024, 0, 1024, mt * 256, 5120 + hn * 128, mt * 256, 5120 + hn * 128, 0, smem, tid);
    const int col = (160 + hn * 4 + wn) * 16 + (lane & 15);
#pragma unroll
    for (int i = 0; i < 8; ++i)
#pragma unroll
      for (int r = 0; r < 4; ++r) {
        const int row = mt * 256 + wm * 128 + i * 16 + (lane >> 4) * 4 + r;
        const float g = acc[i][0][r], u = acc[i][1][r];
        act[(size_t)row * DFF + col] = f2bf(siluf_(g) * u);
      }
  }
}

__device__ __forceinline__ void phase_gemm_f32(const u16* A, const u16* Bt, int K, u16* out, u16* smem,
                                               volatile LAS unsigned* vb_) {
  const int tid = RTID;
  const int lane = tid & 63, wave = tid >> 6;
  const int wm = wave >> 2, wn = wave & 3;
  const int vb = real_vb(vb_);
  G8REGS_DECL;
  R_b1 = R_b2 = R_b3 = make_uint4(0u, 0u, 0u, 0u);
  const int step = gridDim.x >> 3;
  bool pre = false;
  for (int lt = vb >> 3; lt < 8 * 4; lt += step) {
    const int nt = lt >> 3, mt = (vb & 7) * 8 + (lt & 7);
    const int ltn = (lt + step < 8 * 4) ? lt + step : lt;
    f32x4 acc[8][4];
    ZERO_ACC8(acc, 4);
    gemm8<8, 4>(acc, G8REGS_ARGS, pre, A, K, Bt, K, 0, K, mt * 256, nt * 256, ((vb & 7) * 8 + (ltn & 7)) * 256, (ltn >> 3) * 256, 0, smem, tid);
    pre = true;
#pragma unroll
    for (int i = 0; i < 8; ++i)
#pragma unroll
      for (int j = 0; j < 4; ++j)
#pragma unroll
        for (int r = 0; r < 4; ++r)
          smem[(wm * 128 + i * 16 + (lane >> 4) * 4 + r) * 264 + wn * 64 + j * 16 + (lane & 15)] = f2bf(acc[i][j][r]);
    __syncthreads();
    const int tid2 = RTID;
#pragma unroll
    for (int k = 0; k < 16; ++k) {
      const int c = tid2 + 512 * k;
      const int row = c >> 5, ch = c & 31;
      const uint4 v = *(const uint4*)(smem + row * 264 + ch * 8);
      *(uint4*)(out + (size_t)(mt * 256 + row) * 1024 + nt * 256 + ch * 8) = v;
    }
    __syncthreads();
  }
}

__device__ __forceinline__ void phase_win(const Params& p, int part, u16* smem, volatile LAS unsigned* vb_) {
  const u16* H = (const u16*)(p.ws + OFF_H);
  const u16* W = (const u16*)(p.ws + W_IN);
  const int tid = RTID;
  const int lane = tid & 63, wave = tid >> 6;
  const int wm = wave >> 2, wn = wave & 3;
  const int NT = part ? 20 : 12;
  const int vb = real_vb(vb_);
  G8REGS_DECL;
  R_b1 = R_b2 = R_b3 = make_uint4(0u, 0u, 0u, 0u);
  const int step = gridDim.x >> 3;
  bool pre = false;
  auto ntile = [&](int nl_) { return (part == 0) ? ((nl_ < 6) ? nl_ : (14 + nl_ - 6)) : ((nl_ < 8) ? (6 + nl_) : (20 + nl_ - 8)); };
  for (int lt = vb >> 3; lt < 8 * NT; lt += step) {
    const int nl = lt >> 3, mt = (vb & 7) * 8 + (lt & 7);
    const int nt = ntile(nl);
    const int ltn = (lt + step < 8 * NT) ? lt + step : lt;
    const int nmt = (vb & 7) * 8 + (ltn & 7), nnt = ntile(ltn >> 3);
    u16* dstA; u16* dstB; int ldA, ldB;
    {
      const int ct = nt * 2;
      if (ct < 12) { dstA = (u16*)(p.ws + OFF_UCONV) + ct * 128; ldA = 1536; }
      else if (ct < 28) { dstA = (u16*)(p.ws + OFF_UHG) + (ct - 12) * 128; ldA = 2048; }
      else if (ct < 40) { dstA = (u16*)(p.ws + OFF_UNSA) + (ct - 28) * 128; ldA = 1536; }
      else { dstA = (u16*)(p.ws + OFF_UMG) + (ct - 40) * 128; ldA = 3072; }
      dstB = dstA + 128; ldB = ldA;
    }
    f32x4 acc[8][4];
    ZERO_ACC8(acc, 4);
    gemm8<8, 4>(acc, G8REGS_ARGS, pre, H, 1024, W, 1024, 0, 1024, mt * 256, nt * 256, nmt * 256, nnt * 256, 0, smem, tid);
    pre = true;
#pragma unroll
    for (int i = 0; i < 8; ++i)
#pragma unroll
      for (int j = 0; j < 4; ++j)
#pragma unroll
        for (int r = 0; r < 4; ++r)
          smem[(wm * 128 + i * 16 + (lane >> 4) * 4 + r) * 264 + wn * 64 + j * 16 + (lane & 15)] = f2bf(acc[i][j][r]);
    __syncthreads();
    const int tid2 = RTID;
#pragma unroll
    for (int k = 0; k < 16; ++k) {
      const int c = tid2 + 512 * k;
      const int row = c >> 5, ch = c & 31;
      const uint4 v = *(const uint4*)(smem + row * 264 + ch * 8);
      u16* d_ = (ch < 16) ? dstA : dstB;
      const int l_ = (ch < 16) ? ldA : ldB;
      *(uint4*)(d_ + (size_t)(mt * 256 + row) * l_ + (ch & 15) * 8) = v;
    }
    __syncthreads();
  }
}

__device__ __forceinline__ void phase_cmp1(const Params& p, u16* smem, volatile LAS unsigned* vb_) {
  const int tid = RTID;
  const int lane = tid & 63, wave = tid >> 6;
  const int wm = wave >> 2, wn = wave & 3;
  const int vb = real_vb(vb_);
  for (int it = vb; it < 64; it += gridDim.x) {
    const int m = it >> 5, mt = (it >> 1) & 15, nt = it & 1;
    const u16* A = (const u16*)(p.ws + OFF_CMPA) + (size_t)m * 2048 * 2048;
    const u16* Bt = (const u16*)(p.ws + W_C1) + (size_t)m * 256 * 2048;
    u16* Hc = (u16*)(p.ws + OFF_HC) + (size_t)m * 2048 * 256;
    f32x4 acc[4][2];
#pragma unroll
    for (int i = 0; i < 4; ++i)
#pragma unroll
      for (int j = 0; j < 2; ++j) acc[i][j] = (f32x4){0.f, 0.f, 0.f, 0.f};
    {
      G8REGS_DECL;
      R_a2 = R_a3 = R_b2 = R_b3 = make_uint4(0u, 0u, 0u, 0u);
      gemm8<4, 2>(acc, G8REGS_ARGS, false, A, 2048, Bt, 2048, 0, 2048, mt * 128, nt * 128, mt * 128, nt * 128, 0, smem, tid);
    }
#pragma unroll
    for (int i = 0; i < 4; ++i)
#pragma unroll
      for (int j = 0; j < 2; ++j) {
        const int col = nt * 128 + wn * 32 + j * 16 + (lane & 15);
#pragma unroll
        for (int r = 0; r < 4; ++r) {
          const int row = mt * 128 + wm * 64 + i * 16 + (lane >> 4) * 4 + r;
          const float x = acc[i][j][r];
          const float u = 0.7978845608028654f * (x + 0.044715f * x * x * x);
          Hc[(size_t)row * 256 + col] = f2bf(x * sigmoidf_(2.0f * u));
        }
      }
  }
}

__device__ __forceinline__ void phase_cmp2(const Params& p, int l, u16* smem) {
  (void)l;
  u16* kcmp = (u16*)(p.ws + OFF_KCMP);
  u16* vcmpT = (u16*)(p.ws + OFF_VCMP);
  const int tid = TIDX;
  const int lane = tid & 63, wave = tid >> 6;
  const int wm = wave >> 1, wn = wave & 1;
  for (int it = BIDX; it < 32; it += VGRID) {
    const int m = it >> 4, mt = it & 15;
    const u16* A = (const u16*)(p.ws + OFF_HC) + (size_t)m * 2048 * 256;
    const u16* Bt = (const u16*)(p.ws + W_C2) + (size_t)m * 64 * 256;
    f32x4 acc[4][2];
#pragma unroll
    for (int i = 0; i < 4; ++i)
#pragma unroll
      for (int j = 0; j < 2; ++j) acc[i][j] = (f32x4){0.f, 0.f, 0.f, 0.f};
    gemm_acc<2>(acc, A, 256, Bt, 256, 0, 256, mt * 128, 0, smem);
#pragma unroll
    for (int i = 0; i < 4; ++i)
#pragma unroll
      for (int j = 0; j < 2; ++j) {
        const int d = wn * 32 + j * 16 + (lane & 15);
#pragma unroll
        for (int r = 0; r < 4; ++r) {
          const int row = mt * 128 + wm * 64 + i * 16 + (lane >> 4) * 4 + r;
          if (row < 2044) {
            const int b = row / 1022, r2 = row % 1022;
            const int n = r2 >> 1, kh = r2 & 1;
            if (m == 0) kcmp[((size_t)(b * 2 + kh) * 8 + (n >> 6)) * 4096 + kfrag_off(n & 63, d)] = f2bf(acc[i][j][r]);
            else vcmpT[((size_t)(b * 2 + kh) * 8 + (n >> 6)) * 4096 + vfrag_off(d, n & 63)] = f2bf(acc[i][j][r]);
          } else {
            const int bk = row - 2044;
            if (m == 0) kcmp[((size_t)bk * 8 + 7) * 4096 + kfrag_off(63, d)] = 0;
            else vcmpT[((size_t)bk * 8 + 7) * 4096 + vfrag_off(d, 63)] = 0;
          }
        }
      }
  }
}

__device__ __forceinline__ void phase_merge(const Params& p, u16* smem, volatile LAS unsigned* vb_) {
  const u16* Y = (const u16*)(p.ws + OFF_Y);
  const u16* W = (const u16*)(p.ws + W_BR);
  const u16* MG = (const u16*)(p.ws + OFF_UMG);
  u16* outp = (u16*)(p.ws + OFF_H);
  const int tid = RTID;
  const int lane = tid & 63, wave = tid >> 6;
  const int wm = wave >> 2, wn = wave & 3;
  const int vb = real_vb(vb_);
  const int step = gridDim.x >> 3;
  G8REGS_DECL;
  R_a2 = R_a3 = make_uint4(0u, 0u, 0u, 0u);
  bool pre = false;
  for (int lt = vb >> 3; lt < 16 * 4; lt += step) {
    const int nt = lt >> 4, mt = (vb & 7) * 16 + (lt & 15);
    const int ltn = (lt + step < 16 * 4) ? lt + step : lt;
    const int nmt = (vb & 7) * 16 + (ltn & 15), nnt = ltn >> 4;
    f32x4 tot[4][4];
    ZERO_ACC(tot);
    for (int n = 0; n < 3; ++n) {
      f32x4 acc[4][4];
      ZERO_ACC(acc);
      gemm8<4, 4>(acc, G8REGS_ARGS, pre, Y, 1536, W, 1536, n * 512, n * 512 + 512, mt * 128, nt * 256,
                  (n < 2) ? mt * 128 : nmt * 128, (n < 2) ? nt * 256 : nnt * 256, (n < 2) ? (n + 1) * 512 : 0, smem, tid);
      pre = true;
      const int tid2 = RTID;
#pragma unroll
      for (int k = 0; k < 8; ++k) {
        const int c = tid2 + 512 * k;
        const int row = c >> 5, ch = c & 31;
        *(uint4*)(smem + row * 264 + ch * 8) = *(const uint4*)(MG + (size_t)(mt * 128 + row) * 3072 + n * 1024 + nt * 256 + ch * 8);
      }
      __syncthreads();
#pragma unroll
      for (int i = 0; i < 4; ++i)
#pragma unroll
        for (int j = 0; j < 4; ++j)
#pragma unroll
          for (int r = 0; r < 4; ++r) {
            const float g = sigmoidf_(bf2f(smem[(wm * 64 + i * 16 + (lane >> 4) * 4 + r) * 264 + wn * 64 + j * 16 + (lane & 15)]));
            tot[i][j][r] += g * acc[i][j][r];
            if (r == 3) __builtin_amdgcn_sched_barrier(0);
          }
      __syncthreads();
    }
#pragma unroll
    for (int i = 0; i < 4; ++i)
#pragma unroll
      for (int j = 0; j < 4; ++j)
#pragma unroll
        for (int r = 0; r < 4; ++r)
          smem[(wm * 64 + i * 16 + (lane >> 4) * 4 + r) * 264 + wn * 64 + j * 16 + (lane & 15)] = f2bf(tot[i][j][r]);
    __syncthreads();
    const int tid3 = RTID;
#pragma unroll
    for (int k = 0; k < 8; ++k) {
      const int c = tid3 + 512 * k;
      const int row = c >> 5, ch = c & 31;
      *(uint4*)(outp + (size_t)(mt * 128 + row) * 1024 + nt * 256 + ch * 8) = *(const uint4*)(smem + row * 264 + ch * 8);
    }
    __syncthreads();
  }
}

__device__ __forceinline__ void unpack8(const uint4& v, float (&f)[8]) {
  f[0] = __uint_as_float(v.x << 16); f[1] = __uint_as_float(v.x & 0xffff0000u);
  f[2] = __uint_as_float(v.y << 16); f[3] = __uint_as_float(v.y & 0xffff0000u);
  f[4] = __uint_as_float(v.z << 16); f[5] = __uint_as_float(v.z & 0xffff0000u);
  f[6] = __uint_as_float(v.w << 16); f[7] = __uint_as_float(v.w & 0xffff0000u);
}
__device__ __forceinline__ uint4 pack8(const float (&f)[8]) {
  return make_uint4(pack2bf(f[0], f[1]), pack2bf(f[2], f[3]), pack2bf(f[4], f[5]), pack2bf(f[6], f[7]));
}
__device__ __forceinline__ void load8f(const float* p, float (&f)[8]) {
  const float4 a = *(const float4*)(p), b = *(const float4*)(p + 4);
  f[0] = a.x; f[1] = a.y; f[2] = a.z; f[3] = a.w; f[4] = b.x; f[5] = b.y; f[6] = b.z; f[7] = b.w;
}

__device__ __forceinline__ void phase_prep(const Params& p, int l) {
  const u16* Uc = (const u16*)(p.ws + OFF_UCONV);
  const u16* Un = (const u16*)(p.ws + OFF_UNSA);
  u16* Y = (u16*)(p.ws + OFF_Y);
  u16* qr = (u16*)(p.ws + OFF_QR);
  u16* KR = (u16*)(p.ws + OFF_KR);
  u16* VT = (u16*)(p.ws + OFF_VT);
  u16* CA = (u16*)(p.ws + OFF_CMPA);
  float* gates = (float*)(p.ws + OFF_GATES);
  const float* cs = (const float*)(p.ws + OFF_ROPE);
  const int tid = TIDX;
  const size_t nth = (size_t)VGRID * 256;
  const size_t gt = (size_t)BIDX * 256 + tid;
  for (size_t e = gt; e < (size_t)T_TOK * 64; e += nth) {
    const int t = (int)(e >> 6), c0 = (int)(e & 63) * 8;
    const int s = t & (SEQL - 1);
    float w0[8], w1[8], w2[8], bb[8], cv[8], xv[8], acc[8];
    load8f(p.convw + (l * 3 + 0) * 512 + c0, w0);
    load8f(p.convw + (l * 3 + 1) * 512 + c0, w1);
    load8f(p.convw + (l * 3 + 2) * 512 + c0, w2);
    const u16* r2 = Uc + (size_t)t * 1536 + c0;
    unpack8(*(const uint4*)(r2), bb);
    unpack8(*(const uint4*)(r2 + 512), cv);
    unpack8(*(const uint4*)(r2 + 1024), xv);
#pragma unroll
    for (int j = 0; j < 8; ++j) acc[j] = w2[j] * (cv[j] * xv[j]);
    if (s >= 1) {
      unpack8(*(const uint4*)(r2 - 1536 + 512), cv);
      unpack8(*(const uint4*)(r2 - 1536 + 1024), xv);
#pragma unroll
      for (int j = 0; j < 8; ++j) acc[j] += w1[j] * (cv[j] * xv[j]);
    }
    if (s >= 2) {
      unpack8(*(const uint4*)(r2 - 3072 + 512), cv);
      unpack8(*(const uint4*)(r2 - 3072 + 1024), xv);
#pragma unroll
      for (int j = 0; j < 8; ++j) acc[j] += w0[j] * (cv[j] * xv[j]);
    }
#pragma unroll
    for (int j = 0; j < 8; ++j) acc[j] *= bb[j];
    *(uint4*)(Y + (size_t)t * 1536 + c0) = pack8(acc);
  }
  for (size_t e = gt; e < (size_t)2 * 4 * 2048; e += nth) {
    const int m = (int)(e >> 13), rem = (int)(e & 8191);
    CA[((size_t)m * 2048 + 2044) * 2048 + rem] = 0;
  }
  const float* pek = p.pe + (size_t)(l * 2 + 0) * 2048;
  const float* pev = p.pe + (size_t)(l * 2 + 1) * 2048;
  for (int it = BIDX; it < 1024; it += VGRID) {
    const int b = it >> 9, ch = it & 511;
    const int s0 = ch * 16, t0 = b * SEQL + s0;
    for (int idx = tid; idx < 512 + 384; idx += 256) {
      int i, col, d0, m = -1, kh = 0;
      if (idx < 512) { i = idx >> 5; const int rem = idx & 31; col = (rem >> 2) * 64; d0 = (rem & 3) * 8; }
      else { const int k2 = idx - 512; i = k2 / 24; const int rem = k2 % 24; m = rem >> 3; kh = (rem >> 2) & 1; d0 = (rem & 3) * 8; col = 512 + m * 256 + kh * 64; }
      const int t = t0 + i;
      float x1[8], x2[8], c0[8], c1[8], o1[8], o2[8];
      unpack8(*(const uint4*)(Un + (size_t)t * 1536 + col + d0), x1);
      unpack8(*(const uint4*)(Un + (size_t)t * 1536 + col + 32 + d0), x2);
      load8f(cs + ((size_t)t * 32 + d0) * 2, c0);
      load8f(cs + ((size_t)t * 32 + d0) * 2 + 8, c1);
#pragma unroll
      for (int j = 0; j < 8; ++j) {
        const float cc = (j < 4) ? c0[2 * j] : c1[2 * (j - 4)];
        const float sn = (j < 4) ? c0[2 * j + 1] : c1[2 * (j - 4) + 1];
        o1[j] = x1[j] * cc - x2[j] * sn;
        o2[j] = x2[j] * cc + x1[j] * sn;
      }
      if (m < 0) {
        *(uint4*)(qr + (size_t)t * 512 + col + d0) = pack8(o1);
        *(uint4*)(qr + (size_t)t * 512 + col + 32 + d0) = pack8(o2);
      } else {
        u16* kd = KR + (size_t)m * 2097152 + ((size_t)(b * 2 + kh) * 128 + (s0 >> 6)) * 4096;
        *(uint4*)(kd + kfrag_off((s0 & 63) + i, d0)) = pack8(o1);
        *(uint4*)(kd + kfrag_off((s0 & 63) + i, 32 + d0)) = pack8(o2);
        if (m == 0) {
          float pe1[8], pe2[8], a1[8], a2[8];
          if (ch <= 510) {
            load8f(pek + i * 64 + d0, pe1); load8f(pek + i * 64 + 32 + d0, pe2);
#pragma unroll
            for (int j = 0; j < 8; ++j) { a1[j] = o1[j] + pe1[j]; a2[j] = o2[j] + pe2[j]; }
            u16* a = CA + ((size_t)((b * 511 + ch) * 2 + kh)) * 2048 + i * 64;
            *(uint4*)(a + d0) = pack8(a1); *(uint4*)(a + 32 + d0) = pack8(a2);
          }
          if (ch >= 1) {
            load8f(pek + (16 + i) * 64 + d0, pe1); load8f(pek + (16 + i) * 64 + 32 + d0, pe2);
#pragma unroll
            for (int j = 0; j < 8; ++j) { a1[j] = o1[j] + pe1[j]; a2[j] = o2[j] + pe2[j]; }
            u16* a = CA + ((size_t)((b * 511 + ch - 1) * 2 + kh)) * 2048 + (16 + i) * 64;
            *(uint4*)(a + d0) = pack8(a1); *(uint4*)(a + 32 + d0) = pack8(a2);
          }
        }
      }
    }
    {
      const int i = tid >> 4, cc0 = (tid & 15) * 8;
      const int kh = cc0 >> 6, d0 = cc0 & 63;
      float v[8], pe1[8], a1[8];
      unpack8(*(const uint4*)(Un + (size_t)(t0 + i) * 1536 + 640 + cc0), v);
      u16* CAv = CA + (size_t)2048 * 2048;
      if (ch <= 510) {
        load8f(pev + i * 64 + d0, pe1);
#pragma unroll
        for (int j = 0; j < 8; ++j) a1[j] = v[j] + pe1[j];
        *(uint4*)(CAv + ((size_t)((b * 511 + ch) * 2 + kh)) * 2048 + i * 64 + d0) = pack8(a1);
      }
      if (ch >= 1) {
        load8f(pev + (16 + i) * 64 + d0, pe1);
#pragma unroll
        for (int j = 0; j < 8; ++j) a1[j] = v[j] + pe1[j];
        *(uint4*)(CAv + ((size_t)((b * 511 + ch - 1) * 2 + kh)) * 2048 + (16 + i) * 64 + d0) = pack8(a1);
      }
    }
    if (tid < 128) {
      const int m = tid >> 6, c8 = (tid >> 2) & 15, tq4 = tid & 3;
      const int c2 = c8 * 8, kh = c2 >> 6, d0 = c2 & 63;
      uint4 w[4];
#pragma unroll
      for (int j = 0; j < 4; ++j) w[j] = *(const uint4*)(Un + (size_t)(t0 + tq4 * 4 + j) * 1536 + 896 + m * 256 + c2);
      u16* vd = VT + (size_t)m * 2097152 + ((size_t)(b * 2 + kh) * 128 + (s0 >> 6)) * 4096;
      const int key0 = (s0 & 63) + tq4 * 4;
#pragma unroll
      for (int e = 0; e < 8; ++e) {
        u32 h[4];
#pragma unroll
        for (int j = 0; j < 4; ++j) {
          const u32 word = (e < 2) ? w[j].x : (e < 4) ? w[j].y : (e < 6) ? w[j].z : w[j].w;
          h[j] = (e & 1) ? (word >> 16) : (word & 0xffffu);
        }
        uint2 o;
        o.x = h[0] | (h[1] << 16);
        o.y = h[2] | (h[3] << 16);
        *(uint2*)(vd + vfrag_off(d0 + e, key0)) = o;
      }
    }
    for (int idx = tid; idx < 384; idx += 256) {
      const int i = idx / 24, gI = idx % 24;
      gates[(size_t)(t0 + i) * 24 + gI] = sigmoidf_(bf2f(Un[(size_t)(t0 + i) * 1536 + 1280 + gI]));
    }
  }
}

typedef unsigned long long u64;

__device__ __forceinline__ int kfrag_off(int key, int d) {
  return (((key >> 4) * 2 + (d >> 5)) * 64 + ((d >> 3) & 3) * 16 + (key & 15)) * 8 + (d & 7);
}
__device__ __forceinline__ int vfrag_off(int d, int key) {
  return (((d >> 4) * 2 + (key >> 5)) * 64 + ((key >> 2) & 3) * 16 + (d & 15)) * 8 + ((key >> 4) & 1) * 4 + (key & 3);
}
__device__ __forceinline__ void k_load64(bf16x8 (&kq)[8], const u16* __restrict__ Kp, int lane) {
  const u16* kr = Kp + lane * 8;
#pragma unroll
  for (int i = 0; i < 8; ++i) kq[i] = *(const bf16x8*)(kr + i * 512);
}
__device__ __forceinline__ void v_load64(bf16x8 (&vq)[8], const u16* __restrict__ Vp, int lane) {
  const u16* vr = Vp + lane * 8;
#pragma unroll
  for (int i = 0; i < 8; ++i) vq[i] = *(const bf16x8*)(vr + i * 512);
}
template <class MaskF>
__device__ __forceinline__ void qk64(const bf16x8 (&kq)[8], const bf16x8 (&qf)[2], float scale, MaskF maskf, int lane,
                                     f32x4 (&st)[4]) {
  const int q = lane >> 4;
#pragma unroll
  for (int kt = 0; kt < 4; ++kt) {
    f32x4 z = {0.f, 0.f, 0.f, 0.f};
    z = mfma16(kq[2 * kt], qf[0], z);
    z = mfma16(kq[2 * kt + 1], qf[1], z);
#pragma unroll
    for (int r = 0; r < 4; ++r) st[kt][r] = maskf(kt * 16 + q * 4 + r) ? z[r] * scale : -INFINITY;
  }
}
__device__ __forceinline__ void qk64_lim(const bf16x8 (&kq)[8], const bf16x8 (&qf)[2], float scale, int lim2,
                                         f32x4 (&st)[4]) {
#pragma unroll
  for (int kt = 0; kt < 4; ++kt) {
    f32x4 z = {0.f, 0.f, 0.f, 0.f};
    z = mfma16(kq[2 * kt], qf[0], z);
    z = mfma16(kq[2 * kt + 1], qf[1], z);
#pragma unroll
    for (int r = 0; r < 4; ++r) st[kt][r] = ((kt * 16 + r) <= lim2) ? z[r] * scale : -INFINITY;
  }
}
__device__ __forceinline__ void pv64(const bf16x8 (&vq)[8], const f32x4 (&pr)[4], f32x4 (&o)[4]) {
#pragma unroll
  for (int hf = 0; hf < 2; ++hf) {
    uint4 pw;
    pw.x = pack2bf(pr[2 * hf][0], pr[2 * hf][1]); pw.y = pack2bf(pr[2 * hf][2], pr[2 * hf][3]);
    pw.z = pack2bf(pr[2 * hf + 1][0], pr[2 * hf + 1][1]); pw.w = pack2bf(pr[2 * hf + 1][2], pr[2 * hf + 1][3]);
    const bf16x8 pb = __builtin_bit_cast(bf16x8, pw);
#pragma unroll
    for (int dt = 0; dt < 4; ++dt) o[dt] = mfma16(vq[dt * 2 + hf], pb, o[dt]);
  }
}
#define EXP2F(x) __builtin_amdgcn_exp2f(x)
__device__ __forceinline__ void softmax_update(f32x4 (&st)[4], float& m, float& lsum, f32x4 (&o)[4]) {
  float mx = -1e30f;
#pragma unroll
  for (int kt = 0; kt < 4; ++kt)
#pragma unroll
    for (int r = 0; r < 4; ++r) mx = fmaxf(mx, st[kt][r]);
  mx = fmaxf(mx, __shfl_xor(mx, 16));
  mx = fmaxf(mx, __shfl_xor(mx, 32));
  float mnew = fmaxf(m, mx);
  if (__builtin_amdgcn_ballot_w64(mnew - m > 6.0f)) {
    const float alpha = EXP2F(m - mnew);
    lsum *= alpha;
    m = mnew;
#pragma unroll
    for (int dt = 0; dt < 4; ++dt) o[dt] *= alpha;
  }
  float ps = 0.f;
#pragma unroll
  for (int kt = 0; kt < 4; ++kt)
#pragma unroll
    for (int r = 0; r < 4; ++r) {
      const float pv = EXP2F(st[kt][r] - m);
      st[kt][r] = pv;
      ps += pv;
    }
  lsum += ps;
}

#define SB0 __builtin_amdgcn_sched_barrier(0)

__device__ __forceinline__ void phase_nsa_attn(const Params& p, char* smem, volatile LAS unsigned* vb_) {
  const u16* qr = (const u16*)(p.ws + OFF_QR);
  const u16* kcmp = (const u16*)(p.ws + OFF_KCMP);
  const u16* vcmpT = (const u16*)(p.ws + OFF_VCMP);
  const u16* KS = (const u16*)(p.ws + OFF_KR) + (size_t)1 * 2097152;
  const u16* KW = (const u16*)(p.ws + OFF_KR) + (size_t)2 * 2097152;
  const u16* VS = (const u16*)(p.ws + OFF_VT);
  const u16* VW = (const u16*)(p.ws + OFF_VT) + (size_t)2097152;
  const float* gates = (const float*)(p.ws + OFF_GATES);
  u16* Y = (u16*)(p.ws + OFF_Y);
  const int tid = TIDX;
  const int lane = tid & 63, wave = tid >> 6;
  const int c16 = lane & 15, q = lane >> 4;
  const int tq = c16 >> 2, g = c16 & 3;
  const float scale = 0.125f * 1.4426950408889634f;
  float* impl = (float*)smem + wave * 512;
  const int rvb_ = real_vb(vb_);
  int bid_ = (((rvb_ >> 3) * 2 + HALF_) << 3) | (rvb_ & 7);
  asm volatile("" : "+s"(bid_));
  const int xcd_ = bid_ & 7;
  for (int li = bid_ >> 3; li < 256; li += (VGRID >> 3)) {
    const int b = xcd_ >> 2, kh = (xcd_ >> 1) & 1, grp = li * 2 + (xcd_ & 1);
    const int s0 = (grp * 4 + wave) * 4;
    const int s = s0 + tq;
    const int t = b * SEQL + s;
    const int head = kh * 4 + g;
    bf16x8 qf[2];
    qf[0] = *(const bf16x8*)(qr + (size_t)t * 512 + head * 64 + q * 8);
    qf[1] = *(const bf16x8*)(qr + (size_t)t * 512 + head * 64 + 32 + q * 8);
    const float gt0 = gates[(size_t)t * 24 + kh * 12 + g * 3 + 0];
    const float gt1 = gates[(size_t)t * 24 + kh * 12 + g * 3 + 1];
    const float gt2 = gates[(size_t)t * 24 + kh * 12 + g * 3 + 2];
    const size_t kvb = (size_t)(b * 2 + kh);
    float* yl = (float*)smem + 2048 + wave * 1024 + lane;
    bf16x8 kA[8];
    bf16x8 vA[8];

    {
      const int nvalid = (s >= 31) ? (((s - 31) >> 4) + 1) : 0;
      const int slast = s0 + 3;
      const int nvmax = (slast >= 31) ? (((slast - 31) >> 4) + 1) : 0;
      const int ntile = (nvmax + 63) >> 6;
      const u16* Kb = kcmp + kvb * 512 * 64;
      const u16* Vb = vcmpT + kvb * 64 * 512;
      if (ntile > 0) {
        float m = -1e30f, lsum = 0.f;
        k_load64(kA, Kb, lane);
        for (int i = 0; i < ntile; ++i) {
          const int n0 = i * 64;
          const int nn = (i + 1 < ntile ? i + 1 : i) * 64;
          f32x4 st[4];
          qk64_lim(kA, qf, scale, nvalid - 1 - n0 - q * 4, st);
          SB0;
          k_load64(kA, Kb + (size_t)nn * 64, lane);
          SB0;
          float mx = -1e30f;
#pragma unroll
          for (int kt = 0; kt < 4; ++kt)
#pragma unroll
            for (int r = 0; r < 4; ++r) mx = fmaxf(mx, st[kt][r]);
          mx = fmaxf(mx, __shfl_xor(mx, 16));
          mx = fmaxf(mx, __shfl_xor(mx, 32));
          const float mnew = fmaxf(m, mx);
          float ps = 0.f;
#pragma unroll
          for (int kt = 0; kt < 4; ++kt)
#pragma unroll
            for (int r = 0; r < 4; ++r) ps += EXP2F(st[kt][r] - mnew);
          lsum = lsum * EXP2F(m - mnew) + ps;
          m = mnew;
        }
        lsum += __shfl_xor(lsum, 16);
        lsum += __shfl_xor(lsum, 32);
        const float invl = (lsum > 0.f) ? 1.0f / lsum : 0.f;
        f32x4 o[4];
#pragma unroll
        for (int dt = 0; dt < 4; ++dt) o[dt] = (f32x4){0.f, 0.f, 0.f, 0.f};
        float carry = 0.f;
      SB0;
        k_load64(kA, Kb, lane);
      SB0;
        v_load64(vA, Vb, lane);
      SB0;
        for (int i = 0; i < ntile; ++i) {
          const int n0 = i * 64;
          const int nn = (i + 1 < ntile ? i + 1 : i) * 64;
          f32x4 st[4];
          qk64_lim(kA, qf, scale, nvalid - 1 - n0 - q * 4, st);
          SB0;
          k_load64(kA, Kb + (size_t)nn * 64, lane);
          SB0;
#pragma unroll
          for (int kt = 0; kt < 4; ++kt)
#pragma unroll
            for (int r = 0; r < 4; ++r) st[kt][r] = EXP2F(st[kt][r] - m) * invl;
          pv64(vA, st, o);
          SB0;
          v_load64(vA, Vb + (size_t)nn * 64, lane);
          SB0;
          float mainv[4], ev[4], eup[4];
#pragma unroll
          for (int kt = 0; kt < 4; ++kt) {
            float acc = 0.f, last = 0.f;
#pragma unroll
            for (int r = 0; r < 4; ++r) {
              float a = st[kt][r];
              a += __shfl_xor(a, 1);
              a += __shfl_xor(a, 2);
              acc += a;
              last = a;
            }
            mainv[kt] = acc; ev[kt] = last;
          }
#pragma unroll
          for (int kt = 0; kt < 4; ++kt) eup[kt] = __shfl(ev[kt], (lane + 48) & 63);
#pragma unroll
          for (int kt = 0; kt < 4; ++kt) {
            const float pe = (q > 0) ? eup[kt] : (kt > 0 ? eup[kt > 0 ? kt - 1 : 0] : carry);
            if (g == 0) impl[tq * 128 + (n0 >> 2) + kt * 4 + q] = mainv[kt] + pe;
          }
          carry = eup[3];
        }
#pragma unroll
        for (int dt = 0; dt < 4; ++dt)
#pragma unroll
          for (int r = 0; r < 4; ++r) yl[(dt * 4 + r) * 64] = o[dt][r] * gt0;
      } else {
#pragma unroll
        for (int i = 0; i < 16; ++i) yl[i * 64] = 0.f;
      }
    }

    {
      const u16* Kw = KW + kvb * SEQL * 64;
      const u16* Vw = VW + kvb * 64 * SEQL;
      float m = -1e30f, lsum = 0.f;
      f32x4 o[4];
#pragma unroll
      for (int dt = 0; dt < 4; ++dt) o[dt] = (f32x4){0.f, 0.f, 0.f, 0.f};
      int lo = s0 - 511; if (lo < 0) lo = 0;
      lo &= ~63;
      const int ntile = ((s0 + 3 - lo) >> 6) + 1;
      SB0;
      k_load64(kA, Kw + (size_t)lo * 64, lane);
      SB0;
      v_load64(vA, Vw + (size_t)lo * 64, lane);
      SB0;
      for (int i = 0; i < ntile; ++i) {
        const int k0 = lo + i * 64;
        const int kx = lo + (i + 1 < ntile ? i + 1 : i) * 64;
        f32x4 st[4];
        qk64(kA, qf, scale, [&](int ko) { const int ks = k0 + ko; return (ks <= s) && (ks + 512 > s); }, lane, st);
        SB0;
        k_load64(kA, Kw + (size_t)kx * 64, lane);
        SB0;
        softmax_update(st, m, lsum, o);
        pv64(vA, st, o);
        SB0;
        v_load64(vA, Vw + (size_t)kx * 64, lane);
        SB0;
      }
      lsum += __shfl_xor(lsum, 16);
      lsum += __shfl_xor(lsum, 32);
      const float sc = (lsum > 0.f) ? gt2 / lsum : 0.f;
#pragma unroll
      for (int dt = 0; dt < 4; ++dt)
#pragma unroll
        for (int r = 0; r < 4; ++r) yl[(dt * 4 + r) * 64] += o[dt][r] * sc;
    }

    {
      const u16* Ks = KS + kvb * SEQL * 64;
      const u16* Vs = VS + kvb * 64 * SEQL;
      const int cur = s0 >> 6;
      const int ncand = cur - 2;
      u64 mk0[5], mk1[5];
#pragma unroll
      for (int i = 0; i < 5; ++i) { mk0[i] = 0; mk1[i] = 0; }
      if (ncand <= 13) {
        mk0[0] = (cur >= 63) ? ~0ull : ((1ull << (cur + 1)) - 1ull);
      } else {
        mk0[0] = 1ull;
        if (cur - 1 < 64) mk0[0] |= 1ull << (cur - 1); else mk1[0] |= 1ull << (cur - 1 - 64);
        if (cur < 64) mk0[0] |= 1ull << cur; else mk1[0] |= 1ull << (cur - 64);
#pragma unroll
        for (int tk = 0; tk < 4; ++tk) {
          const float* ir = impl + tk * 128;
          const u32 b0 = (lane >= 1 && lane <= ncand) ? (__float_as_uint(ir[lane]) + 1u) : 0u;
          const u32 b1 = (lane + 64 <= ncand) ? (__float_as_uint(ir[lane + 64]) + 1u) : 0u;
          u32 T = 0u;
          for (int bit = 30; bit >= 0; --bit) {
            const u32 cand = T | (1u << bit);
            const int c = __builtin_popcountll(__builtin_amdgcn_ballot_w64(b0 >= cand)) +
                          __builtin_popcountll(__builtin_amdgcn_ballot_w64(b1 >= cand));
            if (c >= 13) T = cand;
          }
          u64 g0 = __builtin_amdgcn_ballot_w64(b0 > T);
          u64 g1 = __builtin_amdgcn_ballot_w64(b1 > T);
          u64 e0 = __builtin_amdgcn_ballot_w64(b0 == T);
          u64 e1 = __builtin_amdgcn_ballot_w64(b1 == T);
          int need = 13 - __builtin_popcountll(g0) - __builtin_popcountll(g1);
          while (need > 0 && (e0 | e1)) {
            if (e0) { const u64 low = e0 & (~e0 + 1ull); g0 |= low; e0 ^= low; }
            else { const u64 low = e1 & (~e1 + 1ull); g1 |= low; e1 ^= low; }
            --need;
          }
          mk0[tk + 1] = g0; mk1[tk + 1] = g1;
        }
      }
      u64 c0 = mk0[0] | mk0[1] | mk0[2] | mk0[3] | mk0[4];
      u64 c1 = mk1[0] | mk1[1] | mk1[2] | mk1[3] | mk1[4];
      const int ntot = __builtin_popcountll(c0) + __builtin_popcountll(c1);
      const u64 my0 = mk0[0] | ((tq == 0) ? mk0[1] : (tq == 1) ? mk0[2] : (tq == 2) ? mk0[3] : mk0[4]);
      const u64 my1 = mk1[0] | ((tq == 0) ? mk1[1] : (tq == 1) ? mk1[2] : (tq == 2) ? mk1[3] : mk1[4]);
      int jn = 0;
      auto advance = [&]() {
        if (c0) { jn = __builtin_ctzll(c0); c0 &= c0 - 1ull; }
        else if (c1) { jn = 64 + __builtin_ctzll(c1); c1 &= c1 - 1ull; }
      };
      float m = -1e30f, lsum = 0.f;
      f32x4 o[4];
#pragma unroll
      for (int dt = 0; dt < 4; ++dt) o[dt] = (f32x4){0.f, 0.f, 0.f, 0.f};
      advance();
      SB0;
      k_load64(kA, Ks + (size_t)jn * 4096, lane);
      SB0;
      v_load64(vA, Vs + (size_t)jn * 4096, lane);
      SB0;
      for (int i = 0; i < ntot; ++i) {
        const int j = jn;
        if (i + 1 < ntot) advance();
        const bool mine = (((j < 64) ? (my0 >> j) : (my1 >> (j - 64))) & 1ull) != 0ull;
        const int lim2 = (mine ? ((j == cur) ? (s - j * 64) : 63) : -1) - q * 4;
        f32x4 st[4];
        qk64_lim(kA, qf, scale, lim2, st);
        SB0;
        k_load64(kA, Ks + (size_t)jn * 4096, lane);
        SB0;
        softmax_update(st, m, lsum, o);
        pv64(vA, st, o);
        SB0;
        v_load64(vA, Vs + (size_t)jn * 4096, lane);
        SB0;
      }
      lsum += __shfl_xor(lsum, 16);
      lsum += __shfl_xor(lsum, 32);
      const float sc = (lsum > 0.f) ? gt1 / lsum : 0.f;
#pragma unroll
      for (int dt = 0; dt < 4; ++dt) {
        const float y0 = yl[(dt * 4 + 0) * 64] + o[dt][0] * sc, y1 = yl[(dt * 4 + 1) * 64] + o[dt][1] * sc;
        const float y2 = yl[(dt * 4 + 2) * 64] + o[dt][2] * sc, y3 = yl[(dt * 4 + 3) * 64] + o[dt][3] * sc;
        uint2 w;
        w.x = pack2bf(y0, y1);
        w.y = pack2bf(y2, y3);
        *(uint2*)(Y + (size_t)t * 1536 + 1024 + head * 64 + dt * 16 + q * 4) = w;
      }
    }

  }
}

#define BCS 132
__device__ __forceinline__ float hg_lb(const Params& p, int l, int ch) {
  if (l == 0) return 0.f;
  const float a0 = p.lb_logits[ch], a1 = p.lb_logits[512 + ch], a2 = p.lb_logits[1024 + ch], a3 = p.lb_logits[1536 + ch];
  const float mx = fmaxf(fmaxf(a0, a1), fmaxf(a2, a3));
  const float e0 = __expf(a0 - mx), e1 = __expf(a1 - mx), e2 = __expf(a2 - mx), e3 = __expf(a3 - mx);
  const float inv = 1.0f / (e0 + e1 + e2 + e3);
  float sacc = e1;
  if (l >= 2) sacc += e2;
  if (l >= 3) sacc += e3;
  return sacc * inv;
}

__device__ __forceinline__ void hg_bcum(const Params& p, int l, const u16* Uhg, int t0, int h, float* bc, float* lbs,
                                        float* tots) {
  const int tid = TIDX;
  if (tid < 128) lbs[tid] = hg_lb(p, l, h * 128 + tid);
  __syncthreads();
#pragma unroll
  for (int k = 0; k < 4; ++k) {
    const int s = (tid >> 4) + 16 * k, d0 = (tid & 15) * 8;
    float z[8];
    unpack8(*(const uint4*)(Uhg + (size_t)(t0 + s) * 2048 + 512 + h * 128 + d0), z);
    float lf[8];
#pragma unroll
    for (int j = 0; j < 8; ++j) {
      const float lbv = lbs[d0 + j];
      const float f = lbv + (1.0f - lbv) * sigmoidf_(z[j]);
      lf[j] = __logf(fmaxf(f, 1e-30f));
    }
    *(float4*)(bc + s * BCS + d0) = make_float4(lf[0], lf[1], lf[2], lf[3]);
    *(float4*)(bc + s * BCS + d0 + 4) = make_float4(lf[4], lf[5], lf[6], lf[7]);
  }
  __syncthreads();
  {
    const int d = tid & 127, hf = tid >> 7;
    float r[32];
    float run = 0.f;
#pragma unroll
    for (int s = 0; s < 32; ++s) { run += bc[(hf * 32 + s) * BCS + d]; r[s] = run; }
    if (hf == 0) tots[d] = run;
    __syncthreads();
    const float add = hf ? tots[d] : 0.f;
#pragma unroll
    for (int s = 0; s < 32; ++s) bc[(hf * 32 + s) * BCS + d] = r[s] + add;
  }
  __syncthreads();
}

__device__ __forceinline__ void phase_hg_local(const Params& p, int l, char* smem) {
  const u16* Uhg = (const u16*)(p.ws + OFF_UHG);
  u16* states = (u16*)(p.ws + OFF_STATES);
  float* gdec = (float*)(p.ws + OFF_GDEC);
  float* bc = (float*)smem;
  float* lbs = (float*)(smem + 33792);
  u16* KT = (u16*)(smem + 33792 + 512);
  u16* VTs = (u16*)(smem + 33792 + 512 + 18432);
  const int tid = TIDX, lane = tid & 63, wave = tid >> 6;
  const int c16 = lane & 15, q = lane >> 4;
  const int vb0_ = BIDX;
  for (int k_ = 0; k_ < (1024 + VGRID - 1) / VGRID; ++k_) {
    int it = vb0_ + k_ * VGRID;
    if (it > 1023) it = 1023;
    const int b = it >> 9, h = (it >> 7) & 3, c = it & 127;
    const int t0 = b * SEQL + c * 64;
    hg_bcum(p, l, Uhg, t0, h, bc, lbs, (float*)(smem + 71168));
    {
      const int d = tid & 127;
      const float bl = bc[63 * BCS + d];
      for (int idx = tid; idx < 64 * 128; idx += 256) {
        const int s = idx >> 7;
        const float bs = bc[s * BCS + d];
        const float bp = s ? bc[(s - 1) * BCS + d] : 0.f;
        const float kk = 1.0f - __expf(bs - bp);
        KT[d * 72 + s] = f2bf(kk * __expf(bl - bs));
        VTs[d * 72 + s] = Uhg[(size_t)(t0 + s) * 2048 + 1024 + h * 128 + d];
      }
      if (tid < 128) gdec[(size_t)it * 128 + d] = __expf(bl);
    }
    __syncthreads();
    f32x4 acc[2][8];
#pragma unroll
    for (int i = 0; i < 2; ++i)
#pragma unroll
      for (int j = 0; j < 8; ++j) acc[i][j] = (f32x4){0.f, 0.f, 0.f, 0.f};
#pragma unroll
    for (int ks = 0; ks < 2; ++ks) {
      bf16x8 af[2];
#pragma unroll
      for (int i = 0; i < 2; ++i) af[i] = *(const bf16x8*)(VTs + (wave * 32 + i * 16 + c16) * 72 + ks * 32 + q * 8);
#pragma unroll
      for (int j = 0; j < 8; ++j) {
        const bf16x8 bfr = *(const bf16x8*)(KT + (j * 16 + c16) * 72 + ks * 32 + q * 8);
#pragma unroll
        for (int i = 0; i < 2; ++i) acc[i][j] = mfma16(af[i], bfr, acc[i][j]);
      }
    }
    __syncthreads();
    {
      u16* stg = (u16*)smem;
#pragma unroll
      for (int i = 0; i < 2; ++i)
#pragma unroll
        for (int j = 0; j < 8; ++j)
#pragma unroll
          for (int r = 0; r < 4; ++r) stg[(wave * 32 + i * 16 + q * 4 + r) * 136 + j * 16 + c16] = f2bf(acc[i][j][r]);
      __syncthreads();
      u16* st = states + (size_t)it * 16384;
#pragma unroll
      for (int k = 0; k < 8; ++k) {
        const int cc = tid + 256 * k;
        const int row = cc >> 4, ch = cc & 15;
        *(uint4*)(st + row * 128 + ch * 8) = *(const uint4*)(stg + row * 136 + ch * 8);
      }
    }
    __syncthreads();
  }
}

__device__ __forceinline__ void phase_hg_scan(const Params& p) {
  u16* __restrict__ states = (u16*)(p.ws + OFF_STATES);
  const float* __restrict__ gdec = (const float*)(p.ws + OFF_GDEC);
  const size_t nth = (size_t)VGRID * 256;
  for (size_t e = (size_t)BIDX * 256 + TIDX; e < (size_t)8 * 16384; e += nth) {
    const int bh = (int)(e >> 14), vd = (int)(e & 16383), d = vd & 127;
    float S = 0.f;
    for (int c0 = 0; c0 < 128; c0 += 16) {
      float Lv[16], gv[16];
#pragma unroll
      for (int i = 0; i < 16; ++i) {
        const size_t item = (size_t)bh * 128 + c0 + i;
        Lv[i] = bf2f(states[item * 16384 + vd]);
        gv[i] = gdec[item * 128 + d];
      }
#pragma unroll
      for (int i = 0; i < 16; ++i) {
        const size_t item = (size_t)bh * 128 + c0 + i;
        S = gv[i] * S + Lv[i];
        states[item * 16384 + vd] = f2bf(S);
      }
    }
  }
}

__device__ __forceinline__ void phase_hg_out(const Params& p, int l, char* smem) {
  const u16* Uhg = (const u16*)(p.ws + OFF_UHG);
  const u16* states = (const u16*)(p.ws + OFF_STATES);
  u16* Y = (u16*)(p.ws + OFF_Y);
  float* bc = (float*)smem;
  float* lbs = (float*)(smem + 33792);
  u16* VTs = (u16*)(smem + 33792 + 512);
  const int tid = TIDX, lane = tid & 63, wave = tid >> 6;
  const int c16 = lane & 15, q = lane >> 4;
  const int vb0_ = BIDX;
  for (int k_ = 0; k_ < (1024 + VGRID - 1) / VGRID; ++k_) {
    int it = vb0_ + k_ * VGRID;
    if (it > 1023) it = 1023;
    const int b = it >> 9, h = (it >> 7) & 3, c = it & 127;
    const int t0 = b * SEQL + c * 64;
    hg_bcum(p, l, Uhg, t0, h, bc, lbs, (float*)(smem + 71168));
    {
      const int d = tid & 127;
      for (int idx = tid; idx < 64 * 128; idx += 256) {
        const int s = idx >> 7;
        VTs[d * 72 + s] = Uhg[(size_t)(t0 + s) * 2048 + 1024 + h * 128 + d];
      }
    }
    __syncthreads();
    const int tt = wave * 16 + c16;
    const bool hi = (wave >= 2);
    bf16x8 Qt[4], Qh[4];
    float rr8[4][8];
#pragma unroll
    for (int ks = 0; ks < 4; ++ks) {
      const int d0 = ks * 32 + q * 8;
      if (hi) load8f(bc + 31 * BCS + d0, rr8[ks]);
      else {
#pragma unroll
        for (int j = 0; j < 8; ++j) rr8[ks][j] = 0.f;
      }
    }
#pragma unroll
    for (int ks = 0; ks < 4; ++ks) {
      const int d0 = ks * 32 + q * 8;
      const bf16x8 qraw = *(const bf16x8*)(Uhg + (size_t)(t0 + tt) * 2048 + h * 128 + d0);
      float bt8[8];
      load8f(bc + tt * BCS + d0, bt8);
      uint4 wt, wh;
      float a_[8], b_[8];
#pragma unroll
      for (int j = 0; j < 8; ++j) {
        const float qv = siluf_(bf2f((u16)qraw[j]));
        a_[j] = qv * __expf(bt8[j] - rr8[ks][j]);
        b_[j] = qv * __expf(bt8[j]);
      }
      wt = pack8(a_); wh = pack8(b_);
      Qt[ks] = __builtin_bit_cast(bf16x8, wt);
      Qh[ks] = __builtin_bit_cast(bf16x8, wh);
    }
    f32x4 at[4];
#pragma unroll
    for (int st = 0; st < 4; ++st) {
      at[st] = (f32x4){0.f, 0.f, 0.f, 0.f};
      if (st <= wave) {
        f32x4 a = {0.f, 0.f, 0.f, 0.f};
        const int srow = st * 16 + c16;
#pragma unroll
        for (int ks = 0; ks < 4; ++ks) {
          const int d0 = ks * 32 + q * 8;
          float bs8[8], bp8[8], kv[8];
          load8f(bc + srow * BCS + d0, bs8);
          if (srow > 0) load8f(bc + (srow - 1) * BCS + d0, bp8);
          else {
#pragma unroll
            for (int j = 0; j < 8; ++j) bp8[j] = 0.f;
          }
#pragma unroll
          for (int j = 0; j < 8; ++j) {
            const float kk = 1.0f - __expf(bs8[j] - bp8[j]);
            const float ex = fminf(rr8[ks][j] - bs8[j], 80.f);
            kv[j] = kk * __expf(ex);
          }
          const uint4 wk = pack8(kv);
          a = mfma16(__builtin_bit_cast(bf16x8, wk), Qt[ks], a);
        }
        int tt2 = tt;
        asm volatile("" : "+v"(tt2));
#pragma unroll
        for (int r = 0; r < 4; ++r) at[st][r] = ((st * 16 + q * 4 + r) <= tt2) ? a[r] : 0.f;
      }
    }
    bf16x8 pb[2];
#pragma unroll
    for (int sp = 0; sp < 2; ++sp)
#pragma unroll
      for (int j = 0; j < 4; ++j) {
        pb[sp][j] = (short)f2bf(at[2 * sp][j]);
        pb[sp][4 + j] = (short)f2bf(at[2 * sp + 1][j]);
      }
    f32x4 o[8];
    float ss = 0.f;
    const u16* Sp = states + (size_t)(it - 1) * 16384;
#pragma unroll
    for (int vt = 0; vt < 8; ++vt) {
      f32x4 acc = {0.f, 0.f, 0.f, 0.f};
#pragma unroll
      for (int sp = 0; sp < 2; ++sp) {
        if (2 * sp <= wave) {
          const u16* vr = VTs + (vt * 16 + c16) * 72 + sp * 32 + q * 4;
          const bf16x4 va = *(const bf16x4*)(vr);
          const bf16x4 vb = *(const bf16x4*)(vr + 16);
          const bf16x8 vf = __builtin_shufflevector(va, vb, 0, 1, 2, 3, 4, 5, 6, 7);
          acc = mfma16(vf, pb[sp], acc);
        }
      }
      o[vt] = acc;
    }
    if (c > 0) {
#pragma unroll
      for (int ks = 0; ks < 4; ++ks) {
        bf16x8 sf[8];
#pragma unroll
        for (int vt = 0; vt < 8; ++vt) sf[vt] = *(const bf16x8*)(Sp + (size_t)(vt * 16 + c16) * 128 + ks * 32 + q * 8);
#pragma unroll
        for (int vt = 0; vt < 8; ++vt) o[vt] = mfma16(sf[vt], Qh[ks], o[vt]);
      }
    }
#pragma unroll
    for (int vt = 0; vt < 8; ++vt)
#pragma unroll
      for (int r = 0; r < 4; ++r) ss += o[vt][r] * o[vt][r];
    ss += __shfl_xor(ss, 16);
    ss += __shfl_xor(ss, 32);
    const float rinv = rsqrtf(ss * (1.0f / 128.0f) + EPSN);
    const size_t trow = (size_t)(t0 + tt);
#pragma unroll
    for (int vt = 0; vt < 8; ++vt) {
      const int v0 = vt * 16 + q * 4;
      const uint2 graw = *(const uint2*)(Uhg + trow * 2048 + 1536 + h * 128 + v0);
      const float4 gn = *(const float4*)(p.gnorm + l * 128 + v0);
      const float y0 = o[vt][0] * rinv * gn.x * siluf_(bf2f((u16)(graw.x & 0xffff)));
      const float y1 = o[vt][1] * rinv * gn.y * siluf_(bf2f((u16)(graw.x >> 16)));
      const float y2 = o[vt][2] * rinv * gn.z * siluf_(bf2f((u16)(graw.y & 0xffff)));
      const float y3 = o[vt][3] * rinv * gn.w * siluf_(bf2f((u16)(graw.y >> 16)));
      uint2 w;
      w.x = pack2bf(y0, y1);
      w.y = pack2bf(y2, y3);
      *(uint2*)(Y + trow * 1536 + 512 + h * 128 + v0) = w;
    }
    __syncthreads();
  }
}


#define XB_TMO      128
#define XB_XCNT(j)  (256  + 64 * (j))
#define XB_XSUB(j)  (1280 + 64 * (j))
#define XB_XGEN(j)  (2304 + 64 * (j))
#define XB_TOP      3328
#define XB_TOPGEN   3392
#define XCD_BAR_WORDS 3456
#define XB_SPIN_CAP (1u << 18)

__device__ __forceinline__ unsigned xb_ld(unsigned* p)              { return __hip_atomic_load(p, __ATOMIC_RELAXED, __HIP_MEMORY_SCOPE_AGENT); }
__device__ __forceinline__ unsigned xb_add(unsigned* p, unsigned v) { return __hip_atomic_fetch_add(p, v, __ATOMIC_RELAXED, __HIP_MEMORY_SCOPE_AGENT); }
__device__ __forceinline__ unsigned xb_xcc_id() { return (unsigned)__builtin_amdgcn_s_getreg((3 << 11) | 20) & 0xFu; }
#define XB_SPIN(cond, bar) do { unsigned _sp = 0; while (cond) { __builtin_amdgcn_s_sleep(1); \
    if ((++_sp & 255u) == 0u) { if (xb_ld(&(bar)[XB_TMO])) break; if (_sp > XB_SPIN_CAP) { atomicAdd(&(bar)[XB_TMO], 1u); break; } } } } while (0)

struct XcdBarrier { unsigned* bar; unsigned x; volatile LAS unsigned* st; };

__device__ __forceinline__ XcdBarrier xcd_barrier_post(unsigned* bar, volatile LAS unsigned* st) {
    XcdBarrier b; b.bar = bar; b.x = xb_xcc_id(); b.st = st;
    if (threadIdx.x == 0) st[3] = xb_add(&bar[XB_XCNT(b.x)], 1u);
    return b;
}
__device__ __forceinline__ void xcd_barrier_complete(unsigned* bar, unsigned x, unsigned& nloc, unsigned& nx) {
    const unsigned G = gridDim.x * gridDim.y * gridDim.z;
    unsigned sum, cnt, mine, sp = 0u;
    for (;;) {
        sum = 0u; cnt = 0u; mine = 0u;
#pragma unroll
        for (unsigned j = 0; j < 16; ++j) { const unsigned c = xb_ld(&bar[XB_XCNT(j)]); sum += c; cnt += (c > 0u) ? 1u : 0u; mine = (j == x) ? c : mine; }
        if (sum == G) break;
        __builtin_amdgcn_s_sleep(1);
        if ((++sp & 255u) == 0u) { if (xb_ld(&bar[XB_TMO])) break; if (sp > XB_SPIN_CAP) { atomicAdd(&bar[XB_TMO], 1u); break; } }
    }
    nloc = mine > 0u ? mine : 1u; nx = cnt > 0u ? cnt : 1u;
}
__device__ __forceinline__ void xcd_barrier(const XcdBarrier& b) {
    asm volatile("s_waitcnt vmcnt(0)" ::: "memory");
    __syncthreads();
    if (threadIdx.x == 0) {
        unsigned* bar = b.bar;
        __builtin_amdgcn_s_waitcnt(0);
        unsigned nloc = b.st[0], nx = b.st[1];
        if (nloc == 0u) { xcd_barrier_complete(bar, b.x, nloc, nx); b.st[0] = nloc; b.st[1] = nx; }
        const unsigned old = xb_add(&bar[XB_XSUB(b.x)], 1u);
        const unsigned gen = old / nloc;
        if (old + 1u == (gen + 1u) * nloc) {
            __builtin_amdgcn_fence(__ATOMIC_RELEASE, "agent");
            asm volatile("s_waitcnt vmcnt(0)" ::: "memory");
            const unsigned og = xb_add(&bar[XB_TOP], 1u);
            const unsigned tg = og / nx;
            if (og + 1u == (tg + 1u) * nx) xb_add(&bar[XB_TOPGEN], 1u);
            else XB_SPIN(xb_ld(&bar[XB_TOPGEN]) == tg, bar);
            __builtin_amdgcn_fence(__ATOMIC_ACQUIRE, "agent");
            xb_add(&bar[XB_XGEN(b.x)], 1u);
            asm volatile("s_waitcnt vmcnt(0)" ::: "memory");
        } else {
            XB_SPIN(xb_ld(&bar[XB_XGEN(b.x)]) == gen, bar);
            __builtin_amdgcn_fence(__ATOMIC_ACQUIRE, "agent");
            asm volatile("s_waitcnt vmcnt(0)" ::: "memory");
        }
    }
    __syncthreads();
}

#define SMEM_HALF 71680
#define SMEM_BYTES 143360
#ifndef XREP
#define XREP 0
#endif
#ifndef REPMASK
#define REPMASK 0
#endif
#define NREP(st) (((st) >= 0 && (st) != 2 && (st) != 7 && (st) != 11 && (st) != 14 && ((REPMASK >> (st)) & 1)) ? 2 : 1)
__global__ void __launch_bounds__(512, 2) mega(Params p) {
  cg::grid_group grid = cg::this_grid();
  __shared__ __attribute__((aligned(16))) char smem[SMEM_BYTES];
  __shared__ uint4 xb_words;
  u16* sm16 = (u16*)smem;
  char* smh = smem + (int)HALF_ * SMEM_HALF;
  char* ws = p.ws;
  if (threadIdx.x == 0) xb_words = make_uint4(0u, 0u, 0u, 0u);
  __syncthreads();
  XcdBarrier xb = xcd_barrier_post((unsigned*)(ws + OFF_BAR), (volatile LAS unsigned*)&xb_words);
  if (threadIdx.x == 0) ((volatile LAS unsigned*)&xb_words)[2] = blockIdx.x;
  for (int gs = -1; gs < 60; ++gs) {
    const int l = (gs < 0) ? 0 : gs / 15;
    const int st = (gs < 0) ? -1 : gs % 15;
    const float* g = p.gains + (size_t)l * 6 * 1024;
    for (int rep_ = 0; rep_ < NREP(st); ++rep_) {
    if (st == 0 || st == 12) {
      phase_ffn_up(p, (const u16*)(ws + (st == 0 ? W_GU0 : W_GU1)), sm16, xb.st);
    } else if (st == 1 || st == 10 || st == 13) {
      const u16* A = (const u16*)(ws + (st == 10 ? OFF_H : OFF_ACT));
      const u16* Bt = (const u16*)(ws + (st == 10 ? W_OUT : (st == 1 ? W_D0 : W_D1)));
      const int K = (st == 10) ? 1024 : DFF;
      u16* outp = (u16*)(ws + (st == 10 ? OFF_D2 : OFF_D));
      phase_gemm_f32(A, Bt, K, outp, sm16, xb.st);
    } else if (st == -1 || st == 2 || st == 11 || st == 14) {
      if (st == -1) phase_rope_table(p);
      const int mode = (st == -1) ? 0 : 1;
      const u16* D = (const u16*)(ws + (st == 11 ? OFF_D2 : OFF_D));
      const float* gD = g + (st == 2 ? 1 : (st == 11 ? 3 : 5)) * 1024;
      const float scale = (st == 11) ? 1.0f : 0.5f;
      const float* gH = (st == -1) ? g : g + (st == 2 ? 2 : (st == 11 ? 4 : 6)) * 1024;
      const bool writeH = !(st == 14 && l == 3);
      phase_norm(p, mode, D, gD, scale, gH, writeH);
      if (XREP == 3) phase_norm(p, 2, D, gD, scale, gH, writeH);
      if (XREP == 4 && (st == -1 || (st == 14 && l < 3))) phase_convert(p, (st == -1) ? 0 : l + 1, (float*)smh);
      if (st == -1 || (st == 14 && l < 3)) phase_convert(p, (st == -1) ? 0 : l + 1, (float*)smh);
    } else if (st == 3 || st == 5) {
      if (st == 5) phase_cmp1(p, sm16, xb.st);
      phase_win(p, st == 5 ? 1 : 0, sm16, xb.st);
    } else if (st == 4) {
      phase_prep(p, l);
    } else if (st == 6) {
      phase_cmp2(p, l, (u16*)smh);
      phase_hg_local(p, l, smh);
    } else if (st == 7) {
      for (int r2_ = 0; r2_ < (XREP == 1 ? 2 : 1); ++r2_) phase_nsa_attn(p, smh, xb.st);
      phase_hg_scan(p);
    } else if (st == 8) {
      phase_hg_out(p, l, smh);
    } else if (st == 9) {
      phase_merge(p, sm16, xb.st);
    }
    }
    if (gs < 0) {
      grid.sync();
      if (threadIdx.x == 0) {
        unsigned* bar = (unsigned*)(ws + OFF_BAR);
        unsigned npop = 0, lower = 0, mine = 0; bool uni = true; unsigned first = 0;
        unsigned myx = xb.x;
        asm volatile("" : "+s"(myx));
#pragma unroll 1
        for (unsigned j = 0; j < 16; ++j) {
          const unsigned c = xb_ld(&bar[XB_XCNT(j)]);
          if (c > 0u) { if (npop == 0u) first = c; else if (c != first) uni = false; ++npop; if (j < myx) ++lower; }
          if (j == myx) mine = c;
        }
        const unsigned rank = ((volatile LAS unsigned*)&xb_words)[3];
        unsigned v = blockIdx.x;
        if (uni && npop == 8u && mine * 8u == gridDim.x && rank < mine) v = rank * 8u + lower;
        ((volatile LAS unsigned*)&xb_words)[2] = v;
      }
      __syncthreads();
    }
    else if (gs < 59) xcd_barrier(xb);
    if (XREP == 2 && gs < 59) xcd_barrier(xb);
  }
}

extern "C" void kernel_launch(void* const* d_in, const int* in_sizes, int n_in,
                              void* d_out, int out_size, void* d_ws, size_t ws_size,
                              hipStream_t stream) {
  static int grid_blocks = 0;
  if (!grid_blocks) {
    int dev = 0, cus = 0, per_cu = 0;
    hipGetDevice(&dev);
    hipDeviceGetAttribute(&cus, hipDeviceAttributeMultiprocessorCount, dev);
    hipOccupancyMaxActiveBlocksPerMultiprocessor(&per_cu, mega, 512, 0);
    if (per_cu > 1) per_cu = 1;
    if (per_cu < 1) per_cu = 1;
    grid_blocks = cus * per_cu;
  }
  if (ws_size < (size_t)WS_NEEDED) {
    fprintf(stderr, "workspace too small: %zu < %zu\n", ws_size, (size_t)WS_NEEDED);
    return;
  }
  Params p{};
  p.x_in = (const float*)d_in[0];
  p.pos = (const int*)d_in[1];
  p.lb_logits = (const float*)d_in[2];
  p.gains = (const float*)d_in[3];
  p.wg = (const float*)d_in[4];
  p.wu = (const float*)d_in[5];
  p.wd = (const float*)d_in[6];
  p.win = (const float*)d_in[7];
  p.convw = (const float*)d_in[8];
  p.gnorm = (const float*)d_in[9];
  p.pe = (const float*)d_in[10];
  p.cw1 = (const float*)d_in[11];
  p.cw2 = (const float*)d_in[12];
  p.wbr = (const float*)d_in[13];
  p.wout = (const float*)d_in[14];
  p.x = (float*)d_out;
  p.ws = (char*)d_ws;
  hipMemsetAsync((char*)d_ws + OFF_BAR, 0, 16384, stream);
  void* args[] = {&p};
  hipError_t e = hipLaunchCooperativeKernel((void*)mega, dim3(grid_blocks), dim3(512), args, 0, stream);
  if (e != hipSuccess) fprintf(stderr, "coop launch failed: %s (grid %d)\n", hipGetErrorString(e), grid_blocks);
}
```
